# Optimizing an MI355X kernel written in HIP

```python
import functools
import jax, jax.numpy as jnp
from jax import lax
import numpy as np

D_MODEL = 1024
BATCH = 32
SEQ = 2048
DEPTH = 2
DEC_BATCH = 32
DEC_SEQ = 64
PAST_LEN = 2048

CHUNK = 64
Q_BLOCK = 128
HEAD_DIM = 64
H_A = 6
H_B = 6
H_C = 4
W_A = H_A * HEAD_DIM
W_B = H_B * HEAD_DIM
W_C = H_C * HEAD_DIM
W_MIX = W_A + W_B + W_C
D_DECAY_LORA = 64
D_AAA_LORA = 64
SHIFT_W = 3 * W_A + D_DECAY_LORA + D_AAA_LORA
IN_COLS = SHIFT_W + W_A + 4 * W_B + H_B + 4 * W_C
ALPHA = (2 * DEPTH) ** 0.25
BETA = (8 * DEPTH) ** -0.25
GN_EPS = 64e-5
LN_EPS = 1e-5
NEG_INF = -1e30

kernel_name = 'hybrid_rwkv7_fox_stickbreak_stream_step'


def _layernorm(x, g, b):
    xf = x.astype(jnp.float32)
    mu = jnp.mean(xf, axis=-1, keepdims=True)
    var = jnp.mean(jnp.square(xf - mu), axis=-1, keepdims=True)
    return ((xf - mu) * lax.rsqrt(var + LN_EPS) * g + b).astype(x.dtype)


def _wkv7_scan(s0, r, decay, k, v, kk, a):
    def step(s, inp):
        r_t, w_t, k_t, v_t, kk_t, a_t = inp
        sa = jnp.einsum('bhvk,bhk->bhv', s, kk_t)
        s = (s * w_t[:, :, None, :]
             - sa[..., None] * (kk_t * a_t)[:, :, None, :]
             + v_t[..., None] * k_t[:, :, None, :])
        return s, jnp.einsum('bhvk,bhk->bhv', s, r_t)
    xs = tuple(jnp.moveaxis(z, 1, 0) for z in (r, decay, k, v, kk, a))
    s_fin, y = lax.scan(step, s0, xs)
    return s_fin, jnp.moveaxis(y, 0, 1)


def _sweep_queries(block_fn, q_inputs, q_pos):
    tq = q_pos.shape[0]
    qb = min(Q_BLOCK, tq)
    nb = -(-tq // qb)
    pad = nb * qb - tq

    def to_blocks(arr):
        arr = jnp.pad(arr, [(0, 0), (0, pad)] + [(0, 0)] * (arr.ndim - 2), mode='edge')
        return jnp.moveaxis(arr.reshape(arr.shape[0], nb, qb, *arr.shape[2:]), 1, 0)

    qs = tuple(to_blocks(arr) for arr in q_inputs)
    qp = jnp.pad(q_pos, (0, pad), mode='edge').reshape(nb, qb)
    out = lax.map(lambda xs: block_fn(*xs[0], xs[1]), (qs, qp))
    out = jnp.moveaxis(out, 0, 1)
    return out.reshape(out.shape[0], nb * qb, *out.shape[3:])[:, :tq]


def _fox_block(q, fq, q_pos, k, v, fk, k_pos):
    s = jnp.einsum('bqhd,bkhd->bhqk', q, k).astype(jnp.float32) * (HEAD_DIM ** -0.5)
    s = s + jnp.swapaxes(fq, 1, 2)[..., :, None] - jnp.swapaxes(fk, 1, 2)[..., None, :]
    s = jnp.where(k_pos[None, :] <= q_pos[:, None], s, NEG_INF)
    p = jax.nn.softmax(s, axis=-1)
    return jnp.einsum('bhqk,bkhd->bqhd', p.astype(v.dtype), v)


def _sb_block(q, q_pos, k, v, k_pos):
    z = jnp.einsum('bqhd,bkhd->bhqk', q, k).astype(jnp.float32) * (HEAD_DIM ** -0.5)
    mask = k_pos[None, :] < q_pos[:, None]
    log_1m = jnp.where(mask, jax.nn.log_sigmoid(-z), 0.0)
    after = lax.cumsum(log_1m, axis=3, reverse=True) - log_1m
    w = jnp.where(mask, jnp.exp(jax.nn.log_sigmoid(z) + after), 0.0)
    return jnp.einsum('bhqk,bkhd->bqhd', w.astype(v.dtype), v)


def _layer(x, hist, w_in, mu_shift, w0_decay, w_decay, a0, w_aaa, k_k, k_a, r_k,
           lnx_g, lnx_b, fox_fb, w_out, ln_g, ln_b):
    f32 = jnp.float32
    bsz, t, _ = x.shape
    past = 0 if hist is None else hist[0].shape[1]
    q_pos = past + jnp.arange(t, dtype=jnp.int32)
    k_pos = jnp.arange(past + t, dtype=jnp.int32)

    u = jnp.einsum('btd,dc->btc', x, w_in)
    sizes = (SHIFT_W, W_A, W_B, W_B, W_B, H_B, W_B, W_C, W_C, W_C, W_C)
    (u_shift, g_a, q_b, k_b, v_b, f_b, g_b, q_c, k_c, v_c, g_c) = jnp.split(
        u, np.cumsum(sizes)[:-1].tolist(), axis=-1)

    prev = (jnp.zeros((bsz, 1, SHIFT_W), u.dtype) if hist is None else hist[6].astype(u.dtype))
    z_prev = jnp.concatenate([prev, u_shift[:, :-1]], axis=1)
    zs = u_shift + (z_prev - u_shift) * mu_shift
    r, k, v, w_lo, a_lo = jnp.split(
        zs, [W_A, 2 * W_A, 3 * W_A, 3 * W_A + D_DECAY_LORA], axis=-1)
    w_log = -jax.nn.softplus(-(w0_decay + jnp.tanh(w_lo) @ w_decay).astype(f32)) - 0.5
    decay = jnp.exp(-jnp.exp(w_log))
    a = jax.nn.sigmoid((a0 + a_lo @ w_aaa).astype(f32))

    def heads_a(z):
        return z.reshape(bsz, t, H_A, HEAD_DIM).astype(f32)

    r, k, v, decay, a = (heads_a(z) for z in (r, k, v, decay, a))
    kk = k * k_k.reshape(H_A, HEAD_DIM)
    kk = kk * lax.rsqrt(jnp.sum(kk * kk, axis=-1, keepdims=True) + 1e-12)
    k = k * (1.0 + (a - 1.0) * k_a.reshape(H_A, HEAD_DIM))
    s0 = (jnp.zeros((bsz, H_A, HEAD_DIM, HEAD_DIM), f32) if hist is None else hist[5].astype(f32))
    wkv_new, y = _wkv7_scan(s0, r, decay, k, v, kk, a)
    mean = jnp.mean(y, axis=-1, keepdims=True)
    var = jnp.mean(jnp.square(y - mean), axis=-1, keepdims=True)
    yn = ((y - mean) * lax.rsqrt(var + GN_EPS) * lnx_g.reshape(H_A, HEAD_DIM)
          + lnx_b.reshape(H_A, HEAD_DIM))
    bonus = jnp.sum(r * k * r_k, axis=-1, keepdims=True) * v
    o_a = (yn + bonus).reshape(bsz, t, W_A).astype(x.dtype) * jax.nn.silu(g_a)

    qh_b = q_b.reshape(bsz, t, H_B, HEAD_DIM)
    kh_b = k_b.reshape(bsz, t, H_B, HEAD_DIM)
    vh_b = v_b.reshape(bsz, t, H_B, HEAD_DIM)
    logf = jax.nn.log_sigmoid((f_b + fox_fb).astype(f32))
    if hist is None:
        kb_all, vb_all, lf_all = kh_b, vh_b, logf
    else:
        kb_all = jnp.concatenate([hist[0].astype(kh_b.dtype), kh_b], axis=1)
        vb_all = jnp.concatenate([hist[1].astype(vh_b.dtype), vh_b], axis=1)
        lf_all = jnp.concatenate([hist[2].astype(f32), logf], axis=1)
    cum_f = jnp.cumsum(lf_all, axis=1)
    o = _sweep_queries(
        functools.partial(_fox_block, k=kb_all, v=vb_all, fk=cum_f, k_pos=k_pos),
        (qh_b, cum_f[:, past:]), q_pos)
    o_b = o.reshape(bsz, t, W_B).astype(x.dtype) * jax.nn.silu(g_b)

    qh_c = q_c.reshape(bsz, t, H_C, HEAD_DIM)
    kh_c = k_c.reshape(bsz, t, H_C, HEAD_DIM)
    vh_c = v_c.reshape(bsz, t, H_C, HEAD_DIM)
    if hist is None:
        kc_all, vc_all = kh_c, vh_c
    else:
        kc_all = jnp.concatenate([hist[3].astype(kh_c.dtype), kh_c], axis=1)
        vc_all = jnp.concatenate([hist[4].astype(vh_c.dtype), vh_c], axis=1)
    o = _sweep_queries(
        functools.partial(_sb_block, k=kc_all, v=vc_all, k_pos=k_pos), (qh_c,), q_pos)
    o_c = o.reshape(bsz, t, W_C).astype(x.dtype) * jax.nn.silu(g_c)

    out = jnp.einsum('btc,cd->btd', jnp.concatenate([o_a, o_b, o_c], axis=-1), w_out)
    y_out = _layernorm(ALPHA * x + out, ln_g, ln_b)
    return y_out, (kh_b, vh_b, logf, kh_c, vh_c, wkv_new, u_shift[:, -1:])


def setup_inputs(seed: int = 0) -> dict:
    key = jax.random.key(seed)
    ks = jax.random.split(key, 24)
    f32 = jnp.float32
    L = DEPTH

    def nrm(k, shape, s=1.0):
        return s * jax.random.normal(k, shape, f32)

    def uni(k, shape, lo, hi):
        return jax.random.uniform(k, shape, f32, lo, hi)

    return {
        'x_prompt': nrm(ks[0], (BATCH, SEQ, D_MODEL)),
        'x_sample': nrm(ks[1], (DEC_BATCH, DEC_SEQ, D_MODEL)),
        'cache_fox_k': nrm(ks[2], (L, DEC_BATCH, PAST_LEN, H_B, HEAD_DIM)),
        'cache_fox_v': nrm(ks[3], (L, DEC_BATCH, PAST_LEN, H_B, HEAD_DIM)),
        'cache_fox_logf': jax.nn.log_sigmoid(3.0 + nrm(ks[4], (L, DEC_BATCH, PAST_LEN, H_B))),
        'cache_sb_k': nrm(ks[5], (L, DEC_BATCH, PAST_LEN, H_C, HEAD_DIM)),
        'cache_sb_v': nrm(ks[6], (L, DEC_BATCH, PAST_LEN, H_C, HEAD_DIM)),
        'state_wkv': nrm(ks[7], (L, DEC_BATCH, H_A, HEAD_DIM, HEAD_DIM), 0.1),
        'state_shift': nrm(ks[8], (L, DEC_BATCH, 1, SHIFT_W)),
        'w_in': nrm(ks[9], (L, D_MODEL, IN_COLS), D_MODEL ** -0.5),
        'mu_shift': uni(ks[10], (L, SHIFT_W), 0.0, 1.0),
        'w0_decay': uni(ks[11], (L, W_A), -5.0, 1.0),
        'w_decay': nrm(ks[12], (L, D_DECAY_LORA, W_A), 0.5 * D_DECAY_LORA ** -0.5),
        'a0': nrm(ks[13], (L, W_A), 0.1),
        'w_aaa': nrm(ks[14], (L, D_AAA_LORA, W_A), 0.5 * D_AAA_LORA ** -0.5),
        'k_k': 0.85 + nrm(ks[15], (L, W_A), 0.05),
        'k_a': 1.0 + nrm(ks[16], (L, W_A), 0.05),
        'r_k': nrm(ks[17], (L, H_A, HEAD_DIM), 0.1),
        'lnx_g': 1.0 + nrm(ks[18], (L, W_A), 0.05),
        'lnx_b': nrm(ks[19], (L, W_A), 0.01),
        'fox_fb': uni(ks[20], (L, H_B), 1.0, 5.0),
        'w_out': nrm(ks[21], (L, W_MIX, D_MODEL), BETA * W_MIX ** -0.5),
        'ln_g': 1.0 + nrm(ks[22], (L, D_MODEL), 0.05),
        'ln_b': nrm(ks[23], (L, D_MODEL), 0.01),
    }


def reference(x_prompt, x_sample, cache_fox_k, cache_fox_v, cache_fox_logf, cache_sb_k,
              cache_sb_v, state_wkv, state_shift, w_in, mu_shift, w0_decay, w_decay, a0,
              w_aaa, k_k, k_a, r_k, lnx_g, lnx_b, fox_fb, w_out, ln_g, ln_b):
    yp, ys = x_prompt, x_sample
    new_p, new_s = [], []
    for l in range(DEPTH):
        prm = (w_in[l], mu_shift[l], w0_decay[l], w_decay[l], a0[l], w_aaa[l], k_k[l],
               k_a[l], r_k[l], lnx_g[l], lnx_b[l], fox_fb[l], w_out[l], ln_g[l], ln_b[l])
        yp, st_p = _layer(yp, None, *prm)
        hist = (cache_fox_k[l], cache_fox_v[l], cache_fox_logf[l], cache_sb_k[l],
                cache_sb_v[l], state_wkv[l], state_shift[l])
        ys, st_s = _layer(ys, hist, *prm)
        new_p.append(st_p)
        new_s.append(st_s)

    def stack(sts, i):
        return jnp.stack([st[i] for st in sts])

    p_fox_k, p_fox_v, p_fox_logf = stack(new_p, 0), stack(new_p, 1), stack(new_p, 2)
    p_sb_k, p_sb_v = stack(new_p, 3), stack(new_p, 4)
    p_wkv, p_shift = stack(new_p, 5), stack(new_p, 6)
    s_fox_k, s_fox_v, s_fox_logf = stack(new_s, 0), stack(new_s, 1), stack(new_s, 2)
    s_sb_k, s_sb_v = stack(new_s, 3), stack(new_s, 4)
    s_wkv, s_shift = stack(new_s, 5), stack(new_s, 6)
    return (yp, ys, p_fox_k, p_fox_v, p_fox_logf, p_sb_k, p_sb_v, p_wkv, p_shift,
            s_fox_k, s_fox_v, s_fox_logf, s_sb_k, s_sb_v, s_wkv, s_shift)
```

```cpp
#define PREPFN prep_wave
#include <hip/hip_runtime.h>
#include <hip/hip_cooperative_groups.h>
#include <cstdio>
#include <cstdint>
namespace cg = cooperative_groups;
namespace pg8 {
#define PG8_LAS __attribute__((address_space(3)))
typedef unsigned short bf16_t;
typedef short bf16x8 __attribute__((ext_vector_type(8)));
typedef float f32x4 __attribute__((ext_vector_type(4)));
typedef unsigned u32x4 __attribute__((ext_vector_type(4)));
constexpr int BM = 256, BK = 64, HALF = 128, HTB = HALF * BK * 2  , STAGE_BYTES = 8 * HTB, NXCD = 8, WGM = 8;

__host__ __device__ __forceinline__ int lds_byte(int r, int c) { const int st = (r >> 4) * 2 + (c >> 5), rr = r & 15, cc = c & 31, ob = rr * 64 + cc * 2; return st * 1024 + (ob ^ (((ob >> 9) & 1) << 5)); }
__host__ __device__ __forceinline__ void stage_rc(int b, int& R, int& C) { const int st = b / 1024, sb = b % 1024, swz = sb ^ (((sb >> 9) & 1) << 5); R = (st >> 1) * 16 + swz / 64; C = (st & 1) * 32 + (swz % 64) / 2; }
__host__ __device__ __forceinline__ int perm32(int rho) { const int n = rho >> 4, i = rho & 15; return 8 * (i >> 2) + 4 * n + (i & 3); }

struct Unit { int pm, pn; };
struct Gemm { const bf16_t* A; const bf16_t* Bt; int M, N, K; };

struct StaticOrder {
    int nM, nN, nwg, G, c;
    __host__ __device__ void init(int M, int N, int G_, int c_) { nM = M / BM; nN = N / BM; nwg = nM * nN; G = G_; c = c_; }
    __host__ __device__ bool next(int i, Unit& u) const {
        const long L = (long)i * G + c; if (L >= nwg) return false;
        int wgid = (int)L; { const int q = nwg / NXCD, r = nwg % NXCD, xcd = wgid % NXCD, off = wgid / NXCD; wgid = (xcd < r ? xcd * (q + 1) : r * (q + 1) + (xcd - r) * q) + off; }
        const int nig = WGM * nN, gid = wgid / nig, fm = gid * WGM, gsz = (nM - fm) < WGM ? (nM - fm) : WGM;
        u.pm = fm + ((wgid % nig) % gsz); u.pn = (wgid % nig) / gsz; return true;
    }
    __device__ __forceinline__ void a_ready(const Unit&) const {}
    __device__ __forceinline__ void done(const Unit&) const {}
};

template <class Epi, class Sched, bool ALIGN_EPI = false, bool SP2 = false>
__device__ __forceinline__ void gemm_phase(PG8_LAS unsigned char* lds, const Gemm g, const Sched& S, const Epi& E) {
    int tid_ = threadIdx.x; asm volatile("" : "+v"(tid_));
    const int tid = tid_, wid = __builtin_amdgcn_readfirstlane(tid >> 6), lane = tid & 63, wr = wid >> 2, wc = wid & 3, fr = lane & 15, fq = lane >> 4;
    const int K = g.K, nt = K / BK;
    unsigned voffA[2], voffB[2];
#pragma unroll
    for (int i = 0; i < 2; ++i) { int R, C; stage_rc(tid * 16 + i * 8192, R, C); const int Rb = Epi::PERM ? ((R & ~31) + perm32(R & 31)) : R;
        voffA[i] = (unsigned)(R * K + C) * 2u; voffB[i] = (unsigned)(Rb * K + C) * 2u; }
    const size_t kstep = (size_t)(BK * 2);
    const size_t hstep = (size_t)HALF * K * 2;
    const size_t tstep = 2 * hstep;
    const unsigned ldsw = (unsigned)wid * 1024u;
    const int aoff = lds_byte(wr * 64 + fr, fq * 8), boff = lds_byte(wc * 32 + fr, fq * 8);
#define PG8_SA(b, h) (((b) * 2 + (h)) * HTB)
#define PG8_SB(b, h) ((4 + (b) * 2 + (h)) * HTB)
#define PG8_STAGE(bufoff, gbase, voff) do { _Pragma("unroll") for (int _i = 0; _i < 2; ++_i) \
        __builtin_amdgcn_global_load_lds((const unsigned*)((const char*)(gbase) + (voff)[_i]), (PG8_LAS unsigned*)(lds + (bufoff) + ldsw + _i * 8192), 16, 0, 0); } while (0)
#define PG8_LDA(dst, b, h) do { _Pragma("unroll") for (int m = 0; m < 4; ++m) _Pragma("unroll") for (int k = 0; k < 2; ++k) dst[m][k] = *(const PG8_LAS bf16x8*)(lds + PG8_SA(b, h) + aoff + m * 2048 + k * 1024); } while (0)
#define PG8_LDB(dst, b, h) do { _Pragma("unroll") for (int n = 0; n < 2; ++n) _Pragma("unroll") for (int k = 0; k < 2; ++k) dst[n][k] = *(const PG8_LAS bf16x8*)(lds + PG8_SB(b, h) + boff + n * 2048 + k * 1024); } while (0)
#define PG8_MMA(ai, bj, At, Bt) do { __builtin_amdgcn_s_setprio(1); _Pragma("unroll") for (int m = 0; m < 4; ++m) _Pragma("unroll") for (int n = 0; n < 2; ++n) _Pragma("unroll") for (int k = 0; k < 2; ++k) \
        acc[ai][bj][m][n] = __builtin_amdgcn_mfma_f32_16x16x32_bf16(Bt[n][k], At[m][k], acc[ai][bj][m][n], 0, 0, 0); __builtin_amdgcn_s_setprio(0); } while (0)
#define PG8_WAIT_V(n) asm volatile("s_waitcnt vmcnt(" #n ")" ::: "memory")
#define PG8_WAIT_L(n) asm volatile("s_waitcnt lgkmcnt(" #n ")" ::: "memory")
#define PG8_BAR __builtin_amdgcn_s_barrier()
#define PG8_SCHED __builtin_amdgcn_sched_barrier(0)
    Unit cur, nxt; int ui = 0;
    if (!S.next(0, cur)) return;
    f32x4 acc[2][2][4][2];
#pragma unroll
    for (int a = 0; a < 2; ++a)
#pragma unroll
        for (int b = 0; b < 2; ++b)
#pragma unroll
            for (int m = 0; m < 4; ++m)
#pragma unroll
                for (int n = 0; n < 2; ++n) acc[a][b][m][n] = (f32x4){0.f, 0.f, 0.f, 0.f};
    bf16x8 At[4][2], B0[2][2], B1[2][2];
    const char* cA = (const char*)g.A + (size_t)cur.pm * tstep; const char* cB = (const char*)g.Bt + (size_t)cur.pn * tstep;
    S.a_ready(cur);
    if constexpr (SP2) {
        PG8_STAGE(PG8_SB(0, 0), cB, voffB); PG8_STAGE(PG8_SB(0, 1), cB + hstep, voffB); PG8_STAGE(PG8_SA(0, 0), cA, voffA); PG8_STAGE(PG8_SA(0, 1), cA + hstep, voffA);
        if (wr == 1) PG8_BAR;
        PG8_WAIT_V(2); PG8_BAR;
        PG8_STAGE(PG8_SB(1, 0), cB + kstep, voffB); PG8_STAGE(PG8_SA(1, 0), cA + kstep, voffA); PG8_STAGE(PG8_SB(1, 1), cB + hstep + kstep, voffB);
        PG8_WAIT_V(6); PG8_BAR;
    } else {
        PG8_STAGE(PG8_SB(0, 0), cB, voffB); PG8_STAGE(PG8_SA(0, 0), cA, voffA); PG8_STAGE(PG8_SB(0, 1), cB + hstep, voffB); PG8_STAGE(PG8_SA(0, 1), cA + hstep, voffA);
        if (wr == 1) PG8_BAR;
        PG8_WAIT_V(4); PG8_BAR;
        PG8_STAGE(PG8_SB(1, 0), cB + kstep, voffB); PG8_STAGE(PG8_SA(1, 0), cA + kstep, voffA); PG8_STAGE(PG8_SB(1, 1), cB + hstep + kstep, voffB);
        PG8_WAIT_V(6); PG8_BAR;
    }
    for (;;) {
        const bool has_next = S.next(ui + 1, nxt);
        const char* nA = has_next ? (const char*)g.A + (size_t)nxt.pm * tstep : cA; const char* nB = has_next ? (const char*)g.Bt + (size_t)nxt.pn * tstep : cB;
        for (int t = 0; t < nt; t += 2) {
            const bool last = (t == nt - 2);
            const char* a1 = cA + (size_t)(t + 1) * kstep;
            const char* a2 = last ? nA : cA + (size_t)(t + 2) * kstep; const char* b2 = last ? nB : cB + (size_t)(t + 2) * kstep;
            const char* a3 = a2 + kstep; const char* b3 = b2 + kstep;
            if (last && has_next) S.a_ready(nxt);
            if constexpr (SP2) {
            PG8_LDB(B0, 0, 0); PG8_LDB(B1, 0, 1); PG8_SCHED; PG8_LDA(At, 0, 0); PG8_STAGE(PG8_SA(1, 1), a1 + hstep, voffA);
            PG8_WAIT_V(8); PG8_WAIT_L(0); PG8_BAR; PG8_MMA(0, 0, At, B0); PG8_MMA(0, 1, At, B1); PG8_BAR; PG8_SCHED;
            PG8_LDA(At, 0, 1); PG8_STAGE(PG8_SB(0, 0), b2, voffB); PG8_STAGE(PG8_SB(0, 1), b2 + hstep, voffB); PG8_STAGE(PG8_SA(0, 0), a2, voffA);
            PG8_WAIT_V(8); PG8_WAIT_L(0); PG8_BAR; PG8_MMA(1, 0, At, B0); PG8_MMA(1, 1, At, B1); PG8_BAR; PG8_SCHED;
            PG8_LDB(B0, 1, 0); PG8_LDB(B1, 1, 1); PG8_SCHED; PG8_LDA(At, 1, 0); PG8_STAGE(PG8_SA(0, 1), a2 + hstep, voffA);
            PG8_WAIT_V(8); PG8_WAIT_L(0); PG8_BAR; PG8_MMA(0, 0, At, B0); PG8_MMA(0, 1, At, B1); PG8_BAR; PG8_SCHED;
            PG8_LDA(At, 1, 1); PG8_STAGE(PG8_SB(1, 0), b3, voffB); PG8_STAGE(PG8_SB(1, 1), b3 + hstep, voffB); PG8_STAGE(PG8_SA(1, 0), a3, voffA);
            PG8_WAIT_V(8); PG8_WAIT_L(0); PG8_BAR; PG8_MMA(1, 0, At, B0); PG8_MMA(1, 1, At, B1); PG8_BAR; PG8_SCHED;
            } else {
            PG8_LDB(B0, 0, 0); PG8_SCHED; PG8_LDA(At, 0, 0); PG8_STAGE(PG8_SA(1, 1), a1 + hstep, voffA);
            PG8_WAIT_L(8); PG8_BAR; PG8_WAIT_L(0); PG8_MMA(0, 0, At, B0); PG8_BAR; PG8_SCHED;
            PG8_LDB(B1, 0, 1); PG8_STAGE(PG8_SB(0, 0), b2, voffB);
            PG8_BAR; PG8_WAIT_L(0); PG8_MMA(0, 1, At, B1); PG8_BAR;
            PG8_LDA(At, 0, 1); PG8_STAGE(PG8_SA(0, 0), a2, voffA);
            PG8_BAR; PG8_WAIT_L(0); PG8_MMA(1, 0, At, B0); PG8_BAR; PG8_SCHED;
            PG8_STAGE(PG8_SB(0, 1), b2 + hstep, voffB);
            PG8_WAIT_V(6); PG8_BAR; PG8_MMA(1, 1, At, B1); PG8_BAR;
            PG8_LDB(B0, 1, 0); PG8_SCHED; PG8_LDA(At, 1, 0); PG8_STAGE(PG8_SA(0, 1), a2 + hstep, voffA);
            PG8_WAIT_L(8); PG8_BAR; PG8_WAIT_L(0); PG8_MMA(0, 0, At, B0); PG8_BAR; PG8_SCHED;
            PG8_LDB(B1, 1, 1); PG8_STAGE(PG8_SB(1, 0), b3, voffB);
            PG8_BAR; PG8_WAIT_L(0); PG8_MMA(0, 1, At, B1); PG8_BAR;
            PG8_LDA(At, 1, 1); PG8_STAGE(PG8_SA(1, 0), a3, voffA);
            PG8_BAR; PG8_WAIT_L(0); PG8_MMA(1, 0, At, B0); PG8_BAR; PG8_SCHED;
            PG8_STAGE(PG8_SB(1, 1), b3 + hstep, voffB);
            PG8_WAIT_V(6); PG8_BAR; PG8_MMA(1, 1, At, B1); PG8_BAR;
            }
        }
        if constexpr (ALIGN_EPI) { if (wr == 0) PG8_BAR; }
        if constexpr (!Epi::AFTER_DRAIN) { E(acc, cur, wr, wc, fr, fq); S.done(cur); }
        if (!has_next) break;
#pragma unroll
        for (int a = 0; a < 2; ++a)
#pragma unroll
            for (int b = 0; b < 2; ++b)
#pragma unroll
                for (int m = 0; m < 4; ++m)
#pragma unroll
                    for (int n = 0; n < 2; ++n) acc[a][b][m][n] = (f32x4){0.f, 0.f, 0.f, 0.f};
        cur = nxt; cA = nA; cB = nB; ++ui;
        if constexpr (ALIGN_EPI) { if (wr == 1) PG8_BAR; }
    }
    PG8_WAIT_V(0);
    if constexpr (!ALIGN_EPI) { if (wr == 0) PG8_BAR; }
    PG8_BAR;
    if constexpr (Epi::AFTER_DRAIN) { E.fused(acc, cur, wr, wc, fr, fq, lds, wid, lane); S.done(cur); }
#undef PG8_SA
#undef PG8_SB
#undef PG8_STAGE
#undef PG8_LDA
#undef PG8_LDB
#undef PG8_MMA
#undef PG8_WAIT_V
#undef PG8_WAIT_L
#undef PG8_BAR
#undef PG8_SCHED
}
}

#define DI __device__ __forceinline__
#define LAS __attribute__((address_space(3)))
typedef unsigned short bf16_t;
typedef short bf16x8 __attribute__((ext_vector_type(8)));
typedef short v4i16_t __attribute__((ext_vector_type(4)));
typedef float f32x2 __attribute__((ext_vector_type(2)));
typedef float f32x4 __attribute__((ext_vector_type(4)));
typedef float f32x16 __attribute__((ext_vector_type(16)));
typedef unsigned u32x2 __attribute__((ext_vector_type(2)));
typedef unsigned u32x4 __attribute__((ext_vector_type(4)));
typedef __bf16 bf16x2_t __attribute__((ext_vector_type(2)));

constexpr int DM = 1024, NBATCH = 32, TP = 2048, TSS = 64, PAST = 2048, HD = 64, NHA = 6, NHB = 6, NHC = 4;
constexpr int MP = NBATCH * TP, MS = NBATCH * TSS, MT = MP + MS;
constexpr int SHW = 1280, INC = 4230, NPAD = 4352;
constexpr int U_R = 0, U_K = 384, U_V = 768, U_WLO = 1152, U_ALO = 1216, U_GA = 1280, U_QB = 1664, U_KB = 2048, U_VB = 2432, U_GB = 2816,
              U_QC = 3200, U_KC = 3456, U_VC = 3712, U_GC = 3968, U_FB = 4224;
constexpr float ALPHA = 1.41421356237f;
constexpr float GN_EPS = 64e-5f, LN_EPS = 1e-5f;
constexpr float LOG2E = 1.4426950408889634f;
constexpr float QSCALE2 = 0.125f * LOG2E;

constexpr size_t O_YP = 0, O_YS = O_YP + (size_t)MP * DM, O_PFK = O_YS + (size_t)MS * DM, O_PFV = O_PFK + 2ull * MP * 384, O_PFL = O_PFV + 2ull * MP * 384,
                 O_PSK = O_PFL + 2ull * MP * 6, O_PSV = O_PSK + 2ull * MP * 256, O_PWKV = O_PSV + 2ull * MP * 256, O_PSH = O_PWKV + 2ull * 32 * 6 * 4096,
                 O_SFK = O_PSH + 2ull * 32 * 1280, O_SFV = O_SFK + 2ull * MS * 384, O_SFL = O_SFV + 2ull * MS * 384, O_SSK = O_SFL + 2ull * MS * 6,
                 O_SSV = O_SSK + 2ull * MS * 256, O_SWKV = O_SSV + 2ull * MS * 256, O_SSH = O_SWKV + 2ull * 32 * 6 * 4096, O_END = O_SSH + 2ull * 32 * 1280;
static_assert(O_END == 246341632ull, "output size");

constexpr size_t MiB = 1u << 20;
constexpr size_t WS_CTL = 0, CTL_BYTES = 4096, WS_WIN = 1 * MiB, WS_WOUT = 20 * MiB, WS_LOGF = 24 * MiB, WS_XB = 28 * MiB, WS_OB = 160 * MiB, WS_UB = 292 * MiB,
                 WS_BFK = WS_UB + (((size_t)MT * NPAD * 2 + MiB - 1) / MiB) * MiB,
                 BF_BYTES = (size_t)(32 * 6 * 66) * 4096, BS_BYTES = (size_t)(32 * 4 * 66) * 4096, WS_BFV = WS_BFK + BF_BYTES, WS_BSK = WS_BFV + BF_BYTES, WS_BSV = WS_BSK + BS_BYTES, WS_END = WS_BSV + BS_BYTES;
static_assert(WS_WIN + 2ull * NPAD * DM * 2 <= WS_WOUT && WS_WOUT + 2ull * DM * DM * 2 <= WS_LOGF && WS_LOGF + (size_t)MT * 8 * 4 <= WS_XB &&
              WS_XB + (size_t)MT * DM * 2 <= WS_OB && WS_OB + (size_t)MT * DM * 2 <= WS_UB && WS_END <= 1023 * MiB, "ws map");

constexpr int LDS_BYTES = 147456;
constexpr int WK_STRIDE = 8448;
constexpr int SC_OFF = 8 * WK_STRIDE;
constexpr int CH = 16;
constexpr int OPTOK = 384;
constexpr int OPBUF_BYTES = CH * OPTOK * 4;
constexpr int SC_OP = SC_OFF, SC_Y = SC_OP + 2 * OPBUF_BYTES, YBUF_BYTES = CH * 128 * 4  , SC_BON = SC_Y + 2 * YBUF_BYTES, SC_FLAGS = SC_BON + 2 * 64;
static_assert(SC_FLAGS + 64 <= LDS_BYTES, "scan LDS");
enum { F_PROD = 0, F_POST = 1, F_CONS = 2, F_PRODB = 6, F_POSTB = 7, F_SETUP = 8 };

struct Params { const float* in[24]; float* out; unsigned char* ws; int ph_lo, ph_hi, rep_ph, dbg; };
typedef const __attribute__((address_space(4))) Params* PP;
DI PP pp_launder(PP p) { asm volatile("" : "+s"(p)); return p; }

DI float bf2f(unsigned short h) { return __uint_as_float((unsigned)h << 16); }
DI float bflo(unsigned w) { return __uint_as_float(w << 16); }
DI float bfhi(unsigned w) { return __uint_as_float(w & 0xffff0000u); }
DI unsigned cvtpk(float lo, float hi) { f32x2 v = {lo, hi}; bf16x2_t b = __builtin_convertvector(v, bf16x2_t); return __builtin_bit_cast(unsigned, b); }
DI float fast_exp2(float x) { return __builtin_amdgcn_exp2f(x); }
DI float fast_rcp(float x) { return __builtin_amdgcn_rcpf(x); }
DI float sigmoidf_(float x) { return fast_rcp(1.f + fast_exp2(-LOG2E * x)); }
DI float siluf_(float x) { return x * sigmoidf_(x); }
DI float swap32_other(float x, float& mine_lo, float& mine_hi) { auto r = __builtin_amdgcn_permlane32_swap(__float_as_uint(x), __float_as_uint(x), false, false); mine_lo = __uint_as_float(r[0]); mine_hi = __uint_as_float(r[1]); return 0.f; }
DI float red4(float x) {
    auto a = __builtin_amdgcn_permlane16_swap(__float_as_uint(x), __float_as_uint(x), false, false);
    const float s = __uint_as_float(a[0]) + __uint_as_float(a[1]);
    auto b = __builtin_amdgcn_permlane32_swap(__float_as_uint(s), __float_as_uint(s), false, false);
    return __uint_as_float(b[0]) + __uint_as_float(b[1]);
}
template <int CTRL> DI float dpp_f(float x) { return __uint_as_float((unsigned)__builtin_amdgcn_update_dpp(0, (int)__float_as_uint(x), CTRL, 0xf, 0xf, false)); }
DI float red16(float x) {
    x += dpp_f<0x121>(x); x += dpp_f<0x122>(x); x += dpp_f<0x124>(x); x += dpp_f<0x128>(x); return x;
}
DI unsigned ld_flag(LAS unsigned* p) { return __hip_atomic_load(p, __ATOMIC_ACQUIRE, __HIP_MEMORY_SCOPE_WORKGROUP); }
DI void st_flag(LAS unsigned* p, unsigned v) { __hip_atomic_store(p, v, __ATOMIC_RELEASE, __HIP_MEMORY_SCOPE_WORKGROUP); }
DI void wait_ge(LAS unsigned* p, unsigned need) { while (ld_flag(p) < need) __builtin_amdgcn_s_sleep(1); }
DI int crow(int r, int hi) { return (r & 3) + 8 * (r >> 2) + 4 * hi; }
#define MFMA32(a, b, c) __builtin_amdgcn_mfma_f32_32x32x16_bf16((a), (b), (c), 0, 0, 0)
#define MFMA16(a, b, c) __builtin_amdgcn_mfma_f32_16x16x32_bf16((a), (b), (c), 0, 0, 0)

DI void p0_item(const float* W, int Nsrc, int kind, bf16_t* WT, LAS float* scr, int item, int nblk, int lane) {
    const int kb = item / nblk, nb = item % nblk, k0 = 64 * kb, n0 = 32 * nb;
    const int n = n0 + (lane & 31); int src = n; bool valid = true;
    if (kind == 0) { if (n < 2816) src = n; else if (n < 4224) src = n + 6; else if (n < 4230) src = n - 4224 + 2816; else { valid = false; src = 0; } }
#pragma unroll 8
    for (int i = 0; i < 32; ++i) { const int kk = 2 * i + (lane >> 5); scr[kk * 33 + (lane & 31)] = valid ? W[(size_t)(k0 + kk) * Nsrc + src] : 0.f; }
    asm volatile("s_waitcnt lgkmcnt(0)" ::: "memory");
    const int c = lane & 7;
#pragma unroll
    for (int j = 0; j < 4; ++j) { const int nn = (lane >> 3) + 8 * j; const LAS float* s = scr + (8 * c) * 33 + nn;
        u32x4 o; o.x = cvtpk(s[0 * 33], s[1 * 33]); o.y = cvtpk(s[2 * 33], s[3 * 33]); o.z = cvtpk(s[4 * 33], s[5 * 33]); o.w = cvtpk(s[6 * 33], s[7 * 33]);
        *(u32x4*)(WT + (size_t)(n0 + nn) * 1024 + k0 + 8 * c) = o; }
    asm volatile("s_waitcnt lgkmcnt(0)" ::: "memory");
}
DI void phase0(PP P, LAS unsigned char* lds, int wave, int lane, int bidx, int gdim) {
    LAS float* scr = (LAS float*)(lds + wave * 8448);
    const int gw = bidx * 8 + wave, NGW = gdim * 8;
    constexpr int I_IN = 16 * (NPAD / 32), I_OUT = 16 * 32, NITEMS = 2 * (I_IN + I_OUT);
    for (int it = gw; it < NITEMS; it += NGW) {
        int r = it; const int l = r / (I_IN + I_OUT); r -= l * (I_IN + I_OUT);
        if (r < I_IN) p0_item(P->in[9] + (size_t)l * DM * INC, INC, 0, (bf16_t*)(P->ws + WS_WIN) + (size_t)l * NPAD * DM, scr, r, NPAD / 32, lane);
        else p0_item(P->in[21] + (size_t)l * DM * DM, DM, 1, (bf16_t*)(P->ws + WS_WOUT) + (size_t)l * DM * DM, scr, r - I_IN, 32, lane);
    }
    bf16_t* xb = (bf16_t*)(P->ws + WS_XB);
#pragma unroll 4
    for (int m = gw; m < MT; m += NGW) {
        const float* xr = (m < MP) ? P->in[0] + (size_t)m * DM : P->in[1] + (size_t)(m - MP) * DM;
        const f32x4* x4 = (const f32x4*)xr + lane; u32x2* o = (u32x2*)(xb + (size_t)m * DM) + lane;
#pragma unroll
        for (int j = 0; j < 4; ++j) { const f32x4 v = x4[64 * j]; u32x2 w; w.x = cvtpk(v.x, v.y); w.y = cvtpk(v.z, v.w); o[64 * j] = w; }
    }
}

DI float log_sigmoid_f(float x) { return fminf(x, 0.f) - log1pf(expf(-fabsf(x))); }
struct EpiU {
    static constexpr bool PERM = true, AFTER_DRAIN = false;
    unsigned char* ws; float* out; const float* fb; int l, mode;
    DI void operator()(const pg8::f32x4 (&acc)[2][2][4][2], const pg8::Unit& u, int wr, int wc, int fr, int fq) const {
        const int row0 = u.pm * 256 + wr * 64 + fr;
        if (mode == 0) {
            bf16_t* U = (bf16_t*)(ws + WS_UB); float* logf = (float*)(ws + WS_LOGF);
#pragma unroll
            for (int bj = 0; bj < 2; ++bj) {
                const int ch = u.pn * 2 + bj, c0 = ch * 128 + wc * 32 + 8 * fq;
                int W = 0, cs = 0, isv = 0, NHx = 6; size_t op = 0, os = 0, wb = 0;
                if (ch >= 16 && ch < 19) { W = 384; cs = U_KB; op = O_PFK; os = O_SFK; wb = WS_BFK; }
                else if (ch >= 19 && ch < 22) { W = 384; cs = U_VB; op = O_PFV; os = O_SFV; wb = WS_BFV; isv = 1; }
                else if (ch == 27 || ch == 28) { W = 256; cs = U_KC; op = O_PSK; os = O_SSK; wb = WS_BSK; NHx = 4; }
                else if (ch == 29 || ch == 30) { W = 256; cs = U_VC; op = O_PSV; os = O_SSV; wb = WS_BSV; NHx = 4; isv = 1; }
                const int hh = (c0 - cs) >> 6, dd = (c0 - cs) & 63;
                const unsigned koff = (unsigned)((dd >> 4) * 1024 + ((dd >> 3) & 1) * 512), voff = (unsigned)((dd >> 5) * 2048 + ((dd & 31) >> 3) * 16);
                float* segp = out + op + (size_t)l * MP * W + (c0 - cs); float* segs = out + os + (size_t)l * MS * W + (c0 - cs);
#pragma unroll
                for (int ai = 0; ai < 2; ++ai)
#pragma unroll
                    for (int m = 0; m < 4; ++m) {
                        const int r = row0 + ai * 128 + m * 16;
                        const f32x4 v0 = acc[ai][bj][m][0], v1 = acc[ai][bj][m][1];
                        u32x4 w; w.x = cvtpk(v0[0], v0[1]); w.y = cvtpk(v0[2], v0[3]); w.z = cvtpk(v1[0], v1[1]); w.w = cvtpk(v1[2], v1[3]);
                        if (W) { float* d = (r < MP) ? segp + (size_t)r * W : segs + (size_t)(r - MP) * W; *(f32x4*)d = v0; *(f32x4*)(d + 4) = v1;
                            int bq, tq_, smp; if (r < MP) { bq = r >> 11; tq_ = r & 2047; smp = 0; } else { const int rs = r - MP; bq = rs >> 6; tq_ = rs & 63; smp = 1; }
                            const unsigned tix = smp ? (unsigned)(32 * NHx * 64 + (bq * NHx + hh) * 2 + (tq_ >> 5)) : (unsigned)((bq * NHx + hh) * 64 + (tq_ >> 5));
                            const int r32_ = tq_ & 31;
                            const unsigned off = isv ? voff + (unsigned)((r32_ >> 4) * 1024 + (r32_ & 15) * 64) : koff + (unsigned)(r32_ * 16);
                            *(u32x4*)(ws + wb + (size_t)tix * 4096 + off) = w; }
                        else *(u32x4*)(U + (size_t)r * NPAD + c0) = w;
                        if (ch < 10) {
                            if (r < MP) { if ((r & 2047) == 2047) { float* d = out + O_PSH + (size_t)(l * 32 + (r >> 11)) * SHW + c0; *(f32x4*)d = v0; *(f32x4*)(d + 4) = v1; } }
                            else { const int rs = r - MP; if ((rs & 63) == 63) { float* d = out + O_SSH + (size_t)(l * 32 + (rs >> 6)) * SHW + c0; *(f32x4*)d = v0; *(f32x4*)(d + 4) = v1; } }
                        }
                        if (ch == 33 && wc == 0 && fq == 0) {
                            float lf[6];
#pragma unroll
                            for (int h = 0; h < 6; ++h) { const float x = (h < 4 ? v0[h] : v1[h - 4]) + fb[h]; lf[h] = log_sigmoid_f(x); }
                            float* d = (r < MP) ? out + O_PFL + ((size_t)l * MP + r) * 6 : out + O_SFL + ((size_t)l * MS + (r - MP)) * 6;
#pragma unroll
                            for (int h = 0; h < 6; ++h) { d[h] = lf[h]; logf[(size_t)r * 8 + h] = lf[h]; }
                        }
                    }
            }
        } else {
            const bf16_t* X = (const bf16_t*)(ws + WS_XB); bf16_t* Z = (bf16_t*)(ws + WS_UB);
#pragma unroll
            for (int ai = 0; ai < 2; ++ai)
#pragma unroll
                for (int m = 0; m < 4; ++m) {
                    const size_t r = (size_t)(row0 + ai * 128 + m * 16);
#pragma unroll
                    for (int bj = 0; bj < 2; ++bj) {
                        const int c = u.pn * 256 + bj * 128 + wc * 32 + 8 * fq;
                        const u32x4 xw = *(const u32x4*)(X + r * DM + c);
                        f32x4 z0 = acc[ai][bj][m][0], z1 = acc[ai][bj][m][1];
                        z0[0] += ALPHA * bflo(xw.x); z0[1] += ALPHA * bfhi(xw.x); z0[2] += ALPHA * bflo(xw.y); z0[3] += ALPHA * bfhi(xw.y);
                        z1[0] += ALPHA * bflo(xw.z); z1[1] += ALPHA * bfhi(xw.z); z1[2] += ALPHA * bflo(xw.w); z1[3] += ALPHA * bfhi(xw.w);
                        u32x4 zw; zw.x = cvtpk(z0[0], z0[1]); zw.y = cvtpk(z0[2], z0[3]); zw.z = cvtpk(z1[0], z1[1]); zw.w = cvtpk(z1[2], z1[3]);
                        *(u32x4*)(Z + r * DM + c) = zw;
                    }
                }
        }
    }
};

DI float wave_sum(float v) {
#pragma unroll
    for (int o = 1; o < 64; o <<= 1) v += __shfl_xor(v, o);
    return v;
}
DI void phase_ln(PP P, int l, int wave, int lane, int bidx, int gdim) {
    const int gw = bidx * 8 + wave, NGW = gdim * 8;
    const bf16_t* Z = (const bf16_t*)(P->ws + WS_UB); bf16_t* xb = (bf16_t*)(P->ws + WS_XB);
    const f32x4* g4 = (const f32x4*)(P->in[22] + (size_t)l * DM) + lane; const f32x4* b4 = (const f32x4*)(P->in[23] + (size_t)l * DM) + lane;
    f32x4 g[4], bb[4];
#pragma unroll
    for (int j = 0; j < 4; ++j) { g[j] = g4[64 * j]; bb[j] = b4[64 * j]; }
#pragma unroll 2
    for (int m = gw; m < MT; m += NGW) {
        const u32x2* z4 = (const u32x2*)(Z + (size_t)m * DM) + lane;
        f32x4 v[4]; float s = 0.f;
#pragma unroll
        for (int j = 0; j < 4; ++j) { const u32x2 zz_ = z4[64 * j]; v[j] = (f32x4){bflo(zz_.x), bfhi(zz_.x), bflo(zz_.y), bfhi(zz_.y)}; s += (v[j].x + v[j].y) + (v[j].z + v[j].w); }
        const float mean = wave_sum(s) * (1.f / DM); float s2 = 0.f;
#pragma unroll
        for (int j = 0; j < 4; ++j) { v[j] = v[j] - mean; s2 += (v[j].x * v[j].x + v[j].y * v[j].y) + (v[j].z * v[j].z + v[j].w * v[j].w); }
        const float rstd = 1.f / sqrtf(wave_sum(s2) * (1.f / DM) + LN_EPS);
#pragma unroll
        for (int j = 0; j < 4; ++j) v[j] = v[j] * rstd * g[j] + bb[j];
        if (l == 0) { u32x2* o = (u32x2*)(xb + (size_t)m * DM) + lane;
#pragma unroll
            for (int j = 0; j < 4; ++j) { u32x2 w; w.x = cvtpk(v[j].x, v[j].y); w.y = cvtpk(v[j].z, v[j].w); o[64 * j] = w; } }
        else { f32x4* o = (f32x4*)(P->out + O_YP + (size_t)m * DM) + lane;
#pragma unroll
            for (int j = 0; j < 4; ++j) o[64 * j] = v[j]; }
    }
}

DI void scan_wave(PP P, int l, LAS unsigned char* lds, int wave, int lane, int seq0, int nseq, bool sample, int dbg, bool two = false) {
    const int row = wave * 16 + (lane & 15), kq = lane >> 4;
    LAS unsigned* flags = (LAS unsigned*)(lds + SC_FLAGS);
    unsigned cgl = 0;
    const int nch = sample ? TSS / CH : TP / CH;
    __builtin_amdgcn_s_setprio(3);
    for (int s = 0; s < nseq; ++s) {
        const int seq = seq0 + s, b = seq / 6, h = seq % 6;
        f32x4 S[4];
        if (sample) { const f32x4* sp = (const f32x4*)(P->in[7] + ((size_t)((l * 32 + b) * 6 + h) * 64 + row) * 64 + kq * 16);
#pragma unroll
            for (int i = 0; i < 4; ++i) S[i] = sp[i]; }
        else {
#pragma unroll
            for (int i = 0; i < 4; ++i) S[i] = (f32x4){0.f, 0.f, 0.f, 0.f}; }
        for (int c = 0; c < nch; ++c, ++cgl) {
            if (two) { wait_ge(&flags[(cgl & 1) ? F_PRODB : F_PROD], (cgl >> 1) + 1); if (cgl >= 2) wait_ge(&flags[(cgl & 1) ? F_POSTB : F_POST], cgl >> 1); }
            else { wait_ge(&flags[F_PROD], cgl + 1); if (cgl >= 2) wait_ge(&flags[F_POST], cgl - 1); }
            LAS const float* opb = (LAS const float*)(lds + SC_OP + (cgl & 1) * OPBUF_BYTES);
            LAS float* yb = (LAS float*)(lds + SC_Y + (cgl & 1) * YBUF_BYTES);
            LAS const float* bon = (LAS const float*)(lds + SC_BON + (cgl & 1) * 64);
            LAS const float* tp0 = opb + kq * 16; asm volatile("" : "+v"(tp0));
            LAS const float* vp0 = opb + 320 + row; asm volatile("" : "+v"(vp0));
            f32x4 w4[2][4], kk4[2][4], ka4[2][4], kp4[2][4], r4[2][4]; float vv[2], bt[2];
#define SC_LOAD(buf, t_) do { LAS const float* tp = tp0 + (t_) * OPTOK; \
                _Pragma("unroll") for (int i = 0; i < 4; ++i) { w4[buf][i] = *(LAS const f32x4*)(tp + 4 * i); kk4[buf][i] = *(LAS const f32x4*)(tp + 64 + 4 * i); ka4[buf][i] = *(LAS const f32x4*)(tp + 128 + 4 * i); \
                    kp4[buf][i] = *(LAS const f32x4*)(tp + 192 + 4 * i); r4[buf][i] = *(LAS const f32x4*)(tp + 256 + 4 * i); } \
                vv[buf] = vp0[(t_) * OPTOK]; bt[buf] = bon[t_]; } while (0)
            SC_LOAD(0, 0);
#pragma unroll
            for (int t = 0; t < CH; ++t) {
                if ((dbg & 8) && t >= 8) break;
                const int cb = t & 1, nb = cb ^ 1;
                if (t + 1 < CH) SC_LOAD(nb, t + 1);
                f32x4 a4 = S[0] * kk4[cb][0];
#pragma unroll
                for (int i = 1; i < 4; ++i) a4 += S[i] * kk4[cb][i];
                float sa = (a4[0] + a4[1]) + (a4[2] + a4[3]);
                sa = red4(sa);
                const float nsa = -sa;
                f32x4 y4 = (f32x4){0.f, 0.f, 0.f, 0.f};
#pragma unroll
                for (int i = 0; i < 4; ++i) { S[i] = S[i] * w4[cb][i] + nsa * ka4[cb][i] + vv[cb] * kp4[cb][i]; y4 += S[i] * r4[cb][i]; }
                float y = (y4[0] + y4[1]) + (y4[2] + y4[3]);
                y = red4(y);
                if (kq < 2) yb[t * 128 + kq * 64 + row] = kq == 0 ? y : bt[cb] * vv[cb];
            }
#undef SC_LOAD
            st_flag(&flags[F_CONS + wave], cgl + 1);
        }
        float* so = P->out + (sample ? O_SWKV : O_PWKV) + ((size_t)((l * 32 + b) * 6 + h) * 64 + row) * 64 + kq * 16;
        if (!(dbg & 256)) {
#pragma unroll
            for (int i = 0; i < 4; ++i) *(f32x4*)(so + 4 * i) = S[i]; }
    }
    __builtin_amdgcn_s_setprio(0);
}

constexpr int SC_CST = SC_FLAGS + 64, CST_BYTES = 10 * 64 * 4, RAWBUF = 16384;
static_assert(SC_CST + CST_BYTES <= LDS_BYTES && 2 * RAWBUF <= 4 * WK_STRIDE && 15 * 1024 <= RAWBUF, "prep LDS");
#define RAWOFF(R, sg, c) ((((sg) * 3 + ((R) >> 3)) * 1024) + (((R) & 7) * 128) + (c) * 2)
DI void prep_wave(PP P, int l, LAS unsigned char* lds, int lane, int seq0, int nseq, bool sample, int dbg) {
    const int fr = lane & 15, fq = lane >> 4;
    LAS unsigned* flags = (LAS unsigned*)(lds + SC_FLAGS);
    LAS float* cst = (LAS float*)(lds + SC_CST);
    const bf16_t* ub = (const bf16_t*)(P->ws + WS_UB);
    const float* mu = P->in[10] + (size_t)l * SHW;
    unsigned cgl = 0;
    const int nch = sample ? TSS / CH : TP / CH;
    const int c8 = lane & 7, rsub = lane >> 3;
    const unsigned goff = (unsigned)(rsub * NPAD + c8 * 8) * 2u;
    for (int s = 0; s < nseq; ++s) {
        const int seq = seq0 + s, b = seq / 6, h = seq % 6;
        const size_t m0 = sample ? (size_t)MP + (size_t)b * TSS : (size_t)b * TP;
        const float* sh0 = P->in[8] + (size_t)(l * 32 + b) * SHW;
        {
            const int kc = h * 64 + lane;
            cst[0 * 64 + lane] = mu[U_R + kc]; cst[1 * 64 + lane] = mu[U_K + kc]; cst[2 * 64 + lane] = mu[U_V + kc];
            cst[3 * 64 + lane] = P->in[11][(size_t)l * 384 + kc]; cst[4 * 64 + lane] = P->in[13][(size_t)l * 384 + kc]; cst[5 * 64 + lane] = P->in[15][(size_t)l * 384 + kc];
            cst[6 * 64 + lane] = P->in[16][(size_t)l * 384 + kc]; cst[7 * 64 + lane] = P->in[17][(size_t)l * 384 + kc];
            cst[8 * 64 + lane] = mu[U_WLO + lane]; cst[9 * 64 + lane] = mu[U_ALO + lane];
        }
        LAS unsigned char* btab = lds + 4 * WK_STRIDE;
        {
            LAS float* wst = (LAS float*)lds;
#pragma unroll
            for (int arr = 0; arr < 2; ++arr)
#pragma unroll
                for (int ks = 0; ks < 2; ++ks) {
                    const float* W = P->in[arr == 0 ? 12 : 14] + (size_t)l * 64 * 384 + (size_t)(32 * ks) * 384 + h * 64;
                    asm volatile("" ::: "memory");
#pragma unroll
                    for (int n = 0; n < 8; ++n) { const int row = (lane >> 4) + 4 * n; *(LAS f32x4*)(wst + row * 64 + (lane & 15) * 4) = *(const f32x4*)(W + (size_t)row * 384 + (lane & 15) * 4); }
                    asm volatile("" ::: "memory");
#pragma unroll
                    for (int j = 0; j < 4; ++j) { u32x4 pq;
#pragma unroll
                        for (int e = 0; e < 4; ++e) { const int k0 = 8 * fq + 2 * e; pq[e] = cvtpk(wst[k0 * 64 + 16 * j + fr], wst[(k0 + 1) * 64 + 16 * j + fr]); }
                        *(LAS u32x4*)(btab + (((arr * 4 + j) * 2 + ks) * 64 + lane) * 16) = pq; }
                    asm volatile("" ::: "memory");
                }
        }
        u32x4 pf[15];
#define PREP_FETCH(c_) do { const char* gb_ = (const char*)(ub + (m0 + (size_t)(c_) * CH - 1) * NPAD); \
            _Pragma("unroll") for (int sg = 0; sg < 5; ++sg) { const char* gs_ = gb_ + (sg < 3 ? (sg * 384 + h * 64) * 2 : (sg == 3 ? U_WLO * 2 : U_ALO * 2)); \
                _Pragma("unroll") for (int rg = 0; rg < 3; ++rg) { if (rg < 2 || rsub == 0) pf[sg * 3 + rg] = *(const u32x4*)(gs_ + (size_t)(rg * 8 * NPAD * 2) + goff); } } } while (0)
        asm volatile("s_waitcnt vmcnt(0) lgkmcnt(0)" ::: "memory");
        PREP_FETCH(0);
        for (int c = 0; c < nch; ++c, ++cgl) {
            if (dbg & 2) { if (cgl >= 2) { for (int j = 0; j < 4; ++j) wait_ge(&flags[F_CONS + j], cgl - 1); } st_flag(&flags[F_PROD], cgl + 1); continue; }
            const int t0 = c * CH;
            LAS unsigned char* raw = lds + (c & 1) * RAWBUF;
#pragma unroll
            for (int sg = 0; sg < 5; ++sg)
#pragma unroll
                for (int rg = 0; rg < 3; ++rg) { if (rg < 2 || rsub == 0) *(LAS u32x4*)(raw + (sg * 3 + rg) * 1024 + lane * 16) = pf[sg * 3 + rg]; }
            if (t0 == 0 && rsub == 0) {
#pragma unroll
                for (int sg = 0; sg < 5; ++sg) {
                    u32x4 v = (u32x4){0u, 0u, 0u, 0u};
                    if (sample) { const int col_ = (sg < 3 ? sg * 384 + h * 64 : (sg == 3 ? U_WLO : U_ALO)) + c8 * 8;
                        const f32x4 a = *(const f32x4*)(sh0 + col_), bq = *(const f32x4*)(sh0 + col_ + 4); v.x = cvtpk(a[0], a[1]); v.y = cvtpk(a[2], a[3]); v.z = cvtpk(bq[0], bq[1]); v.w = cvtpk(bq[2], bq[3]); }
                    *(LAS u32x4*)(raw + sg * 3 * 1024 + c8 * 16) = v;
                }
            }
            asm volatile("" ::: "memory");
            if (c + 1 < nch) PREP_FETCH(c + 1);
            int zz = 0; asm volatile("" : "+v"(zz));
            LAS const float* cz = cst + zz;
            f32x4 Dw[4], Da[4];
            {
                bf16x8 Aw[2], Aa[2];
#pragma unroll
                for (int ks = 0; ks < 2; ++ks) {
                    const u32x4 cw = *(LAS const u32x4*)(raw + RAWOFF(fr + 1, 3, 32 * ks + 8 * fq)), pwv = *(LAS const u32x4*)(raw + RAWOFF(fr, 3, 32 * ks + 8 * fq));
                    const u32x4 ca = *(LAS const u32x4*)(raw + RAWOFF(fr + 1, 4, 32 * ks + 8 * fq)), pav = *(LAS const u32x4*)(raw + RAWOFF(fr, 4, 32 * ks + 8 * fq));
                    const f32x4 mw0 = *(LAS const f32x4*)(cz + 8 * 64 + 32 * ks + 8 * fq), mw1 = *(LAS const f32x4*)(cz + 8 * 64 + 32 * ks + 8 * fq + 4);
                    const f32x4 ma0 = *(LAS const f32x4*)(cz + 9 * 64 + 32 * ks + 8 * fq), ma1 = *(LAS const f32x4*)(cz + 9 * 64 + 32 * ks + 8 * fq + 4);
                    u32x4 pw, pa;
#pragma unroll
                    for (int e = 0; e < 4; ++e) {
                        const float c0 = bflo(cw[e]), c1 = bfhi(cw[e]), p0 = bflo(pwv[e]), p1 = bfhi(pwv[e]);
                        const float m0_ = (e < 2 ? mw0[2 * e] : mw1[2 * e - 4]), m1_ = (e < 2 ? mw0[2 * e + 1] : mw1[2 * e - 3]);
                        const float z0 = c0 + (p0 - c0) * m0_, z1 = c1 + (p1 - c1) * m1_;
                        const float t0_ = 1.f - 2.f * fast_rcp(1.f + fast_exp2(2.f * LOG2E * z0)), t1_ = 1.f - 2.f * fast_rcp(1.f + fast_exp2(2.f * LOG2E * z1));
                        pw[e] = cvtpk(t0_, t1_);
                        const float d0 = bflo(ca[e]), d1 = bfhi(ca[e]), q0 = bflo(pav[e]), q1 = bfhi(pav[e]);
                        const float n0_ = (e < 2 ? ma0[2 * e] : ma1[2 * e - 4]), n1_ = (e < 2 ? ma0[2 * e + 1] : ma1[2 * e - 3]);
                        pa[e] = cvtpk(d0 + (q0 - d0) * n0_, d1 + (q1 - d1) * n1_);
                    }
                    Aw[ks] = __builtin_bit_cast(bf16x8, pw); Aa[ks] = __builtin_bit_cast(bf16x8, pa);
                }
#pragma unroll
                for (int j = 0; j < 4; ++j) {
                    const f32x4 z = (f32x4){0.f, 0.f, 0.f, 0.f};
                    LAS const unsigned char* bt = btab + zz + lane * 16;
                    Dw[j] = MFMA16(Aw[0], *(LAS const bf16x8*)(bt + ((0 * 4 + j) * 2 + 0) * 1024), z); Dw[j] = MFMA16(Aw[1], *(LAS const bf16x8*)(bt + ((0 * 4 + j) * 2 + 1) * 1024), Dw[j]);
                    Da[j] = MFMA16(Aa[0], *(LAS const bf16x8*)(bt + ((1 * 4 + j) * 2 + 0) * 1024), z); Da[j] = MFMA16(Aa[1], *(LAS const bf16x8*)(bt + ((1 * 4 + j) * 2 + 1) * 1024), Da[j]);
                }
            }
            if (cgl >= 2) {
#pragma unroll
                for (int j = 0; j < 4; ++j) wait_ge(&flags[F_CONS + j], cgl - 1);
            }
            LAS float* opb = (LAS float*)(lds + SC_OP + (cgl & 1) * OPBUF_BYTES);
            LAS float* bon = (LAS float*)(lds + SC_BON + (cgl & 1) * 64);
#pragma unroll
            for (int i = 0; i < 4; ++i) {
                const int tl = 4 * fq + i; LAS const unsigned char* rc = raw + RAWOFF(tl + 1, 0, fr); LAS const unsigned char* rp = raw + RAWOFF(tl, 0, fr);
#define RB(p_, sg_, j_) bf2f(*(LAS const bf16_t*)((p_) + (sg_) * 3072 + (j_) * 32))
                float rr[4], kk[4], vv[4], aa[4], ww[4], kn[4]; float ss = 0.f;
#pragma unroll
                for (int j = 0; j < 4; ++j) {
                    const float cr = RB(rc, 0, j), ck = RB(rc, 1, j), cv = RB(rc, 2, j);
                    const float pr = RB(rp, 0, j), pk = RB(rp, 1, j), pv_ = RB(rp, 2, j);
                    rr[j] = cr + (pr - cr) * cz[0 * 64 + 16 * j + fr]; kk[j] = ck + (pk - ck) * cz[1 * 64 + 16 * j + fr]; vv[j] = cv + (pv_ - cv) * cz[2 * 64 + 16 * j + fr];
                    const float x = cz[3 * 64 + 16 * j + fr] + Dw[j][i];
                    const float sg = fast_rcp(1.f + fast_exp2(-LOG2E * x));
                    ww[j] = fast_exp2(-0.60653066f * LOG2E * sg);
                    aa[j] = fast_rcp(1.f + fast_exp2(-LOG2E * (cz[4 * 64 + 16 * j + fr] + Da[j][i])));
                    kn[j] = kk[j] * cz[5 * 64 + 16 * j + fr]; ss += kn[j] * kn[j];
                }
                ss = red16(ss);
                const float rn = 1.f / sqrtf(ss + 1e-12f);
                float bs = 0.f; LAS float* o = opb + tl * OPTOK + fr;
#pragma unroll
                for (int j = 0; j < 4; ++j) {
                    const float knn = kn[j] * rn, kp = kk[j] * (1.f + (aa[j] - 1.f) * cz[6 * 64 + 16 * j + fr]);
                    bs += rr[j] * kp * cz[7 * 64 + 16 * j + fr];
                    o[16 * j] = ww[j]; o[64 + 16 * j] = knn; o[128 + 16 * j] = knn * aa[j]; o[192 + 16 * j] = kp; o[256 + 16 * j] = rr[j]; o[320 + 16 * j] = vv[j];
                }
                bs = red16(bs);
                if (fr == 0) bon[tl] = bs;
#undef RB
            }
            st_flag(&flags[F_PROD], cgl + 1);
        }
#undef PREP_FETCH
    }
}

DI void helper2_wave(PP P, int l, LAS unsigned char* lds, int lane, int seq0, int par, int dbg) {
    const int nseq = 1; const bool sample = false;
    const int fr = lane & 15, fq = lane >> 4;
    LAS unsigned* flags = (LAS unsigned*)(lds + SC_FLAGS);
    LAS float* cst = (LAS float*)(lds + SC_CST);
    const bf16_t* ub = (const bf16_t*)(P->ws + WS_UB);
    const float* mu = P->in[10] + (size_t)l * SHW;
    unsigned cgl = 0;
    const int nch = sample ? TSS / CH : TP / CH;
    const int c8 = lane & 7, rsub = lane >> 3;
    const unsigned goff = (unsigned)(rsub * NPAD + c8 * 8) * 2u;
    for (int s = 0; s < nseq; ++s) {
        const int seq = seq0 + s, b = seq / 6, h = seq % 6;
        const size_t m0 = sample ? (size_t)MP + (size_t)b * TSS : (size_t)b * TP;
        const float* sh0 = P->in[8] + (size_t)(l * 32 + b) * SHW;
        if (par == 0) {
            const int kc = h * 64 + lane;
            cst[0 * 64 + lane] = mu[U_R + kc]; cst[1 * 64 + lane] = mu[U_K + kc]; cst[2 * 64 + lane] = mu[U_V + kc];
            cst[3 * 64 + lane] = P->in[11][(size_t)l * 384 + kc]; cst[4 * 64 + lane] = P->in[13][(size_t)l * 384 + kc]; cst[5 * 64 + lane] = P->in[15][(size_t)l * 384 + kc];
            cst[6 * 64 + lane] = P->in[16][(size_t)l * 384 + kc]; cst[7 * 64 + lane] = P->in[17][(size_t)l * 384 + kc];
            cst[8 * 64 + lane] = mu[U_WLO + lane]; cst[9 * 64 + lane] = mu[U_ALO + lane];
        }
        LAS unsigned char* btab = lds + 4 * WK_STRIDE;
        if (par == 0) {
            LAS float* wst = (LAS float*)lds;
#pragma unroll
            for (int arr = 0; arr < 2; ++arr)
#pragma unroll
                for (int ks = 0; ks < 2; ++ks) {
                    const float* W = P->in[arr == 0 ? 12 : 14] + (size_t)l * 64 * 384 + (size_t)(32 * ks) * 384 + h * 64;
                    asm volatile("" ::: "memory");
#pragma unroll
                    for (int n = 0; n < 8; ++n) { const int row = (lane >> 4) + 4 * n; *(LAS f32x4*)(wst + row * 64 + (lane & 15) * 4) = *(const f32x4*)(W + (size_t)row * 384 + (lane & 15) * 4); }
                    asm volatile("" ::: "memory");
#pragma unroll
                    for (int j = 0; j < 4; ++j) { u32x4 pq;
#pragma unroll
                        for (int e = 0; e < 4; ++e) { const int k0 = 8 * fq + 2 * e; pq[e] = cvtpk(wst[k0 * 64 + 16 * j + fr], wst[(k0 + 1) * 64 + 16 * j + fr]); }
                        *(LAS u32x4*)(btab + (((arr * 4 + j) * 2 + ks) * 64 + lane) * 16) = pq; }
                    asm volatile("" ::: "memory");
                }
        }
        u32x4 pf[15];
#define PREP_FETCH(c_) do { const char* gb_ = (const char*)(ub + (m0 + (size_t)(c_) * CH - 1) * NPAD); \
            _Pragma("unroll") for (int sg = 0; sg < 5; ++sg) { const char* gs_ = gb_ + (sg < 3 ? (sg * 384 + h * 64) * 2 : (sg == 3 ? U_WLO * 2 : U_ALO * 2)); \
                _Pragma("unroll") for (int rg = 0; rg < 3; ++rg) { if (rg < 2 || rsub == 0) pf[sg * 3 + rg] = *(const u32x4*)(gs_ + (size_t)(rg * 8 * NPAD * 2) + goff); } } } while (0)
        asm volatile("s_waitcnt vmcnt(0) lgkmcnt(0)" ::: "memory");
        if (par == 0) st_flag(&flags[F_SETUP], 1u); else wait_ge(&flags[F_SETUP], 1u);
        const f32x4 pg4 = *(const f32x4*)(P->in[18] + (size_t)l * 384 + h * 64 + 4 * fr), pb4 = *(const f32x4*)(P->in[19] + (size_t)l * 384 + h * 64 + 4 * fr);
        bf16_t* obp = (bf16_t*)(P->ws + WS_OB);
#define POST_CHUNK(cl_) do { const unsigned cg_ = (unsigned)(cl_); \
            u32x2 gwv_[4]; \
            _Pragma("unroll") for (int i = 0; i < 4; ++i) gwv_[i] = *(const u32x2*)(ub + (m0 + (cl_) * CH + 4 * i + fq) * NPAD + U_GA + h * 64 + 4 * fr); \
            _Pragma("unroll") for (int j = 0; j < 4; ++j) wait_ge(&flags[F_CONS + j], cg_ + 1); \
            LAS const float* yb_ = (LAS const float*)(lds + SC_Y + par * YBUF_BYTES); \
            f32x4 yv_[4], bv_[4]; \
            _Pragma("unroll") for (int i = 0; i < 4; ++i) { const int tl_ = 4 * i + fq; yv_[i] = *(LAS const f32x4*)(yb_ + tl_ * 128 + 4 * fr); bv_[i] = *(LAS const f32x4*)(yb_ + tl_ * 128 + 64 + 4 * fr); } \
            st_flag(&flags[par ? F_POSTB : F_POST], (cg_ >> 1) + 1); \
            _Pragma("unroll") for (int i = 0; i < 4; ++i) { const size_t m_ = m0 + (cl_) * CH + 4 * i + fq; \
                const f32x4 y4_ = yv_[i]; \
                const float mean_ = red16((y4_[0] + y4_[1]) + (y4_[2] + y4_[3])) * (1.f / 64.f); \
                const f32x4 d_ = y4_ - mean_; \
                const float var_ = red16((d_[0] * d_[0] + d_[1] * d_[1]) + (d_[2] * d_[2] + d_[3] * d_[3])) * (1.f / 64.f); \
                const float rstd_ = __builtin_amdgcn_rsqf(var_ + GN_EPS); \
                f32x4 o_ = d_ * rstd_ * pg4 + pb4 + bv_[i]; \
                o_[0] *= siluf_(bflo(gwv_[i].x)); o_[1] *= siluf_(bfhi(gwv_[i].x)); o_[2] *= siluf_(bflo(gwv_[i].y)); o_[3] *= siluf_(bfhi(gwv_[i].y)); \
                u32x2 w_; w_.x = cvtpk(o_[0], o_[1]); w_.y = cvtpk(o_[2], o_[3]); \
                if (!(dbg & 256)) *(u32x2*)(obp + m_ * DM + h * 64 + 4 * fr) = w_; } } while (0)
        float cr_[8][4];
#pragma unroll
        for (int a_ = 0; a_ < 8; ++a_)
#pragma unroll
            for (int j = 0; j < 4; ++j) cr_[a_][j] = cst[a_ * 64 + 16 * j + fr];
        PREP_FETCH(par);
        for (int c = par; c < nch; c += 2) { cgl = (unsigned)c;
            const int t0 = c * CH;
            LAS unsigned char* raw = lds + par * RAWBUF;
#pragma unroll
            for (int sg = 0; sg < 5; ++sg)
#pragma unroll
                for (int rg = 0; rg < 3; ++rg) { if (rg < 2 || rsub == 0) *(LAS u32x4*)(raw + (sg * 3 + rg) * 1024 + lane * 16) = pf[sg * 3 + rg]; }
            if (t0 == 0 && rsub == 0) {
#pragma unroll
                for (int sg = 0; sg < 5; ++sg) {
                    u32x4 v = (u32x4){0u, 0u, 0u, 0u};
                    if (sample) { const int col_ = (sg < 3 ? sg * 384 + h * 64 : (sg == 3 ? U_WLO : U_ALO)) + c8 * 8;
                        const f32x4 a = *(const f32x4*)(sh0 + col_), bq = *(const f32x4*)(sh0 + col_ + 4); v.x = cvtpk(a[0], a[1]); v.y = cvtpk(a[2], a[3]); v.z = cvtpk(bq[0], bq[1]); v.w = cvtpk(bq[2], bq[3]); }
                    *(LAS u32x4*)(raw + sg * 3 * 1024 + c8 * 16) = v;
                }
            }
            asm volatile("" ::: "memory");
            if (c + 2 < nch) PREP_FETCH(c + 2);
            int zz = 0; asm volatile("" : "+v"(zz));
            LAS const float* cz = cst + zz;
            f32x4 Dw[4], Da[4];
            {
                bf16x8 Aw[2], Aa[2];
#pragma unroll
                for (int ks = 0; ks < 2; ++ks) {
                    const u32x4 cw = *(LAS const u32x4*)(raw + RAWOFF(fr + 1, 3, 32 * ks + 8 * fq)), pwv = *(LAS const u32x4*)(raw + RAWOFF(fr, 3, 32 * ks + 8 * fq));
                    const u32x4 ca = *(LAS const u32x4*)(raw + RAWOFF(fr + 1, 4, 32 * ks + 8 * fq)), pav = *(LAS const u32x4*)(raw + RAWOFF(fr, 4, 32 * ks + 8 * fq));
                    const f32x4 mw0 = *(LAS const f32x4*)(cz + 8 * 64 + 32 * ks + 8 * fq), mw1 = *(LAS const f32x4*)(cz + 8 * 64 + 32 * ks + 8 * fq + 4);
                    const f32x4 ma0 = *(LAS const f32x4*)(cz + 9 * 64 + 32 * ks + 8 * fq), ma1 = *(LAS const f32x4*)(cz + 9 * 64 + 32 * ks + 8 * fq + 4);
                    u32x4 pw, pa;
#pragma unroll
                    for (int e = 0; e < 4; ++e) {
                        const float c0 = bflo(cw[e]), c1 = bfhi(cw[e]), p0 = bflo(pwv[e]), p1 = bfhi(pwv[e]);
                        const float m0_ = (e < 2 ? mw0[2 * e] : mw1[2 * e - 4]), m1_ = (e < 2 ? mw0[2 * e + 1] : mw1[2 * e - 3]);
                        const float z0 = c0 + (p0 - c0) * m0_, z1 = c1 + (p1 - c1) * m1_;
                        const float t0_ = 1.f - 2.f * fast_rcp(1.f + fast_exp2(2.f * LOG2E * z0)), t1_ = 1.f - 2.f * fast_rcp(1.f + fast_exp2(2.f * LOG2E * z1));
                        pw[e] = cvtpk(t0_, t1_);
                        const float d0 = bflo(ca[e]), d1 = bfhi(ca[e]), q0 = bflo(pav[e]), q1 = bfhi(pav[e]);
                        const float n0_ = (e < 2 ? ma0[2 * e] : ma1[2 * e - 4]), n1_ = (e < 2 ? ma0[2 * e + 1] : ma1[2 * e - 3]);
                        pa[e] = cvtpk(d0 + (q0 - d0) * n0_, d1 + (q1 - d1) * n1_);
                    }
                    Aw[ks] = __builtin_bit_cast(bf16x8, pw); Aa[ks] = __builtin_bit_cast(bf16x8, pa);
                }
#pragma unroll
                for (int j = 0; j < 4; ++j) {
                    const f32x4 z = (f32x4){0.f, 0.f, 0.f, 0.f};
                    LAS const unsigned char* bt = btab + zz + lane * 16;
                    Dw[j] = MFMA16(Aw[0], *(LAS const bf16x8*)(bt + ((0 * 4 + j) * 2 + 0) * 1024), z); Dw[j] = MFMA16(Aw[1], *(LAS const bf16x8*)(bt + ((0 * 4 + j) * 2 + 1) * 1024), Dw[j]);
                    Da[j] = MFMA16(Aa[0], *(LAS const bf16x8*)(bt + ((1 * 4 + j) * 2 + 0) * 1024), z); Da[j] = MFMA16(Aa[1], *(LAS const bf16x8*)(bt + ((1 * 4 + j) * 2 + 1) * 1024), Da[j]);
                }
            }
            if (cgl >= 2) {
#pragma unroll
                for (int j = 0; j < 4; ++j) wait_ge(&flags[F_CONS + j], cgl - 1);
            }
            LAS float* opb = (LAS float*)(lds + SC_OP + (cgl & 1) * OPBUF_BYTES);
            LAS float* bon = (LAS float*)(lds + SC_BON + (cgl & 1) * 64);
            float lr_[4], lk_[4], lv_[4];
#pragma unroll
            for (int i = 0; i < 4; ++i) {
                const int tl = 4 * fq + i; LAS const unsigned char* rc = raw + RAWOFF(tl + 1, 0, fr); LAS const unsigned char* rp = raw + RAWOFF(tl, 0, fr);
#define RB(p_, sg_, j_) bf2f(*(LAS const bf16_t*)((p_) + (sg_) * 3072 + (j_) * 32))
                float rr[4], kk[4], vv[4], aa[4], ww[4], kn[4]; float ss = 0.f;
#pragma unroll
                for (int j = 0; j < 4; ++j) {
                    const float cr = RB(rc, 0, j), ck = RB(rc, 1, j), cv = RB(rc, 2, j);
                    const float pr = i == 0 ? RB(rp, 0, j) : lr_[j], pk = i == 0 ? RB(rp, 1, j) : lk_[j], pv_ = i == 0 ? RB(rp, 2, j) : lv_[j];
                    lr_[j] = cr; lk_[j] = ck; lv_[j] = cv;
                    rr[j] = cr + (pr - cr) * cr_[0][j]; kk[j] = ck + (pk - ck) * cr_[1][j]; vv[j] = cv + (pv_ - cv) * cr_[2][j];
                    const float x = cr_[3][j] + Dw[j][i];
                    const float sg = fast_rcp(1.f + fast_exp2(-LOG2E * x));
                    ww[j] = fast_exp2(-0.60653066f * LOG2E * sg);
                    aa[j] = fast_rcp(1.f + fast_exp2(-LOG2E * (cr_[4][j] + Da[j][i])));
                    kn[j] = kk[j] * cr_[5][j]; ss += kn[j] * kn[j];
                }
                ss = red16(ss);
                const float rn = __builtin_amdgcn_rsqf(ss + 1e-12f);
                float bs = 0.f; LAS float* o = opb + tl * OPTOK + fr;
#pragma unroll
                for (int j = 0; j < 4; ++j) {
                    const float knn = kn[j] * rn, kp = kk[j] * (1.f + (aa[j] - 1.f) * cr_[6][j]);
                    bs += rr[j] * kp * cr_[7][j];
                    o[16 * j] = ww[j]; o[64 + 16 * j] = knn; o[128 + 16 * j] = knn * aa[j]; o[192 + 16 * j] = kp; o[256 + 16 * j] = rr[j]; o[320 + 16 * j] = vv[j];
                }
                bs = red16(bs);
                if (fr == 0) bon[tl] = bs;
#undef RB
            }
            st_flag(&flags[par ? F_PRODB : F_PROD], (cgl >> 1) + 1);
            if (c >= 2) POST_CHUNK(c - 2);
        }
        POST_CHUNK(nch - 2 + par);
        wait_ge(&flags[par ? F_PROD : F_PRODB], (unsigned)(nch / 2));
#undef POST_CHUNK
#undef PREP_FETCH
    }
}

DI void prep_simple(PP P, int l, LAS unsigned char* lds, int lane, int seq0, int nseq, bool sample, int dbg) {
    LAS unsigned* flags = (LAS unsigned*)(lds + SC_FLAGS);
    LAS float* Wd = (LAS float*)lds; LAS float* Wa = Wd + 4096;
    LAS float* lor = (LAS float*)(lds + 4 * WK_STRIDE);
    const bf16_t* ub = (const bf16_t*)(P->ws + WS_UB);
    const float* mu = P->in[10] + (size_t)l * SHW;
    unsigned cgl = 0;
    const int nch = sample ? TSS / CH : TP / CH;
    for (int s = 0; s < nseq; ++s) {
        const int seq = seq0 + s, b = seq / 6, h = seq % 6;
        const int kc = h * 64 + lane;
        const float mur = mu[U_R + kc], muk = mu[U_K + kc], muv = mu[U_V + kc], muw = mu[U_WLO + lane], mua = mu[U_ALO + lane];
        const float w0c = P->in[11][(size_t)l * 384 + kc], a0c = P->in[13][(size_t)l * 384 + kc], kkc = P->in[15][(size_t)l * 384 + kc], kac = P->in[16][(size_t)l * 384 + kc], rkc = P->in[17][(size_t)l * 384 + kc];
        const size_t m0 = sample ? (size_t)MP + (size_t)b * TSS : (size_t)b * TP;
        const int T = sample ? TSS : TP;
        const float* sh0 = P->in[8] + (size_t)(l * 32 + b) * SHW;
        { const float* wd = P->in[12] + (size_t)l * 64 * 384 + kc; const float* wa = P->in[14] + (size_t)l * 64 * 384 + kc;
#pragma unroll 4
          for (int i = 0; i < 64; ++i) { Wd[i * 64 + lane] = wd[(size_t)i * 384]; Wa[i * 64 + lane] = wa[(size_t)i * 384]; } }
        float pr = sample ? sh0[U_R + kc] : 0.f, pk = sample ? sh0[U_K + kc] : 0.f, pv = sample ? sh0[U_V + kc] : 0.f, pwl = sample ? sh0[U_WLO + lane] : 0.f, pal = sample ? sh0[U_ALO + lane] : 0.f;
        const bf16_t* row = ub + m0 * NPAD;
        unsigned short n_r = row[U_R + kc], n_k = row[U_K + kc], n_v = row[U_V + kc], n_wl = row[U_WLO + lane], n_al = row[U_ALO + lane];
        for (int c = 0; c < nch; ++c, ++cgl) {
            if (cgl >= 2) {
#pragma unroll
                for (int j = 0; j < 4; ++j) wait_ge(&flags[F_CONS + j], cgl - 1);
            }
            LAS float* opb = (LAS float*)(lds + SC_OP + (cgl & 1) * OPBUF_BYTES);
            LAS float* bon = (LAS float*)(lds + SC_BON + (cgl & 1) * 64);
#pragma unroll 1
            for (int tl = 0; tl < CH; ++tl) {
                const int t = c * CH + tl;
                const float cr = bf2f(n_r), ck = bf2f(n_k), cv = bf2f(n_v), cwl = bf2f(n_wl), cal = bf2f(n_al);
                { const bf16_t* nrow = ub + (m0 + (t + 1 < T ? t + 1 : t)) * NPAD;
                  n_r = nrow[U_R + kc]; n_k = nrow[U_K + kc]; n_v = nrow[U_V + kc]; n_wl = nrow[U_WLO + lane]; n_al = nrow[U_ALO + lane]; }
                const float r = cr + (pr - cr) * mur, k = ck + (pk - ck) * muk, v = cv + (pv - cv) * muv, zw = cwl + (pwl - cwl) * muw, za = cal + (pal - cal) * mua;
                pr = cr; pk = ck; pv = cv; pwl = cwl; pal = cal;
                lor[lane] = 1.f - 2.f * fast_rcp(1.f + fast_exp2(2.f * LOG2E * zw)); lor[64 + lane] = za;
                float dw = 0.f, da = 0.f;
#pragma unroll 2
                for (int i = 0; i < 64; i += 4) { const f32x4 tw = *(LAS const f32x4*)(lor + i), ta = *(LAS const f32x4*)(lor + 64 + i);
#pragma unroll
                    for (int e = 0; e < 4; ++e) { dw += tw[e] * Wd[(i + e) * 64 + lane]; da += ta[e] * Wa[(i + e) * 64 + lane]; } }
                const float x = w0c + dw;
                const float sg = fast_rcp(1.f + fast_exp2(-LOG2E * x));
                const float w = fast_exp2(-0.60653066f * LOG2E * sg);
                const float a = fast_rcp(1.f + fast_exp2(-LOG2E * (a0c + da)));
                const float kn = k * kkc; const float ss = wave_sum(kn * kn);
                const float knn = kn * (1.f / sqrtf(ss + 1e-12f));
                const float kp = k * (1.f + (a - 1.f) * kac);
                const float bs = wave_sum(r * kp * rkc);
                LAS float* o = opb + tl * OPTOK + lane;
                o[0] = w; o[64] = knn; o[128] = knn * a; o[192] = kp; o[256] = r; o[320] = v;
                if (lane == 0) bon[tl] = bs;
            }
            st_flag(&flags[F_PROD], cgl + 1);
        }
    }
}

DI void post_wave(PP P, int l, LAS unsigned char* lds, int lane, int seq0, int nseq, bool sample, int dbg) {
    const int r16 = lane & 15, tq = lane >> 4;
    LAS unsigned* flags = (LAS unsigned*)(lds + SC_FLAGS);
    const bf16_t* ub = (const bf16_t*)(P->ws + WS_UB); bf16_t* ob = (bf16_t*)(P->ws + WS_OB);
    unsigned cgl = 0;
    const int nch = sample ? TSS / CH : TP / CH;
    for (int s = 0; s < nseq; ++s) {
        const int seq = seq0 + s, b = seq / 6, h = seq % 6;
        const size_t m0 = sample ? (size_t)MP + (size_t)b * TSS : (size_t)b * TP;
        const f32x4 g4 = *(const f32x4*)(P->in[18] + (size_t)l * 384 + h * 64 + 4 * r16), b4 = *(const f32x4*)(P->in[19] + (size_t)l * 384 + h * 64 + 4 * r16);
        for (int c = 0; c < nch; ++c, ++cgl) {
            if (dbg & 1) { for (int j = 0; j < 4; ++j) wait_ge(&flags[F_CONS + j], cgl + 1); st_flag(&flags[F_POST], cgl + 1); continue; }
            u32x2 gwv[4];
#pragma unroll
            for (int i = 0; i < 4; ++i) gwv[i] = *(const u32x2*)(ub + (m0 + c * CH + 4 * i + tq) * NPAD + U_GA + h * 64 + 4 * r16);
#pragma unroll
            for (int j = 0; j < 4; ++j) wait_ge(&flags[F_CONS + j], cgl + 1);
            LAS const float* yb = (LAS const float*)(lds + SC_Y + (cgl & 1) * YBUF_BYTES);
#pragma unroll
            for (int i = 0; i < 4; ++i) {
                const int tl = 4 * i + tq; const size_t m = m0 + c * CH + tl;
                const f32x4 y4 = *(LAS const f32x4*)(yb + tl * 128 + 4 * r16), bv4 = *(LAS const f32x4*)(yb + tl * 128 + 64 + 4 * r16);
                const u32x2 gw = gwv[i];
                const float mean = red16((y4[0] + y4[1]) + (y4[2] + y4[3])) * (1.f / 64.f);
                const f32x4 d = y4 - mean;
                const float var = red16((d[0] * d[0] + d[1] * d[1]) + (d[2] * d[2] + d[3] * d[3])) * (1.f / 64.f);
                const float rstd = 1.f / sqrtf(var + GN_EPS);
                f32x4 o = d * rstd * g4 + b4 + bv4;
                o[0] *= siluf_(bflo(gw.x)); o[1] *= siluf_(bfhi(gw.x)); o[2] *= siluf_(bflo(gw.y)); o[3] *= siluf_(bfhi(gw.y));
                u32x2 w; w.x = cvtpk(o[0], o[1]); w.y = cvtpk(o[2], o[3]);
                if (!(dbg & 256)) *(u32x2*)(ob + m * DM + h * 64 + 4 * r16) = w;
            }
            st_flag(&flags[F_POST], cgl + 1);
        }
    }
}

DI void naive_seq(PP P, int l, LAS unsigned char* sl, int lane, int b, int h, bool sample) {
    LAS float* opl = (LAS float*)sl;
    LAS float* lor = opl + 384;
    const bf16_t* ub = (const bf16_t*)(P->ws + WS_UB); bf16_t* ob = (bf16_t*)(P->ws + WS_OB);
    const float* mu = P->in[10] + (size_t)l * SHW;
    const int kc = h * 64 + lane;
    const float mur = mu[U_R + kc], muk = mu[U_K + kc], muv = mu[U_V + kc], muw = mu[U_WLO + lane], mua = mu[U_ALO + lane];
    const float w0c = P->in[11][(size_t)l * 384 + kc], a0c = P->in[13][(size_t)l * 384 + kc], kkc = P->in[15][(size_t)l * 384 + kc], kac = P->in[16][(size_t)l * 384 + kc], rkc = P->in[17][(size_t)l * 384 + kc];
    const float gng = P->in[18][(size_t)l * 384 + kc], gnb = P->in[19][(size_t)l * 384 + kc];
    const size_t m0 = sample ? (size_t)MP + (size_t)b * TSS : (size_t)b * TP;
    const int T = sample ? TSS : TP;
    const float* sh0 = P->in[8] + (size_t)(l * 32 + b) * SHW;
    LAS float* Wd = opl + 512; LAS float* Wa = Wd + 4096;
    { const float* wd = P->in[12] + (size_t)l * 64 * 384 + kc; const float* wa = P->in[14] + (size_t)l * 64 * 384 + kc;
#pragma unroll 4
      for (int i = 0; i < 64; ++i) { Wd[i * 64 + lane] = wd[(size_t)i * 384]; Wa[i * 64 + lane] = wa[(size_t)i * 384]; } }
    float S[64];
    if (sample) { const float* sp = P->in[7] + ((size_t)((l * 32 + b) * 6 + h) * 64 + lane) * 64;
#pragma unroll
        for (int k = 0; k < 64; ++k) S[k] = sp[k]; }
    else {
#pragma unroll
        for (int k = 0; k < 64; ++k) S[k] = 0.f; }
    float pr = sample ? sh0[U_R + kc] : 0.f, pk = sample ? sh0[U_K + kc] : 0.f, pv = sample ? sh0[U_V + kc] : 0.f, pwl = sample ? sh0[U_WLO + lane] : 0.f, pal = sample ? sh0[U_ALO + lane] : 0.f;
    const bf16_t* row = ub + m0 * NPAD;
    unsigned short n_r = row[U_R + kc], n_k = row[U_K + kc], n_v = row[U_V + kc], n_wl = row[U_WLO + lane], n_al = row[U_ALO + lane], n_g = row[U_GA + kc];
#pragma unroll 1
    for (int t = 0; t < T; ++t) {
        const float cr = bf2f(n_r), ck = bf2f(n_k), cv = bf2f(n_v), cwl = bf2f(n_wl), cal = bf2f(n_al), cg = bf2f(n_g);
        { const bf16_t* nrow = ub + (m0 + (t + 1 < T ? t + 1 : t)) * NPAD;
          n_r = nrow[U_R + kc]; n_k = nrow[U_K + kc]; n_v = nrow[U_V + kc]; n_wl = nrow[U_WLO + lane]; n_al = nrow[U_ALO + lane]; n_g = nrow[U_GA + kc]; }
        const float r = cr + (pr - cr) * mur, k = ck + (pk - ck) * muk, v = cv + (pv - cv) * muv, zw = cwl + (pwl - cwl) * muw, za = cal + (pal - cal) * mua;
        pr = cr; pk = ck; pv = cv; pwl = cwl; pal = cal;
        lor[lane] = tanhf(zw); lor[64 + lane] = za;
        float dw = 0.f, da = 0.f;
#pragma unroll 1
        for (int i = 0; i < 64; i += 4) { const f32x4 tw = *(LAS const f32x4*)(lor + i), ta = *(LAS const f32x4*)(lor + 64 + i);
#pragma unroll
            for (int e = 0; e < 4; ++e) { dw += tw[e] * Wd[(i + e) * 64 + lane]; da += ta[e] * Wa[(i + e) * 64 + lane]; } }
        const float x = w0c + dw;
        const float wlog = -log1pf(expf(-x)) - 0.5f;
        const float w = expf(-expf(wlog));
        const float a = 1.f / (1.f + expf(-(a0c + da)));
        const float kn = k * kkc; const float ss = wave_sum(kn * kn);
        const float knn = kn * (1.f / sqrtf(ss + 1e-12f));
        const float kp = k * (1.f + (a - 1.f) * kac);
        const float bs = wave_sum(r * kp * rkc);
        opl[lane] = w; opl[64 + lane] = knn; opl[128 + lane] = knn * a; opl[192 + lane] = kp; opl[256 + lane] = r; opl[320 + lane] = v;
        const float vv = v;
        float sa = 0.f;
#pragma unroll
        for (int i = 0; i < 64; i += 4) { const f32x4 q = *(LAS const f32x4*)(opl + 64 + i);
#pragma unroll
            for (int e = 0; e < 4; ++e) sa += S[i + e] * q[e]; }
        float y = 0.f;
#pragma unroll
        for (int i = 0; i < 64; i += 4) { const f32x4 qw = *(LAS const f32x4*)(opl + i), qa = *(LAS const f32x4*)(opl + 128 + i), qk = *(LAS const f32x4*)(opl + 192 + i), qr = *(LAS const f32x4*)(opl + 256 + i);
#pragma unroll
            for (int e = 0; e < 4; ++e) { S[i + e] = S[i + e] * qw[e] - sa * qa[e] + vv * qk[e]; y += S[i + e] * qr[e]; } }
        const float mean = wave_sum(y) * (1.f / 64.f); const float d = y - mean;
        const float var = wave_sum(d * d) * (1.f / 64.f);
        float o = d * (1.f / sqrtf(var + GN_EPS)) * gng + gnb + bs * vv;
        o *= cg / (1.f + expf(-cg));
        ob[(m0 + t) * DM + kc] = (bf16_t)(cvtpk(o, o) & 0xffffu);
        asm volatile("" ::: "memory");
    }
    float* so = P->out + (sample ? O_SWKV : O_PWKV) + ((size_t)((l * 32 + b) * 6 + h) * 64 + lane) * 64;
#pragma unroll
    for (int k = 0; k < 64; k += 4) *(f32x4*)(so + k) = (f32x4){S[k], S[k + 1], S[k + 2], S[k + 3]};
}

DI bf16x8 ld_bf16x8(const bf16_t* p) { return *(const bf16x8*)p; }
DI bf16x8 cvt_f32x8(const float* p) { const f32x4 a = *(const f32x4*)p, b = *(const f32x4*)(p + 4); u32x4 w; w.x = cvtpk(a[0], a[1]); w.y = cvtpk(a[2], a[3]); w.z = cvtpk(b[0], b[1]); w.w = cvtpk(b[2], b[3]); return __builtin_bit_cast(bf16x8, w); }
DI bf16x8 pack8(const f32x16& x, int s) { u32x4 w; w.x = cvtpk(x[8 * s], x[8 * s + 1]); w.y = cvtpk(x[8 * s + 2], x[8 * s + 3]); w.z = cvtpk(x[8 * s + 4], x[8 * s + 5]); w.w = cvtpk(x[8 * s + 6], x[8 * s + 7]); return __builtin_bit_cast(bf16x8, w); }
DI bf16x8 vfrag(LAS const unsigned char* p) {
    const v4i16_t lo = __builtin_amdgcn_ds_read_tr16_b64_v4i16((LAS v4i16_t*)p), hi = __builtin_amdgcn_ds_read_tr16_b64_v4i16((LAS v4i16_t*)(p + 512));
    return (bf16x8){lo[0], lo[1], lo[2], lo[3], hi[0], hi[1], hi[2], hi[3]};
}

struct AttnState { f32x16 o0, o1; float m_run, l_run, carry; };

template <int KIND, bool F32>
DI void attn_tile(AttnState& st, const bf16x8 (&qr)[4], bf16x8 (&kf)[4], f32x4 (&kq)[8], bf16x8 (&vr)[4], f32x4 (&vq)[8], const char* knext, const char* vnext, unsigned vpitch16, float lf, bool diag, LAS unsigned char* wl, int lane) {
    const int r32 = lane & 31, hi = lane >> 5;
    LAS float* sm = (LAS float*)(wl + 8192);
#pragma unroll
    for (int pc = 0; pc < 4; ++pc) {
        if (F32) { u32x4 x; x.x = cvtpk(vq[2 * pc][0], vq[2 * pc][1]); x.y = cvtpk(vq[2 * pc][2], vq[2 * pc][3]); x.z = cvtpk(vq[2 * pc + 1][0], vq[2 * pc + 1][1]); x.w = cvtpk(vq[2 * pc + 1][2], vq[2 * pc + 1][3]);
            *(LAS u32x4*)(wl + pc * 1024 + lane * 16) = x; }
        else *(LAS bf16x8*)(wl + pc * 1024 + lane * 16) = vr[pc];
    }
#pragma unroll
    for (int pc = 0; pc < 4; ++pc) {
        if (F32) { const char* p_ = vnext + (size_t)((pc & 1) * vpitch16 + (pc >> 1) * 128); vq[2 * pc] = *(const f32x4*)p_; vq[2 * pc + 1] = *(const f32x4*)(p_ + 16); }
        else vr[pc] = *(const bf16x8*)(vnext + pc * 1024);
    }
    if (F32) {
#pragma unroll
        for (int i = 0; i < 4; ++i) { u32x4 w; w.x = cvtpk(kq[2 * i][0], kq[2 * i][1]); w.y = cvtpk(kq[2 * i][2], kq[2 * i][3]); w.z = cvtpk(kq[2 * i + 1][0], kq[2 * i + 1][1]); w.w = cvtpk(kq[2 * i + 1][2], kq[2 * i + 1][3]);
            kf[i] = __builtin_bit_cast(bf16x8, w); }
    }
    f32x16 p = {};
#pragma unroll
    for (int d0 = 0; d0 < 4; ++d0) p = MFMA32(kf[d0], qr[d0], p);
    asm volatile("" : "+v"(p));
    if (F32) {
#pragma unroll
        for (int d0 = 0; d0 < 4; ++d0) { kq[2 * d0] = *(const f32x4*)(knext + 64 * d0); kq[2 * d0 + 1] = *(const f32x4*)(knext + 64 * d0 + 16); }
    } else {
#pragma unroll
        for (int d0 = 0; d0 < 4; ++d0) kf[d0] = *(const bf16x8*)(knext + d0 * 1024);
    }
    if (KIND == 0) {
        float incl = lf;
#pragma unroll
        for (int off = 1; off < 32; off <<= 1) { const float t = __shfl_down(incl, off, 32); if (r32 + off < 32) incl += t; }
        const float bias = (st.carry + (incl - lf)) * LOG2E;
        const float tot = __shfl(incl, 0, 32);
        if (hi == 0) sm[r32] = bias;
        st.carry += tot;
        float s[16];
#pragma unroll
        for (int g = 0; g < 4; ++g) { const f32x4 b4 = *(LAS const f32x4*)(sm + 8 * g + 4 * hi);
#pragma unroll
            for (int e = 0; e < 4; ++e) s[4 * g + e] = p[4 * g + e] * QSCALE2 + b4[e]; }
        if (diag) {
#pragma unroll
            for (int r = 0; r < 16; ++r) if (crow(r, hi) > r32) s[r] = -1e30f;
        }
        if (diag) {
            float mt = s[0];
#pragma unroll
            for (int r = 1; r < 16; ++r) mt = fmaxf(mt, s[r]);
            { auto rr = __builtin_amdgcn_permlane32_swap(__float_as_uint(mt), __float_as_uint(mt), false, false); mt = fmaxf(__uint_as_float(rr[0]), __uint_as_float(rr[1])); }
            st.m_run = mt;
        }
        float ls = 0.f;
#pragma unroll
        for (int r = 0; r < 16; ++r) { p[r] = fast_exp2(s[r] - st.m_run); ls += p[r]; }
        st.l_run += ls;
    } else {
        float be[16], om[16];
#pragma unroll
        for (int r = 0; r < 16; ++r) {
            const float z2 = fmaxf(p[r] * QSCALE2, -80.f);
            const float e = fast_exp2(-z2); const float bt = fast_rcp(1.f + e);
            be[r] = bt; om[r] = e * bt;
        }
        if (diag) {
#pragma unroll
            for (int r = 0; r < 16; ++r) if (crow(r, hi) >= r32) { be[r] = 0.f; om[r] = 1.f; }
        }
        float H[4], oth[4];
#pragma unroll
        for (int g = 0; g < 4; ++g) { const float gp = (om[4 * g] * om[4 * g + 1]) * (om[4 * g + 2] * om[4 * g + 3]);
            auto rr = __builtin_amdgcn_permlane32_swap(__float_as_uint(gp), __float_as_uint(gp), false, false);
            const float a = __uint_as_float(rr[0]), b = __uint_as_float(rr[1]); H[g] = a * b; oth[g] = hi ? 1.f : b; }
        float suf[4]; suf[3] = 1.f; suf[2] = H[3]; suf[1] = H[3] * H[2]; suf[0] = suf[1] * H[1];
        const float cin = st.carry;
#pragma unroll
        for (int g = 0; g < 4; ++g) {
            float A = cin * suf[g] * oth[g];
            p[4 * g + 3] = be[4 * g + 3] * A; A *= om[4 * g + 3];
            p[4 * g + 2] = be[4 * g + 2] * A; A *= om[4 * g + 2];
            p[4 * g + 1] = be[4 * g + 1] * A; A *= om[4 * g + 1];
            p[4 * g + 0] = be[4 * g + 0] * A;
        }
        st.carry = cin * suf[0] * H[0];
    }
    const bf16x8 pa0 = pack8(p, 0), pa1 = pack8(p, 1);
    LAS const unsigned char* vb = wl + ((lane >> 4) & 1) * 32 + (lane & 3) * 8 + (4 * hi + ((lane & 15) >> 2)) * 64;
    st.o0 = MFMA32(pa0, vfrag(vb + 0 * 1024), st.o0);
    st.o0 = MFMA32(pa1, vfrag(vb + 1 * 1024), st.o0);
    st.o1 = MFMA32(pa0, vfrag(vb + 2 * 1024), st.o1);
    st.o1 = MFMA32(pa1, vfrag(vb + 3 * 1024), st.o1);
    if (F32) {
#pragma unroll
        for (int i = 0; i < 8; ++i) { asm volatile("" : "+v"(kq[i])); asm volatile("" : "+v"(vq[i])); }
    } else {
#pragma unroll
        for (int i = 0; i < 4; ++i) { asm volatile("" : "+v"(kf[i])); asm volatile("" : "+v"(vr[i])); }
    }
}

template <int KIND>
DI void attn_item(PP P, int l, LAS unsigned char* wl, int lane, bool sample, int b, int h, int qb) {
    const int r32 = lane & 31, hi = lane >> 5;
    const char* ubb = (const char*)(P->ws + WS_UB);
    constexpr unsigned PITCH = NPAD * 2;
    constexpr int NH = KIND == 0 ? NHB : NHC;
    constexpr int QC = KIND == 0 ? U_QB : U_QC, KC = KIND == 0 ? U_KB : U_KC, VC = KIND == 0 ? U_VB : U_VC, GC = KIND == 0 ? U_GB : U_GC, OC = KIND == 0 ? 384 : 768;
    const int q0 = qb * 32, past = sample ? PAST : 0;
    const unsigned row0 = sample ? (unsigned)(MP + b * TSS) : (unsigned)(b * TP);
    const unsigned kl = (unsigned)(r32 * NPAD + KC + h * 64 + 8 * hi) * 2u;
    const unsigned vl = (unsigned)((lane >> 2) * NPAD + VC + h * 64 + (lane & 3) * 8) * 2u;
    bf16x8 qr[4];
    { const char* qp = ubb + (size_t)((row0 + q0) * PITCH + (unsigned)(r32 * NPAD + QC + h * 64 + 8 * hi) * 2u);
#pragma unroll
      for (int d0 = 0; d0 < 4; ++d0) qr[d0] = *(const bf16x8*)(qp + 32 * d0); }
    AttnState st; st.o0 = f32x16{}; st.o1 = f32x16{}; st.m_run = -1e30f; st.l_run = 0.f; st.carry = KIND == 0 ? 0.f : 1.f;
    const int tdiag = (past + q0) / 32, tnew0 = past / 32;
    const float* logf = (const float*)(P->ws + WS_LOGF) + h;
    bf16x8 kf[4], vr[4]; f32x4 kq[8], vq[8];
    {
        const unsigned tix0 = sample ? (unsigned)(32 * NH * 64 + (b * NH + h) * 2) : (unsigned)((b * NH + h) * 64);
        const char* kbb = (const char*)(P->ws + (KIND == 0 ? WS_BFK : WS_BSK)) + (size_t)tix0 * 4096 + lane * 16;
        const char* vbb = (const char*)(P->ws + (KIND == 0 ? WS_BFV : WS_BSV)) + (size_t)tix0 * 4096 + lane * 16;
        float lf = 0.f;
        { const unsigned tl_ = (unsigned)(tdiag - tnew0); const unsigned trow_ = row0 + tl_ * 32u;
#pragma unroll
          for (int d0 = 0; d0 < 4; ++d0) kf[d0] = *(const bf16x8*)(kbb + (size_t)(tl_ * 4096u) + d0 * 1024);
#pragma unroll
          for (int pc = 0; pc < 4; ++pc) vr[pc] = *(const bf16x8*)(vbb + (size_t)(tl_ * 4096u) + pc * 1024);
          if (KIND == 0) lf = logf[(size_t)(trow_ + r32) * 8]; }
        for (int tile = tdiag; tile >= tnew0; --tile) {
            const unsigned tn = (unsigned)((tile > tnew0 ? tile - 1 : tnew0) - tnew0);
            const unsigned trow_ = row0 + tn * 32u;
            const float lfc = lf;
            if (KIND == 0) lf = logf[(size_t)(trow_ + r32) * 8];
            attn_tile<KIND, false>(st, qr, kf, kq, vr, vq, kbb + (size_t)(tn * 4096u), vbb + (size_t)(tn * 4096u), 0u, lfc, tile == tdiag, wl, lane);
        }
    }
    if (sample) {
        const char* cK = (const char*)(P->in[KIND == 0 ? 2 : 5] + (size_t)(l * 32 + b) * PAST * NH * 64 + h * 64);
        const char* cV = (const char*)(P->in[KIND == 0 ? 3 : 6] + (size_t)(l * 32 + b) * PAST * NH * 64 + h * 64);
        const float* cL = P->in[4] + (size_t)(l * 32 + b) * PAST * 6 + h;
        constexpr unsigned CP = NH * 64 * 4;
        const unsigned klc = (unsigned)r32 * CP + 32u * hi, vlc = (unsigned)(lane >> 2) * CP + 32u * (lane & 3);
        float lf = 0.f;
        { const char* kb_ = cK + (size_t)((unsigned)(tnew0 - 1) * 32u * CP) + klc;
#pragma unroll
          for (int d0 = 0; d0 < 4; ++d0) { kq[2 * d0] = *(const f32x4*)(kb_ + 64 * d0); kq[2 * d0 + 1] = *(const f32x4*)(kb_ + 64 * d0 + 16); }
          const char* vb_ = cV + (size_t)((unsigned)(tnew0 - 1) * 32u * CP) + vlc;
#pragma unroll
          for (int pc = 0; pc < 4; ++pc) { const char* p_ = vb_ + (size_t)((pc & 1) * (16u * CP) + (pc >> 1) * 128); vq[2 * pc] = *(const f32x4*)p_; vq[2 * pc + 1] = *(const f32x4*)(p_ + 16); }
          if (KIND == 0) lf = cL[(size_t)((tnew0 - 1) * 32 + r32) * 6]; }
        for (int tile = tnew0 - 1; tile >= 0; --tile) {
            const int tn = tile > 0 ? tile - 1 : 0;
            const float lfc = lf;
            if (KIND == 0) lf = cL[(size_t)(tn * 32 + r32) * 6];
            attn_tile<KIND, true>(st, qr, kf, kq, vr, vq, cK + (size_t)((unsigned)tn * 32u * CP) + klc, cV + (size_t)((unsigned)tn * 32u * CP) + vlc, 16u * CP, lfc, false, wl, lane);
        }
    }
    LAS float* stg = (LAS float*)wl; LAS float* sm = (LAS float*)(wl + 8192);
    if (KIND == 0) {
        auto rr = __builtin_amdgcn_permlane32_swap(__float_as_uint(st.l_run), __float_as_uint(st.l_run), false, false);
        const float lt = __uint_as_float(rr[0]) + __uint_as_float(rr[1]);
        if (hi == 0) sm[r32] = 1.f / lt;
    }
#pragma unroll
    for (int r = 0; r < 16; ++r) { stg[crow(r, hi) * 64 + r32] = st.o0[r]; stg[crow(r, hi) * 64 + 32 + r32] = st.o1[r]; }
    char* obb = (char*)(P->ws + WS_OB);
#pragma unroll
    for (int i = 0; i < 4; ++i) {
        const int row = i * 8 + (lane >> 3), chn = lane & 7;
        const f32x4 a = *(LAS const f32x4*)(stg + row * 64 + chn * 8), c = *(LAS const f32x4*)(stg + row * 64 + chn * 8 + 4);
        const float li = KIND == 0 ? sm[row] : 1.f;
        const unsigned m = row0 + q0 + row;
        const u32x4 g = *(const u32x4*)(ubb + (size_t)(m * PITCH + (unsigned)(GC + h * 64 + chn * 8) * 2u));
        u32x4 w;
        w.x = cvtpk(a[0] * li * siluf_(bflo(g.x)), a[1] * li * siluf_(bfhi(g.x))); w.y = cvtpk(a[2] * li * siluf_(bflo(g.y)), a[3] * li * siluf_(bfhi(g.y)));
        w.z = cvtpk(c[0] * li * siluf_(bflo(g.z)), c[1] * li * siluf_(bfhi(g.z))); w.w = cvtpk(c[2] * li * siluf_(bflo(g.w)), c[3] * li * siluf_(bfhi(g.w)));
        *(u32x4*)(obb + (size_t)(m * (DM * 2) + (unsigned)(OC + h * 64 + chn * 8) * 2u)) = w;
    }
}

constexpr int Q_SAMPLE = 2 * (16 + 24), Q_ITEMS = Q_SAMPLE + 40 * 64;
DI unsigned xcc_id() { return (unsigned)__builtin_amdgcn_s_getreg((3 << 11) | 20) & 7u; }
DI void worker_loop(PP P, int l, int lq, LAS unsigned char* lds, int wave, int lane) {
    LAS unsigned char* wl = lds + wave * WK_STRIDE;
    unsigned* qbase = (unsigned*)(P->ws + WS_CTL) + 64 + lq * 128;
    const unsigned x0 = xcc_id();
    for (unsigned sx = 0; sx < 8; ++sx) {
        const unsigned x = (x0 + sx) & 7u;
        unsigned* qctr = qbase + x * 16;
        for (;;) {
            unsigned idx = 0;
            if (lane == 0) idx = atomicAdd(qctr, 1u);
            idx = (unsigned)__builtin_amdgcn_readfirstlane((int)idx);
            if (idx >= (unsigned)Q_ITEMS) break;
            int kind, smp, bh, qb;
            if (idx < (unsigned)Q_SAMPLE) {
                smp = 1;
                if (idx < 32u) { kind = 1; bh = (int)x + 8 * (int)(idx >> 1); qb = idx & 1; }
                else { const int i2 = idx - 32; kind = 0; bh = (int)x + 8 * (i2 >> 1); qb = i2 & 1; }
            } else {
                smp = 0;
                const int i2 = idx - Q_SAMPLE, g = i2 >> 6; qb = 63 - (i2 & 63);
                if (g < 16) { kind = 1; bh = (int)x + 8 * g; } else { kind = 0; bh = (int)x + 8 * (g - 16); }
            }
            if (kind) attn_item<1>(P, l, wl, lane, smp != 0, bh / NHC, bh % NHC, qb);
            else attn_item<0>(P, l, wl, lane, smp != 0, bh / NHB, bh % NHB, qb);
        }
    }
}

DI void phase_mix(PP P, int lq, LAS unsigned char* lds, int wave, int lane, int bidx, int gdim) {
    const int l = lq & 1; const int dbg = (lq & 2) ? (P->dbg | 256) : 0;
    if (wave == 0 && lane < 16) ((LAS unsigned*)(lds + SC_FLAGS))[lane] = 0u;
    __syncthreads();
    const int bx = bidx;
#ifdef NAIVE_SCAN
    if (wave == 0) {
        for (int sq = bx; sq < 384; sq += gdim) {
            if (sq < 192) naive_seq(P, l, lds + SC_OFF, lane, sq / 6, sq % 6, false);
            else naive_seq(P, l, lds + SC_OFF, lane, (sq - 192) / 6, (sq - 192) % 6, true);
        }
    }
#else
    if (gdim >= 256 && !(dbg & 16)) {
        if (bx < 192) {
#ifndef SK_SCAN
            if (wave < 4) scan_wave(P, l, lds, wave, lane, bx, 1, false, dbg, true);
#endif
#ifndef SK_PREP
            if (wave == 4 || wave == 5) helper2_wave(P, l, lds, lane, bx, wave - 4, dbg);
#endif
        } else if (bx < 256) {
            const int s0 = (bx - 192) * 3;
#ifndef SK_SCAN
            if (wave < 4) scan_wave(P, l, lds, wave, lane, s0, 3, true, dbg);
#endif
#ifndef SK_PREP
            if (wave == 4) PREPFN(P, l, lds, lane, s0, 3, true, dbg);
#endif
#ifndef SK_POST
            if (wave == 5) post_wave(P, l, lds, lane, s0, 3, true, dbg);
#endif
        }
    }
#endif
#ifndef SK_WORK
    if (!(dbg & 4)) worker_loop(P, l, lq, lds, wave, lane);
#endif
}

__global__ void __launch_bounds__(512, 2) fwd_kernel(Params Pv) {
    extern __shared__ __attribute__((aligned(16))) unsigned char lds_raw[];
    LAS unsigned char* lds = (LAS unsigned char*)lds_raw;
    const int tid = threadIdx.x, lane0 = tid & 63, wave0 = __builtin_amdgcn_readfirstlane(tid >> 6);
    PP P0 = (PP)__builtin_amdgcn_kernarg_segment_ptr();
    const int lo = Pv.ph_lo, hi = Pv.ph_hi;
    const int rep_ph = Pv.rep_ph;
#pragma unroll 1
    for (int ph2 = lo * 2; ph2 < hi * 2; ++ph2) {
        const int ph = ph2 >> 1, rep = ph2 & 1;
        if (rep && ph != rep_ph) continue;
        PP P = pp_launder(P0);
        int lane = lane0, wave = wave0, bidx = (int)blockIdx.x, gdim = (int)gridDim.x;
        asm volatile("" : "+v"(lane)); asm volatile("" : "+s"(wave)); asm volatile("" : "+s"(bidx)); asm volatile("" : "+s"(gdim));
        if (ph == 0) {
#ifndef SK_P0
            phase0(P, lds, wave, lane, bidx, gdim);
#endif
        } else {
            const int l = (ph - 1) >> 2, k = (ph - 1) & 3;
            if (k == 0 || k == 2) {
#ifndef SK_G1
                pg8::Gemm g; pg8::StaticOrder S; EpiU E;
                E.ws = P->ws; E.out = P->out; E.fb = P->in[20] + l * 6; E.l = l; E.mode = k;
                if (k == 0) { g = pg8::Gemm{(const bf16_t*)(P->ws + WS_XB), (const bf16_t*)(P->ws + WS_WIN) + (size_t)l * NPAD * DM, MT, NPAD, DM}; S.init(MT, NPAD, gdim, bidx); }
                else { g = pg8::Gemm{(const bf16_t*)(P->ws + WS_OB), (const bf16_t*)(P->ws + WS_WOUT) + (size_t)l * DM * DM, MT, DM, DM}; S.init(MT, DM, gdim, bidx); }
                pg8::gemm_phase<EpiU, pg8::StaticOrder, true, true>(lds, g, S, E);
#endif
            } else if (k == 1) {
#ifndef SK_MIX
                phase_mix(P, l + 2 * rep, lds, wave, lane, bidx, gdim);
#endif
            } else {
#ifndef SK_LN
                phase_ln(P, l, wave, lane, bidx, gdim);
#endif
            }
        }
        if (ph2 + 1 < hi * 2) cg::this_grid().sync();
    }
}

extern "C" void kernel_launch(void* const* d_in, const int* in_sizes, int n_in, void* d_out, int out_size, void* d_ws, size_t ws_size, hipStream_t stream) {
    static int grid = 0;
    if (grid == 0) {
        if (n_in != 24 || (size_t)out_size != O_END || ws_size < WS_END) { fprintf(stderr, "kernel_launch: unexpected shapes n_in %d out %d ws %zu\n", n_in, out_size, ws_size); grid = -1; return; }
        int dev = 0, cus = 0, per_cu = 0;
        (void)hipGetDevice(&dev); (void)hipDeviceGetAttribute(&cus, hipDeviceAttributeMultiprocessorCount, dev);
        if (hipFuncSetAttribute((const void*)fwd_kernel, hipFuncAttributeMaxDynamicSharedMemorySize, LDS_BYTES) != hipSuccess) { fprintf(stderr, "kernel_launch: hipFuncSetAttribute failed\n"); grid = -1; return; }
        if (hipOccupancyMaxActiveBlocksPerMultiprocessor(&per_cu, (const void*)fwd_kernel, 512, LDS_BYTES) != hipSuccess || per_cu < 1) { fprintf(stderr, "kernel_launch: occupancy query says %d\n", per_cu); per_cu = 1; }
        (void)hipGetLastError();
        grid = cus * 1;
        if (grid != 256) fprintf(stderr, "kernel_launch: grid %d (expected 256)\n", grid);
    }
    if (grid < 0) return;
    (void)hipMemsetAsync((char*)d_ws + WS_CTL, 0, CTL_BYTES, stream);
    Params p{};
    for (int i = 0; i < 24; ++i) p.in[i] = (const float*)d_in[i];
    p.out = (float*)d_out; p.ws = (unsigned char*)d_ws; p.ph_lo = 0; p.ph_hi = 9; p.rep_ph = -1; p.dbg = 0;
    void* args[] = {&p};
    hipError_t e = hipLaunchCooperativeKernel((const void*)fwd_kernel, dim3(grid), dim3(512), args, LDS_BYTES, stream);
    if (e != hipSuccess) fprintf(stderr, "cooperative launch failed: %s (grid %d)\n", hipGetErrorString(e), grid);
}
```

```cpp
#define PREPFN prep_wave
#include <hip/hip_runtime.h>
#include <hip/hip_cooperative_groups.h>
#include <cstdio>
#include <cstdint>
namespace cg = cooperative_groups;
namespace pg8 {
#define PG8_LAS __attribute__((address_space(3)))
typedef unsigned short bf16_t;
typedef short bf16x8 __attribute__((ext_vector_type(8)));
typedef float f32x4 __attribute__((ext_vector_type(4)));
typedef unsigned u32x4 __attribute__((ext_vector_type(4)));
constexpr int BM = 256, BK = 64, HALF = 128, HTB = HALF * BK * 2  , STAGE_BYTES = 8 * HTB, NXCD = 8, WGM = 8;

__host__ __device__ __forceinline__ int lds_byte(int r, int c) { const int st = (r >> 4) * 2 + (c >> 5), rr = r & 15, cc = c & 31, ob = rr * 64 + cc * 2; return st * 1024 + (ob ^ (((ob >> 9) & 1) << 5)); }
__host__ __device__ __forceinline__ void stage_rc(int b, int& R, int& C) { const int st = b / 1024, sb = b % 1024, swz = sb ^ (((sb >> 9) & 1) << 5); R = (st >> 1) * 16 + swz / 64; C = (st & 1) * 32 + (swz % 64) / 2; }
__host__ __device__ __forceinline__ int perm32(int rho) { const int n = rho >> 4, i = rho & 15; return 8 * (i >> 2) + 4 * n + (i & 3); }

struct Unit { int pm, pn; };
struct Gemm { const bf16_t* A; const bf16_t* Bt; int M, N, K; };

struct StaticOrder {
    int nM, nN, nwg, G, c;
    __host__ __device__ void init(int M, int N, int G_, int c_) { nM = M / BM; nN = N / BM; nwg = nM * nN; G = G_; c = c_; }
    __host__ __device__ bool next(int i, Unit& u) const {
        const long L = (long)i * G + c; if (L >= nwg) return false;
        int wgid = (int)L; { const int q = nwg / NXCD, r = nwg % NXCD, xcd = wgid % NXCD, off = wgid / NXCD; wgid = (xcd < r ? xcd * (q + 1) : r * (q + 1) + (xcd - r) * q) + off; }
        const int nig = WGM * nN, gid = wgid / nig, fm = gid * WGM, gsz = (nM - fm) < WGM ? (nM - fm) : WGM;
        u.pm = fm + ((wgid % nig) % gsz); u.pn = (wgid % nig) / gsz; return true;
    }
    __device__ __forceinline__ void a_ready(const Unit&) const {}
    __device__ __forceinline__ void done(const Unit&) const {}
};

template <class Epi, class Sched, bool ALIGN_EPI = false, bool SP2 = false>
__device__ __forceinline__ void gemm_phase(PG8_LAS unsigned char* lds, const Gemm g, const Sched& S, const Epi& E) {
    int tid_ = threadIdx.x; asm volatile("" : "+v"(tid_));
    const int tid = tid_, wid = __builtin_amdgcn_readfirstlane(tid >> 6), lane = tid & 63, wr = wid >> 2, wc = wid & 3, fr = lane & 15, fq = lane >> 4;
    const int K = g.K, nt = K / BK;
    unsigned voffA[2], voffB[2];
#pragma unroll
    for (int i = 0; i < 2; ++i) { int R, C; stage_rc(tid * 16 + i * 8192, R, C); const int Rb = Epi::PERM ? ((R & ~31) + perm32(R & 31)) : R;
        voffA[i] = (unsigned)(R * K + C) * 2u; voffB[i] = (unsigned)(Rb * K + C) * 2u; }
    const size_t kstep = (size_t)(BK * 2);
    const size_t hstep = (size_t)HALF * K * 2;
    const size_t tstep = 2 * hstep;
    const unsigned ldsw = (unsigned)wid * 1024u;
    const int aoff = lds_byte(wr * 64 + fr, fq * 8), boff = lds_byte(wc * 32 + fr, fq * 8);
#define PG8_SA(b, h) (((b) * 2 + (h)) * HTB)
#define PG8_SB(b, h) ((4 + (b) * 2 + (h)) * HTB)
#define PG8_STAGE(bufoff, gbase, voff) do { _Pragma("unroll") for (int _i = 0; _i < 2; ++_i) \
        __builtin_amdgcn_global_load_lds((const unsigned*)((const char*)(gbase) + (voff)[_i]), (PG8_LAS unsigned*)(lds + (bufoff) + ldsw + _i * 8192), 16, 0, 0); } while (0)
#define PG8_LDA(dst, b, h) do { _Pragma("unroll") for (int m = 0; m < 4; ++m) _Pragma("unroll") for (int k = 0; k < 2; ++k) dst[m][k] = *(const PG8_LAS bf16x8*)(lds + PG8_SA(b, h) + aoff + m * 2048 + k * 1024); } while (0)
#define PG8_LDB(dst, b, h) do { _Pragma("unroll") for (int n = 0; n < 2; ++n) _Pragma("unroll") for (int k = 0; k < 2; ++k) dst[n][k] = *(const PG8_LAS bf16x8*)(lds + PG8_SB(b, h) + boff + n * 2048 + k * 1024); } while (0)
#define PG8_MMA(ai, bj, At, Bt) do { __builtin_amdgcn_s_setprio(1); _Pragma("unroll") for (int m = 0; m < 4; ++m) _Pragma("unroll") for (int n = 0; n < 2; ++n) _Pragma("unroll") for (int k = 0; k < 2; ++k) \
        acc[ai][bj][m][n] = __builtin_amdgcn_mfma_f32_16x16x32_bf16(Bt[n][k], At[m][k], acc[ai][bj][m][n], 0, 0, 0); __builtin_amdgcn_s_setprio(0); } while (0)
#define PG8_WAIT_V(n) asm volatile("s_waitcnt vmcnt(" #n ")" ::: "memory")
#define PG8_WAIT_L(n) asm volatile("s_waitcnt lgkmcnt(" #n ")" ::: "memory")
#define PG8_BAR __builtin_amdgcn_s_barrier()
#define PG8_SCHED __builtin_amdgcn_sched_barrier(0)
    Unit cur, nxt; int ui = 0;
    if (!S.next(0, cur)) return;
    f32x4 acc[2][2][4][2];
#pragma unroll
    for (int a = 0; a < 2; ++a)
#pragma unroll
        for (int b = 0; b < 2; ++b)
#pragma unroll
            for (int m = 0; m < 4; ++m)
#pragma unroll
                for (int n = 0; n < 2; ++n) acc[a][b][m][n] = (f32x4){0.f, 0.f, 0.f, 0.f};
    bf16x8 At[4][2], B0[2][2], B1[2][2];
    const char* cA = (const char*)g.A + (size_t)cur.pm * tstep; const char* cB = (const char*)g.Bt + (size_t)cur.pn * tstep;
    S.a_ready(cur);
    if constexpr (SP2) {
        PG8_STAGE(PG8_SB(0, 0), cB, voffB); PG8_STAGE(PG8_SB(0, 1), cB + hstep, voffB); PG8_STAGE(PG8_SA(0, 0), cA, voffA); PG8_STAGE(PG8_SA(0, 1), cA + hstep, voffA);
        if (wr == 1) PG8_BAR;
        PG8_WAIT_V(2); PG8_BAR;
        PG8_STAGE(PG8_SB(1, 0), cB + kstep, voffB); PG8_STAGE(PG8_SA(1, 0), cA + kstep, voffA); PG8_STAGE(PG8_SB(1, 1), cB + hstep + kstep, voffB);
        PG8_WAIT_V(6); PG8_BAR;
    } else {
        PG8_STAGE(PG8_SB(0, 0), cB, voffB); PG8_STAGE(PG8_SA(0, 0), cA, voffA); PG8_STAGE(PG8_SB(0, 1), cB + hstep, voffB); PG8_STAGE(PG8_SA(0, 1), cA + hstep, voffA);
        if (wr == 1) PG8_BAR;
        PG8_WAIT_V(4); PG8_BAR;
        PG8_STAGE(PG8_SB(1, 0), cB + kstep, voffB); PG8_STAGE(PG8_SA(1, 0), cA + kstep, voffA); PG8_STAGE(PG8_SB(1, 1), cB + hstep + kstep, voffB);
        PG8_WAIT_V(6); PG8_BAR;
    }
    for (;;) {
        const bool has_next = S.next(ui + 1, nxt);
        const char* nA = has_next ? (const char*)g.A + (size_t)nxt.pm * tstep : cA; const char* nB = has_next ? (const char*)g.Bt + (size_t)nxt.pn * tstep : cB;
        for (int t = 0; t < nt; t += 2) {
            const bool last = (t == nt - 2);
            const char* a1 = cA + (size_t)(t + 1) * kstep;
            const char* a2 = last ? nA : cA + (size_t)(t + 2) * kstep; const char* b2 = last ? nB : cB + (size_t)(t + 2) * kstep;
            const char* a3 = a2 + kstep; const char* b3 = b2 + kstep;
            if (last && has_next) S.a_ready(nxt);
            if constexpr (SP2) {
            PG8_LDB(B0, 0, 0); PG8_LDB(B1, 0, 1); PG8_SCHED; PG8_LDA(At, 0, 0); PG8_STAGE(PG8_SA(1, 1), a1 + hstep, voffA);
            PG8_WAIT_V(8); PG8_WAIT_L(0); PG8_BAR; PG8_MMA(0, 0, At, B0); PG8_MMA(0, 1, At, B1); PG8_BAR; PG8_SCHED;
            PG8_LDA(At, 0, 1); PG8_STAGE(PG8_SB(0, 0), b2, voffB); PG8_STAGE(PG8_SB(0, 1), b2 + hstep, voffB); PG8_STAGE(PG8_SA(0, 0), a2, voffA);
            PG8_WAIT_V(8); PG8_WAIT_L(0); PG8_BAR; PG8_MMA(1, 0, At, B0); PG8_MMA(1, 1, At, B1); PG8_BAR; PG8_SCHED;
            PG8_LDB(B0, 1, 0); PG8_LDB(B1, 1, 1); PG8_SCHED; PG8_LDA(At, 1, 0); PG8_STAGE(PG8_SA(0, 1), a2 + hstep, voffA);
            PG8_WAIT_V(8); PG8_WAIT_L(0); PG8_BAR; PG8_MMA(0, 0, At, B0); PG8_MMA(0, 1, At, B1); PG8_BAR; PG8_SCHED;
            PG8_LDA(At, 1, 1); PG8_STAGE(PG8_SB(1, 0), b3, voffB); PG8_STAGE(PG8_SB(1, 1), b3 + hstep, voffB); PG8_STAGE(PG8_SA(1, 0), a3, voffA);
            PG8_WAIT_V(8); PG8_WAIT_L(0); PG8_BAR; PG8_MMA(1, 0, At, B0); PG8_MMA(1, 1, At, B1); PG8_BAR; PG8_SCHED;
            } else {
            PG8_LDB(B0, 0, 0); PG8_SCHED; PG8_LDA(At, 0, 0); PG8_STAGE(PG8_SA(1, 1), a1 + hstep, voffA);
            PG8_WAIT_L(8); PG8_BAR; PG8_WAIT_L(0); PG8_MMA(0, 0, At, B0); PG8_BAR; PG8_SCHED;
            PG8_LDB(B1, 0, 1); PG8_STAGE(PG8_SB(0, 0), b2, voffB);
            PG8_BAR; PG8_WAIT_L(0); PG8_MMA(0, 1, At, B1); PG8_BAR;
            PG8_LDA(At, 0, 1); PG8_STAGE(PG8_SA(0, 0), a2, voffA);
            PG8_BAR; PG8_WAIT_L(0); PG8_MMA(1, 0, At, B0); PG8_BAR; PG8_SCHED;
            PG8_STAGE(PG8_SB(0, 1), b2 + hstep, voffB);
            PG8_WAIT_V(6); PG8_BAR; PG8_MMA(1, 1, At, B1); PG8_BAR;
            PG8_LDB(B0, 1, 0); PG8_SCHED; PG8_LDA(At, 1, 0); PG8_STAGE(PG8_SA(0, 1), a2 + hstep, voffA);
            PG8_WAIT_L(8); PG8_BAR; PG8_WAIT_L(0); PG8_MMA(0, 0, At, B0); PG8_BAR; PG8_SCHED;
            PG8_LDB(B1, 1, 1); PG8_STAGE(PG8_SB(1, 0), b3, voffB);
            PG8_BAR; PG8_WAIT_L(0); PG8_MMA(0, 1, At, B1); PG8_BAR;
            PG8_LDA(At, 1, 1); PG8_STAGE(PG8_SA(1, 0), a3, voffA);
            PG8_BAR; PG8_WAIT_L(0); PG8_MMA(1, 0, At, B0); PG8_BAR; PG8_SCHED;
            PG8_STAGE(PG8_SB(1, 1), b3 + hstep, voffB);
            PG8_WAIT_V(6); PG8_BAR; PG8_MMA(1, 1, At, B1); PG8_BAR;
            }
        }
        if constexpr (ALIGN_EPI) { if (wr == 0) PG8_BAR; }
        if constexpr (!Epi::AFTER_DRAIN) { E(acc, cur, wr, wc, fr, fq); S.done(cur); }
        if (!has_next) break;
#pragma unroll
        for (int a = 0; a < 2; ++a)
#pragma unroll
            for (int b = 0; b < 2; ++b)
#pragma unroll
                for (int m = 0; m < 4; ++m)
#pragma unroll
                    for (int n = 0; n < 2; ++n) acc[a][b][m][n] = (f32x4){0.f, 0.f, 0.f, 0.f};
        cur = nxt; cA = nA; cB = nB; ++ui;
        if constexpr (ALIGN_EPI) { if (wr == 1) PG8_BAR; }
    }
    PG8_WAIT_V(0);
    if constexpr (!ALIGN_EPI) { if (wr == 0) PG8_BAR; }
    PG8_BAR;
    if constexpr (Epi::AFTER_DRAIN) { E.fused(acc, cur, wr, wc, fr, fq, lds, wid, lane); S.done(cur); }
#undef PG8_SA
#undef PG8_SB
#undef PG8_STAGE
#undef PG8_LDA
#undef PG8_LDB
#undef PG8_MMA
#undef PG8_WAIT_V
#undef PG8_WAIT_L
#undef PG8_BAR
#undef PG8_SCHED
}
}

#define DI __device__ __forceinline__
#define LAS __attribute__((address_space(3)))
typedef unsigned short bf16_t;
typedef short bf16x8 __attribute__((ext_vector_type(8)));
typedef short v4i16_t __attribute__((ext_vector_type(4)));
typedef float f32x2 __attribute__((ext_vector_type(2)));
typedef float f32x4 __attribute__((ext_vector_type(4)));
typedef float f32x16 __attribute__((ext_vector_type(16)));
typedef unsigned u32x2 __attribute__((ext_vector_type(2)));
typedef unsigned u32x4 __attribute__((ext_vector_type(4)));
typedef __bf16 bf16x2_t __attribute__((ext_vector_type(2)));

constexpr int DM = 1024, NBATCH = 32, TP = 2048, TSS = 64, PAST = 2048, HD = 64, NHA = 6, NHB = 6, NHC = 4;
constexpr int MP = NBATCH * TP, MS = NBATCH * TSS, MT = MP + MS;
constexpr int SHW = 1280, INC = 4230, NPAD = 4352;
constexpr int U_R = 0, U_K = 384, U_V = 768, U_WLO = 1152, U_ALO = 1216, U_GA = 1280, U_QB = 1664, U_KB = 2048, U_VB = 2432, U_GB = 2816,
              U_QC = 3200, U_KC = 3456, U_VC = 3712, U_GC = 3968, U_FB = 4224;
constexpr float ALPHA = 1.41421356237f;
constexpr float GN_EPS = 64e-5f, LN_EPS = 1e-5f;
constexpr float LOG2E = 1.4426950408889634f;
constexpr float QSCALE2 = 0.125f * LOG2E;

constexpr size_t O_YP = 0, O_YS = O_YP + (size_t)MP * DM, O_PFK = O_YS + (size_t)MS * DM, O_PFV = O_PFK + 2ull * MP * 384, O_PFL = O_PFV + 2ull * MP * 384,
                 O_PSK = O_PFL + 2ull * MP * 6, O_PSV = O_PSK + 2ull * MP * 256, O_PWKV = O_PSV + 2ull * MP * 256, O_PSH = O_PWKV + 2ull * 32 * 6 * 4096,
                 O_SFK = O_PSH + 2ull * 32 * 1280, O_SFV = O_SFK + 2ull * MS * 384, O_SFL = O_SFV + 2ull * MS * 384, O_SSK = O_SFL + 2ull * MS * 6,
                 O_SSV = O_SSK + 2ull * MS * 256, O_SWKV = O_SSV + 2ull * MS * 256, O_SSH = O_SWKV + 2ull * 32 * 6 * 4096, O_END = O_SSH + 2ull * 32 * 1280;
static_assert(O_END == 246341632ull, "output size");

constexpr size_t MiB = 1u << 20;
constexpr size_t WS_CTL = 0, CTL_BYTES = 4096, WS_WIN = 1 * MiB, WS_WOUT = 20 * MiB, WS_LOGF = 24 * MiB, WS_XB = 28 * MiB, WS_OB = 160 * MiB, WS_UB = 292 * MiB,
                 WS_BFK = WS_UB + (((size_t)MT * NPAD * 2 + MiB - 1) / MiB) * MiB,
                 BF_BYTES = (size_t)(32 * 6 * 66) * 4096, BS_BYTES = (size_t)(32 * 4 * 66) * 4096, WS_BFV = WS_BFK + BF_BYTES, WS_BSK = WS_BFV + BF_BYTES, WS_BSV = WS_BSK + BS_BYTES, WS_END = WS_BSV + BS_BYTES;
static_assert(WS_WIN + 2ull * NPAD * DM * 2 <= WS_WOUT && WS_WOUT + 2ull * DM * DM * 2 <= WS_LOGF && WS_LOGF + (size_t)MT * 8 * 4 <= WS_XB &&
              WS_XB + (size_t)MT * DM * 2 <= WS_OB && WS_OB + (size_t)MT * DM * 2 <= WS_UB && WS_END <= 1023 * MiB, "ws map");

constexpr int LDS_BYTES = 147456;
constexpr int WK_STRIDE = 8448;
constexpr int SC_OFF = 8 * WK_STRIDE;
constexpr int CH = 16;
constexpr int OPTOK = 384;
constexpr int OPBUF_BYTES = CH * OPTOK * 4;
constexpr int SC_OP = SC_OFF, SC_Y = SC_OP + 2 * OPBUF_BYTES, YBUF_BYTES = CH * 128 * 4  , SC_BON = SC_Y + 2 * YBUF_BYTES, SC_FLAGS = SC_BON + 2 * 64;
static_assert(SC_FLAGS + 64 <= LDS_BYTES, "scan LDS");
enum { F_PROD = 0, F_POST = 1, F_CONS = 2, F_PRODB = 6, F_POSTB = 7, F_SETUP = 8 };

struct Params { const float* in[24]; float* out; unsigned char* ws; int ph_lo, ph_hi, rep_ph, dbg; };
typedef const __attribute__((address_space(4))) Params* PP;
DI PP pp_launder(PP p) { asm volatile("" : "+s"(p)); return p; }

DI float bf2f(unsigned short h) { return __uint_as_float((unsigned)h << 16); }
DI float bflo(unsigned w) { return __uint_as_float(w << 16); }
DI float bfhi(unsigned w) { return __uint_as_float(w & 0xffff0000u); }
DI unsigned cvtpk(float lo, float hi) { f32x2 v = {lo, hi}; bf16x2_t b = __builtin_convertvector(v, bf16x2_t); return __builtin_bit_cast(unsigned, b); }
DI float fast_exp2(float x) { return __builtin_amdgcn_exp2f(x); }
DI float fast_rcp(float x) { return __builtin_amdgcn_rcpf(x); }
DI float sigmoidf_(float x) { return fast_rcp(1.f + fast_exp2(-LOG2E * x)); }
DI float siluf_(float x) { return x * sigmoidf_(x); }
DI float swap32_other(float x, float& mine_lo, float& mine_hi) { auto r = __builtin_amdgcn_permlane32_swap(__float_as_uint(x), __float_as_uint(x), false, false); mine_lo = __uint_as_float(r[0]); mine_hi = __uint_as_float(r[1]); return 0.f; }
DI float red4(float x) {
    auto a = __builtin_amdgcn_permlane16_swap(__float_as_uint(x), __float_as_uint(x), false, false);
    const float s = __uint_as_float(a[0]) + __uint_as_float(a[1]);
    auto b = __builtin_amdgcn_permlane32_swap(__float_as_uint(s), __float_as_uint(s), false, false);
    return __uint_as_float(b[0]) + __uint_as_float(b[1]);
}
template <int CTRL> DI float dpp_f(float x) { return __uint_as_float((unsigned)__builtin_amdgcn_update_dpp(0, (int)__float_as_uint(x), CTRL, 0xf, 0xf, false)); }
DI float red16(float x) {
    x += dpp_f<0x121>(x); x += dpp_f<0x122>(x); x += dpp_f<0x124>(x); x += dpp_f<0x128>(x); return x;
}
DI unsigned ld_flag(LAS unsigned* p) { return __hip_atomic_load(p, __ATOMIC_ACQUIRE, __HIP_MEMORY_SCOPE_WORKGROUP); }
DI void st_flag(LAS unsigned* p, unsigned v) { __hip_atomic_store(p, v, __ATOMIC_RELEASE, __HIP_MEMORY_SCOPE_WORKGROUP); }
DI void wait_ge(LAS unsigned* p, unsigned need) { while (ld_flag(p) < need) __builtin_amdgcn_s_sleep(1); }
DI int crow(int r, int hi) { return (r & 3) + 8 * (r >> 2) + 4 * hi; }
#define MFMA32(a, b, c) __builtin_amdgcn_mfma_f32_32x32x16_bf16((a), (b), (c), 0, 0, 0)
#define MFMA16(a, b, c) __builtin_amdgcn_mfma_f32_16x16x32_bf16((a), (b), (c), 0, 0, 0)

DI void p0_item(const float* W, int Nsrc, int kind, bf16_t* WT, LAS float* scr, int item, int nblk, int lane) {
    const int kb = item / nblk, nb = item % nblk, k0 = 64 * kb, n0 = 32 * nb;
    const int n = n0 + (lane & 31); int src = n; bool valid = true;
    if (kind == 0) { if (n < 2816) src = n; else if (n < 4224) src = n + 6; else if (n < 4230) src = n - 4224 + 2816; else { valid = false; src = 0; } }
#pragma unroll 8
    for (int i = 0; i < 32; ++i) { const int kk = 2 * i + (lane >> 5); scr[kk * 33 + (lane & 31)] = valid ? W[(size_t)(k0 + kk) * Nsrc + src] : 0.f; }
    asm volatile("s_waitcnt lgkmcnt(0)" ::: "memory");
    const int c = lane & 7;
#pragma unroll
    for (int j = 0; j < 4; ++j) { const int nn = (lane >> 3) + 8 * j; const LAS float* s = scr + (8 * c) * 33 + nn;
        u32x4 o; o.x = cvtpk(s[0 * 33], s[1 * 33]); o.y = cvtpk(s[2 * 33], s[3 * 33]); o.z = cvtpk(s[4 * 33], s[5 * 33]); o.w = cvtpk(s[6 * 33], s[7 * 33]);
        *(u32x4*)(WT + (size_t)(n0 + nn) * 1024 + k0 + 8 * c) = o; }
    asm volatile("s_waitcnt lgkmcnt(0)" ::: "memory");
}
DI void phase0(PP P, LAS unsigned char* lds, int wave, int lane, int bidx, int gdim) {
    LAS float* scr = (LAS float*)(lds + wave * 8448);
    const int gw = bidx * 8 + wave, NGW = gdim * 8;
    constexpr int I_IN = 16 * (NPAD / 32), I_OUT = 16 * 32, NITEMS = 2 * (I_IN + I_OUT);
    for (int it = gw; it < NITEMS; it += NGW) {
        int r = it; const int l = r / (I_IN + I_OUT); r -= l * (I_IN + I_OUT);
        if (r < I_IN) p0_item(P->in[9] + (size_t)l * DM * INC, INC, 0, (bf16_t*)(P->ws + WS_WIN) + (size_t)l * NPAD * DM, scr, r, NPAD / 32, lane);
        else p0_item(P->in[21] + (size_t)l * DM * DM, DM, 1, (bf16_t*)(P->ws + WS_WOUT) + (size_t)l * DM * DM, scr, r - I_IN, 32, lane);
    }
    bf16_t* xb = (bf16_t*)(P->ws + WS_XB);
    for (int m = gw; m < MT; m += NGW) {
        const float* xr = (m < MP) ? P->in[0] + (size_t)m * DM : P->in[1] + (size_t)(m - MP) * DM;
        const f32x4* x4 = (const f32x4*)xr + lane; u32x2* o = (u32x2*)(xb + (size_t)m * DM) + lane;
#pragma unroll
        for (int j = 0; j < 4; ++j) { const f32x4 v = x4[64 * j]; u32x2 w; w.x = cvtpk(v.x, v.y); w.y = cvtpk(v.z, v.w); o[64 * j] = w; }
    }
}

DI float log_sigmoid_f(float x) { return fminf(x, 0.f) - log1pf(expf(-fabsf(x))); }
struct EpiU {
    static constexpr bool PERM = true, AFTER_DRAIN = false;
    unsigned char* ws; float* out; const float* fb; int l, mode;
    DI void operator()(const pg8::f32x4 (&acc)[2][2][4][2], const pg8::Unit& u, int wr, int wc, int fr, int fq) const {
        const int row0 = u.pm * 256 + wr * 64 + fr;
        if (mode == 0) {
            bf16_t* U = (bf16_t*)(ws + WS_UB); float* logf = (float*)(ws + WS_LOGF);
#pragma unroll
            for (int bj = 0; bj < 2; ++bj) {
                const int ch = u.pn * 2 + bj, c0 = ch * 128 + wc * 32 + 8 * fq;
                int W = 0, cs = 0, isv = 0, NHx = 6; size_t op = 0, os = 0, wb = 0;
                if (ch >= 16 && ch < 19) { W = 384; cs = U_KB; op = O_PFK; os = O_SFK; wb = WS_BFK; }
                else if (ch >= 19 && ch < 22) { W = 384; cs = U_VB; op = O_PFV; os = O_SFV; wb = WS_BFV; isv = 1; }
                else if (ch == 27 || ch == 28) { W = 256; cs = U_KC; op = O_PSK; os = O_SSK; wb = WS_BSK; NHx = 4; }
                else if (ch == 29 || ch == 30) { W = 256; cs = U_VC; op = O_PSV; os = O_SSV; wb = WS_BSV; NHx = 4; isv = 1; }
                const int hh = (c0 - cs) >> 6, dd = (c0 - cs) & 63;
                const unsigned koff = (unsigned)((dd >> 4) * 1024 + ((dd >> 3) & 1) * 512), voff = (unsigned)((dd >> 5) * 2048 + ((dd & 31) >> 3) * 16);
                float* segp = out + op + (size_t)l * MP * W + (c0 - cs); float* segs = out + os + (size_t)l * MS * W + (c0 - cs);
#pragma unroll
                for (int ai = 0; ai < 2; ++ai)
#pragma unroll
                    for (int m = 0; m < 4; ++m) {
                        const int r = row0 + ai * 128 + m * 16;
                        const f32x4 v0 = acc[ai][bj][m][0], v1 = acc[ai][bj][m][1];
                        u32x4 w; w.x = cvtpk(v0[0], v0[1]); w.y = cvtpk(v0[2], v0[3]); w.z = cvtpk(v1[0], v1[1]); w.w = cvtpk(v1[2], v1[3]);
                        if (W) { float* d = (r < MP) ? segp + (size_t)r * W : segs + (size_t)(r - MP) * W; *(f32x4*)d = v0; *(f32x4*)(d + 4) = v1;
                            int bq, tq_, smp; if (r < MP) { bq = r >> 11; tq_ = r & 2047; smp = 0; } else { const int rs = r - MP; bq = rs >> 6; tq_ = rs & 63; smp = 1; }
                            const unsigned tix = smp ? (unsigned)(32 * NHx * 64 + (bq * NHx + hh) * 2 + (tq_ >> 5)) : (unsigned)((bq * NHx + hh) * 64 + (tq_ >> 5));
                            const int r32_ = tq_ & 31;
                            const unsigned off = isv ? voff + (unsigned)((r32_ >> 4) * 1024 + (r32_ & 15) * 64) : koff + (unsigned)(r32_ * 16);
                            *(u32x4*)(ws + wb + (size_t)tix * 4096 + off) = w; }
                        else *(u32x4*)(U + (size_t)r * NPAD + c0) = w;
                        if (ch < 10) {
                            if (r < MP) { if ((r & 2047) == 2047) { float* d = out + O_PSH + (size_t)(l * 32 + (r >> 11)) * SHW + c0; *(f32x4*)d = v0; *(f32x4*)(d + 4) = v1; } }
                            else { const int rs = r - MP; if ((rs & 63) == 63) { float* d = out + O_SSH + (size_t)(l * 32 + (rs >> 6)) * SHW + c0; *(f32x4*)d = v0; *(f32x4*)(d + 4) = v1; } }
                        }
                        if (ch == 33 && wc == 0 && fq == 0) {
                            float lf[6];
#pragma unroll
                            for (int h = 0; h < 6; ++h) { const float x = (h < 4 ? v0[h] : v1[h - 4]) + fb[h]; lf[h] = log_sigmoid_f(x); }
                            float* d = (r < MP) ? out + O_PFL + ((size_t)l * MP + r) * 6 : out + O_SFL + ((size_t)l * MS + (r - MP)) * 6;
#pragma unroll
                            for (int h = 0; h < 6; ++h) { d[h] = lf[h]; logf[(size_t)r * 8 + h] = lf[h]; }
                        }
                    }
            }
        } else {
            const bf16_t* X = (const bf16_t*)(ws + WS_XB); bf16_t* Z = (bf16_t*)(ws + WS_UB);
#pragma unroll
            for (int ai = 0; ai < 2; ++ai)
#pragma unroll
                for (int m = 0; m < 4; ++m) {
                    const size_t r = (size_t)(row0 + ai * 128 + m * 16);
#pragma unroll
                    for (int bj = 0; bj < 2; ++bj) {
                        const int c = u.pn * 256 + bj * 128 + wc * 32 + 8 * fq;
                        const u32x4 xw = *(const u32x4*)(X + r * DM + c);
                        f32x4 z0 = acc[ai][bj][m][0], z1 = acc[ai][bj][m][1];
                        z0[0] += ALPHA * bflo(xw.x); z0[1] += ALPHA * bfhi(xw.x); z0[2] += ALPHA * bflo(xw.y); z0[3] += ALPHA * bfhi(xw.y);
                        z1[0] += ALPHA * bflo(xw.z); z1[1] += ALPHA * bfhi(xw.z); z1[2] += ALPHA * bflo(xw.w); z1[3] += ALPHA * bfhi(xw.w);
                        u32x4 zw; zw.x = cvtpk(z0[0], z0[1]); zw.y = cvtpk(z0[2], z0[3]); zw.z = cvtpk(z1[0], z1[1]); zw.w = cvtpk(z1[2], z1[3]);
                        *(u32x4*)(Z + r * DM + c) = zw;
                    }
                }
        }
    }
};

DI float wave_sum(float v) {
#pragma unroll
    for (int o = 1; o < 64; o <<= 1) v += __shfl_xor(v, o);
    return v;
}
DI void phase_ln(PP P, int l, int wave, int lane, int bidx, int gdim) {
    const int gw = bidx * 8 + wave, NGW = gdim * 8;
    const bf16_t* Z = (const bf16_t*)(P->ws + WS_UB); bf16_t* xb = (bf16_t*)(P->ws + WS_XB);
    const f32x4* g4 = (const f32x4*)(P->in[22] + (size_t)l * DM) + lane; const f32x4* b4 = (const f32x4*)(P->in[23] + (size_t)l * DM) + lane;
    f32x4 g[4], bb[4];
#pragma unroll
    for (int j = 0; j < 4; ++j) { g[j] = g4[64 * j]; bb[j] = b4[64 * j]; }
    for (int m = gw; m < MT; m += NGW) {
        const u32x2* z4 = (const u32x2*)(Z + (size_t)m * DM) + lane;
        f32x4 v[4]; float s = 0.f;
#pragma unroll
        for (int j = 0; j < 4; ++j) { const u32x2 zz_ = z4[64 * j]; v[j] = (f32x4){bflo(zz_.x), bfhi(zz_.x), bflo(zz_.y), bfhi(zz_.y)}; s += (v[j].x + v[j].y) + (v[j].z + v[j].w); }
        const float mean = wave_sum(s) * (1.f / DM); float s2 = 0.f;
#pragma unroll
        for (int j = 0; j < 4; ++j) { v[j] = v[j] - mean; s2 += (v[j].x * v[j].x + v[j].y * v[j].y) + (v[j].z * v[j].z + v[j].w * v[j].w); }
        const float rstd = 1.f / sqrtf(wave_sum(s2) * (1.f / DM) + LN_EPS);
#pragma unroll
        for (int j = 0; j < 4; ++j) v[j] = v[j] * rstd * g[j] + bb[j];
        if (l == 0) { u32x2* o = (u32x2*)(xb + (size_t)m * DM) + lane;
#pragma unroll
            for (int j = 0; j < 4; ++j) { u32x2 w; w.x = cvtpk(v[j].x, v[j].y); w.y = cvtpk(v[j].z, v[j].w); o[64 * j] = w; } }
        else { f32x4* o = (f32x4*)(P->out + O_YP + (size_t)m * DM) + lane;
#pragma unroll
            for (int j = 0; j < 4; ++j) o[64 * j] = v[j]; }
    }
}

DI void scan_wave(PP P, int l, LAS unsigned char* lds, int wave, int lane, int seq0, int nseq, bool sample, int dbg, bool two = false) {
    const int row = wave * 16 + (lane & 15), kq = lane >> 4;
    LAS unsigned* flags = (LAS unsigned*)(lds + SC_FLAGS);
    unsigned cgl = 0;
    const int nch = sample ? TSS / CH : TP / CH;
    __builtin_amdgcn_s_setprio(3);
    for (int s = 0; s < nseq; ++s) {
        const int seq = seq0 + s, b = seq / 6, h = seq % 6;
        f32x4 S[4];
        if (sample) { const f32x4* sp = (const f32x4*)(P->in[7] + ((size_t)((l * 32 + b) * 6 + h) * 64 + row) * 64 + kq * 16);
#pragma unroll
            for (int i = 0; i < 4; ++i) S[i] = sp[i]; }
        else {
#pragma unroll
            for (int i = 0; i < 4; ++i) S[i] = (f32x4){0.f, 0.f, 0.f, 0.f}; }
        for (int c = 0; c < nch; ++c, ++cgl) {
            if (two) { wait_ge(&flags[(cgl & 1) ? F_PRODB : F_PROD], (cgl >> 1) + 1); if (cgl >= 2) wait_ge(&flags[(cgl & 1) ? F_POSTB : F_POST], cgl >> 1); }
            else { wait_ge(&flags[F_PROD], cgl + 1); if (cgl >= 2) wait_ge(&flags[F_POST], cgl - 1); }
            LAS const float* opb = (LAS const float*)(lds + SC_OP + (cgl & 1) * OPBUF_BYTES);
            LAS float* yb = (LAS float*)(lds + SC_Y + (cgl & 1) * YBUF_BYTES);
            LAS const float* bon = (LAS const float*)(lds + SC_BON + (cgl & 1) * 64);
            LAS const float* tp0 = opb + kq * 16; asm volatile("" : "+v"(tp0));
            LAS const float* vp0 = opb + 320 + row; asm volatile("" : "+v"(vp0));
            f32x4 w4[2][4], kk4[2][4], ka4[2][4], kp4[2][4], r4[2][4]; float vv[2], bt[2];
#define SC_LOAD(buf, t_) do { LAS const float* tp = tp0 + (t_) * OPTOK; \
                _Pragma("unroll") for (int i = 0; i < 4; ++i) { w4[buf][i] = *(LAS const f32x4*)(tp + 4 * i); kk4[buf][i] = *(LAS const f32x4*)(tp + 64 + 4 * i); ka4[buf][i] = *(LAS const f32x4*)(tp + 128 + 4 * i); \
                    kp4[buf][i] = *(LAS const f32x4*)(tp + 192 + 4 * i); r4[buf][i] = *(LAS const f32x4*)(tp + 256 + 4 * i); } \
                vv[buf] = vp0[(t_) * OPTOK]; bt[buf] = bon[t_]; } while (0)
            SC_LOAD(0, 0);
#pragma unroll
            for (int t = 0; t < CH; ++t) {
                if ((dbg & 8) && t >= 8) break;
                const int cb = t & 1, nb = cb ^ 1;
                if (t + 1 < CH) SC_LOAD(nb, t + 1);
                f32x4 a4 = S[0] * kk4[cb][0];
#pragma unroll
                for (int i = 1; i < 4; ++i) a4 += S[i] * kk4[cb][i];
                float sa = (a4[0] + a4[1]) + (a4[2] + a4[3]);
                sa = red4(sa);
                const float nsa = -sa;
                f32x4 y4 = (f32x4){0.f, 0.f, 0.f, 0.f};
#pragma unroll
                for (int i = 0; i < 4; ++i) { S[i] = S[i] * w4[cb][i] + nsa * ka4[cb][i] + vv[cb] * kp4[cb][i]; y4 += S[i] * r4[cb][i]; }
                float y = (y4[0] + y4[1]) + (y4[2] + y4[3]);
                y = red4(y);
                if (kq < 2) yb[t * 128 + kq * 64 + row] = kq == 0 ? y : bt[cb] * vv[cb];
            }
#undef SC_LOAD
            st_flag(&flags[F_CONS + wave], cgl + 1);
        }
        float* so = P->out + (sample ? O_SWKV : O_PWKV) + ((size_t)((l * 32 + b) * 6 + h) * 64 + row) * 64 + kq * 16;
        if (!(dbg & 256)) {
#pragma unroll
            for (int i = 0; i < 4; ++i) *(f32x4*)(so + 4 * i) = S[i]; }
    }
    __builtin_amdgcn_s_setprio(0);
}

constexpr int SC_CST = SC_FLAGS + 64, CST_BYTES = 10 * 64 * 4, RAWBUF = 16384;
static_assert(SC_CST + CST_BYTES <= LDS_BYTES && 2 * RAWBUF <= 4 * WK_STRIDE && 15 * 1024 <= RAWBUF, "prep LDS");
#define RAWOFF(R, sg, c) ((((sg) * 3 + ((R) >> 3)) * 1024) + (((R) & 7) * 128) + (c) * 2)
DI void prep_wave(PP P, int l, LAS unsigned char* lds, int lane, int seq0, int nseq, bool sample, int dbg) {
    const int fr = lane & 15, fq = lane >> 4;
    LAS unsigned* flags = (LAS unsigned*)(lds + SC_FLAGS);
    LAS float* cst = (LAS float*)(lds + SC_CST);
    const bf16_t* ub = (const bf16_t*)(P->ws + WS_UB);
    const float* mu = P->in[10] + (size_t)l * SHW;
    unsigned cgl = 0;
    const int nch = sample ? TSS / CH : TP / CH;
    const int c8 = lane & 7, rsub = lane >> 3;
    const unsigned goff = (unsigned)(rsub * NPAD + c8 * 8) * 2u;
    for (int s = 0; s < nseq; ++s) {
        const int seq = seq0 + s, b = seq / 6, h = seq % 6;
        const size_t m0 = sample ? (size_t)MP + (size_t)b * TSS : (size_t)b * TP;
        const float* sh0 = P->in[8] + (size_t)(l * 32 + b) * SHW;
        {
            const int kc = h * 64 + lane;
            cst[0 * 64 + lane] = mu[U_R + kc]; cst[1 * 64 + lane] = mu[U_K + kc]; cst[2 * 64 + lane] = mu[U_V + kc];
            cst[3 * 64 + lane] = P->in[11][(size_t)l * 384 + kc]; cst[4 * 64 + lane] = P->in[13][(size_t)l * 384 + kc]; cst[5 * 64 + lane] = P->in[15][(size_t)l * 384 + kc];
            cst[6 * 64 + lane] = P->in[16][(size_t)l * 384 + kc]; cst[7 * 64 + lane] = P->in[17][(size_t)l * 384 + kc];
            cst[8 * 64 + lane] = mu[U_WLO + lane]; cst[9 * 64 + lane] = mu[U_ALO + lane];
        }
        LAS unsigned char* btab = lds + 4 * WK_STRIDE;
        {
            LAS float* wst = (LAS float*)lds;
#pragma unroll
            for (int arr = 0; arr < 2; ++arr)
#pragma unroll
                for (int ks = 0; ks < 2; ++ks) {
                    const float* W = P->in[arr == 0 ? 12 : 14] + (size_t)l * 64 * 384 + (size_t)(32 * ks) * 384 + h * 64;
                    asm volatile("" ::: "memory");
#pragma unroll
                    for (int n = 0; n < 8; ++n) { const int row = (lane >> 4) + 4 * n; *(LAS f32x4*)(wst + row * 64 + (lane & 15) * 4) = *(const f32x4*)(W + (size_t)row * 384 + (lane & 15) * 4); }
                    asm volatile("" ::: "memory");
#pragma unroll
                    for (int j = 0; j < 4; ++j) { u32x4 pq;
#pragma unroll
                        for (int e = 0; e < 4; ++e) { const int k0 = 8 * fq + 2 * e; pq[e] = cvtpk(wst[k0 * 64 + 16 * j + fr], wst[(k0 + 1) * 64 + 16 * j + fr]); }
                        *(LAS u32x4*)(btab + (((arr * 4 + j) * 2 + ks) * 64 + lane) * 16) = pq; }
                    asm volatile("" ::: "memory");
                }
        }
        u32x4 pf[15];
#define PREP_FETCH(c_) do { const char* gb_ = (const char*)(ub + (m0 + (size_t)(c_) * CH - 1) * NPAD); \
            _Pragma("unroll") for (int sg = 0; sg < 5; ++sg) { const char* gs_ = gb_ + (sg < 3 ? (sg * 384 + h * 64) * 2 : (sg == 3 ? U_WLO * 2 : U_ALO * 2)); \
                _Pragma("unroll") for (int rg = 0; rg < 3; ++rg) { if (rg < 2 || rsub == 0) pf[sg * 3 + rg] = *(const u32x4*)(gs_ + (size_t)(rg * 8 * NPAD * 2) + goff); } } } while (0)
        asm volatile("s_waitcnt vmcnt(0) lgkmcnt(0)" ::: "memory");
        PREP_FETCH(0);
        for (int c = 0; c < nch; ++c, ++cgl) {
            if (dbg & 2) { if (cgl >= 2) { for (int j = 0; j < 4; ++j) wait_ge(&flags[F_CONS + j], cgl - 1); } st_flag(&flags[F_PROD], cgl + 1); continue; }
            const int t0 = c * CH;
            LAS unsigned char* raw = lds + (c & 1) * RAWBUF;
#pragma unroll
            for (int sg = 0; sg < 5; ++sg)
#pragma unroll
                for (int rg = 0; rg < 3; ++rg) { if (rg < 2 || rsub == 0) *(LAS u32x4*)(raw + (sg * 3 + rg) * 1024 + lane * 16) = pf[sg * 3 + rg]; }
            if (t0 == 0 && rsub == 0) {
#pragma unroll
                for (int sg = 0; sg < 5; ++sg) {
                    u32x4 v = (u32x4){0u, 0u, 0u, 0u};
                    if (sample) { const int col_ = (sg < 3 ? sg * 384 + h * 64 : (sg == 3 ? U_WLO : U_ALO)) + c8 * 8;
                        const f32x4 a = *(const f32x4*)(sh0 + col_), bq = *(const f32x4*)(sh0 + col_ + 4); v.x = cvtpk(a[0], a[1]); v.y = cvtpk(a[2], a[3]); v.z = cvtpk(bq[0], bq[1]); v.w = cvtpk(bq[2], bq[3]); }
                    *(LAS u32x4*)(raw + sg * 3 * 1024 + c8 * 16) = v;
                }
            }
            asm volatile("" ::: "memory");
            if (c + 1 < nch) PREP_FETCH(c + 1);
            int zz = 0; asm volatile("" : "+v"(zz));
            LAS const float* cz = cst + zz;
            f32x4 Dw[4], Da[4];
            {
                bf16x8 Aw[2], Aa[2];
#pragma unroll
                for (int ks = 0; ks < 2; ++ks) {
                    const u32x4 cw = *(LAS const u32x4*)(raw + RAWOFF(fr + 1, 3, 32 * ks + 8 * fq)), pwv = *(LAS const u32x4*)(raw + RAWOFF(fr, 3, 32 * ks + 8 * fq));
                    const u32x4 ca = *(LAS const u32x4*)(raw + RAWOFF(fr + 1, 4, 32 * ks + 8 * fq)), pav = *(LAS const u32x4*)(raw + RAWOFF(fr, 4, 32 * ks + 8 * fq));
                    const f32x4 mw0 = *(LAS const f32x4*)(cz + 8 * 64 + 32 * ks + 8 * fq), mw1 = *(LAS const f32x4*)(cz + 8 * 64 + 32 * ks + 8 * fq + 4);
                    const f32x4 ma0 = *(LAS const f32x4*)(cz + 9 * 64 + 32 * ks + 8 * fq), ma1 = *(LAS const f32x4*)(cz + 9 * 64 + 32 * ks + 8 * fq + 4);
                    u32x4 pw, pa;
#pragma unroll
                    for (int e = 0; e < 4; ++e) {
                        const float c0 = bflo(cw[e]), c1 = bfhi(cw[e]), p0 = bflo(pwv[e]), p1 = bfhi(pwv[e]);
                        const float m0_ = (e < 2 ? mw0[2 * e] : mw1[2 * e - 4]), m1_ = (e < 2 ? mw0[2 * e + 1] : mw1[2 * e - 3]);
                        const float z0 = c0 + (p0 - c0) * m0_, z1 = c1 + (p1 - c1) * m1_;
                        const float t0_ = 1.f - 2.f * fast_rcp(1.f + fast_exp2(2.f * LOG2E * z0)), t1_ = 1.f - 2.f * fast_rcp(1.f + fast_exp2(2.f * LOG2E * z1));
                        pw[e] = cvtpk(t0_, t1_);
                        const float d0 = bflo(ca[e]), d1 = bfhi(ca[e]), q0 = bflo(pav[e]), q1 = bfhi(pav[e]);
                        const float n0_ = (e < 2 ? ma0[2 * e] : ma1[2 * e - 4]), n1_ = (e < 2 ? ma0[2 * e + 1] : ma1[2 * e - 3]);
                        pa[e] = cvtpk(d0 + (q0 - d0) * n0_, d1 + (q1 - d1) * n1_);
                    }
                    Aw[ks] = __builtin_bit_cast(bf16x8, pw); Aa[ks] = __builtin_bit_cast(bf16x8, pa);
                }
#pragma unroll
                for (int j = 0; j < 4; ++j) {
                    const f32x4 z = (f32x4){0.f, 0.f, 0.f, 0.f};
                    LAS const unsigned char* bt = btab + zz + lane * 16;
                    Dw[j] = MFMA16(Aw[0], *(LAS const bf16x8*)(bt + ((0 * 4 + j) * 2 + 0) * 1024), z); Dw[j] = MFMA16(Aw[1], *(LAS const bf16x8*)(bt + ((0 * 4 + j) * 2 + 1) * 1024), Dw[j]);
                    Da[j] = MFMA16(Aa[0], *(LAS const bf16x8*)(bt + ((1 * 4 + j) * 2 + 0) * 1024), z); Da[j] = MFMA16(Aa[1], *(LAS const bf16x8*)(bt + ((1 * 4 + j) * 2 + 1) * 1024), Da[j]);
                }
            }
            if (cgl >= 2) {
#pragma unroll
                for (int j = 0; j < 4; ++j) wait_ge(&flags[F_CONS + j], cgl - 1);
            }
            LAS float* opb = (LAS float*)(lds + SC_OP + (cgl & 1) * OPBUF_BYTES);
            LAS float* bon = (LAS float*)(lds + SC_BON + (cgl & 1) * 64);
#pragma unroll
            for (int i = 0; i < 4; ++i) {
                const int tl = 4 * fq + i; LAS const unsigned char* rc = raw + RAWOFF(tl + 1, 0, fr); LAS const unsigned char* rp = raw + RAWOFF(tl, 0, fr);
#define RB(p_, sg_, j_) bf2f(*(LAS const bf16_t*)((p_) + (sg_) * 3072 + (j_) * 32))
                float rr[4], kk[4], vv[4], aa[4], ww[4], kn[4]; float ss = 0.f;
#pragma unroll
                for (int j = 0; j < 4; ++j) {
                    const float cr = RB(rc, 0, j), ck = RB(rc, 1, j), cv = RB(rc, 2, j);
                    const float pr = RB(rp, 0, j), pk = RB(rp, 1, j), pv_ = RB(rp, 2, j);
                    rr[j] = cr + (pr - cr) * cz[0 * 64 + 16 * j + fr]; kk[j] = ck + (pk - ck) * cz[1 * 64 + 16 * j + fr]; vv[j] = cv + (pv_ - cv) * cz[2 * 64 + 16 * j + fr];
                    const float x = cz[3 * 64 + 16 * j + fr] + Dw[j][i];
                    const float sg = fast_rcp(1.f + fast_exp2(-LOG2E * x));
                    ww[j] = fast_exp2(-0.60653066f * LOG2E * sg);
                    aa[j] = fast_rcp(1.f + fast_exp2(-LOG2E * (cz[4 * 64 + 16 * j + fr] + Da[j][i])));
                    kn[j] = kk[j] * cz[5 * 64 + 16 * j + fr]; ss += kn[j] * kn[j];
                }
                ss = red16(ss);
                const float rn = 1.f / sqrtf(ss + 1e-12f);
                float bs = 0.f; LAS float* o = opb + tl * OPTOK + fr;
#pragma unroll
                for (int j = 0; j < 4; ++j) {
                    const float knn = kn[j] * rn, kp = kk[j] * (1.f + (aa[j] - 1.f) * cz[6 * 64 + 16 * j + fr]);
                    bs += rr[j] * kp * cz[7 * 64 + 16 * j + fr];
                    o[16 * j] = ww[j]; o[64 + 16 * j] = knn; o[128 + 16 * j] = knn * aa[j]; o[192 + 16 * j] = kp; o[256 + 16 * j] = rr[j]; o[320 + 16 * j] = vv[j];
                }
                bs = red16(bs);
                if (fr == 0) bon[tl] = bs;
#undef RB
            }
            st_flag(&flags[F_PROD], cgl + 1);
        }
#undef PREP_FETCH
    }
}

DI void helper2_wave(PP P, int l, LAS unsigned char* lds, int lane, int seq0, int par, int dbg) {
    const int nseq = 1; const bool sample = false;
    const int fr = lane & 15, fq = lane >> 4;
    LAS unsigned* flags = (LAS unsigned*)(lds + SC_FLAGS);
    LAS float* cst = (LAS float*)(lds + SC_CST);
    const bf16_t* ub = (const bf16_t*)(P->ws + WS_UB);
    const float* mu = P->in[10] + (size_t)l * SHW;
    unsigned cgl = 0;
    const int nch = sample ? TSS / CH : TP / CH;
    const int c8 = lane & 7, rsub = lane >> 3;
    const unsigned goff = (unsigned)(rsub * NPAD + c8 * 8) * 2u;
    for (int s = 0; s < nseq; ++s) {
        const int seq = seq0 + s, b = seq / 6, h = seq % 6;
        const size_t m0 = sample ? (size_t)MP + (size_t)b * TSS : (size_t)b * TP;
        const float* sh0 = P->in[8] + (size_t)(l * 32 + b) * SHW;
        if (par == 0) {
            const int kc = h * 64 + lane;
            cst[0 * 64 + lane] = mu[U_R + kc]; cst[1 * 64 + lane] = mu[U_K + kc]; cst[2 * 64 + lane] = mu[U_V + kc];
            cst[3 * 64 + lane] = P->in[11][(size_t)l * 384 + kc]; cst[4 * 64 + lane] = P->in[13][(size_t)l * 384 + kc]; cst[5 * 64 + lane] = P->in[15][(size_t)l * 384 + kc];
            cst[6 * 64 + lane] = P->in[16][(size_t)l * 384 + kc]; cst[7 * 64 + lane] = P->in[17][(size_t)l * 384 + kc];
            cst[8 * 64 + lane] = mu[U_WLO + lane]; cst[9 * 64 + lane] = mu[U_ALO + lane];
        }
        LAS unsigned char* btab = lds + 4 * WK_STRIDE;
        if (par == 0) {
            LAS float* wst = (LAS float*)lds;
#pragma unroll
            for (int arr = 0; arr < 2; ++arr)
#pragma unroll
                for (int ks = 0; ks < 2; ++ks) {
                    const float* W = P->in[arr == 0 ? 12 : 14] + (size_t)l * 64 * 384 + (size_t)(32 * ks) * 384 + h * 64;
                    asm volatile("" ::: "memory");
#pragma unroll
                    for (int n = 0; n < 8; ++n) { const int row = (lane >> 4) + 4 * n; *(LAS f32x4*)(wst + row * 64 + (lane & 15) * 4) = *(const f32x4*)(W + (size_t)row * 384 + (lane & 15) * 4); }
                    asm volatile("" ::: "memory");
#pragma unroll
                    for (int j = 0; j < 4; ++j) { u32x4 pq;
#pragma unroll
                        for (int e = 0; e < 4; ++e) { const int k0 = 8 * fq + 2 * e; pq[e] = cvtpk(wst[k0 * 64 + 16 * j + fr], wst[(k0 + 1) * 64 + 16 * j + fr]); }
                        *(LAS u32x4*)(btab + (((arr * 4 + j) * 2 + ks) * 64 + lane) * 16) = pq; }
                    asm volatile("" ::: "memory");
                }
        }
        u32x4 pf[15];
#define PREP_FETCH(c_) do { const char* gb_ = (const char*)(ub + (m0 + (size_t)(c_) * CH - 1) * NPAD); \
            _Pragma("unroll") for (int sg = 0; sg < 5; ++sg) { const char* gs_ = gb_ + (sg < 3 ? (sg * 384 + h * 64) * 2 : (sg == 3 ? U_WLO * 2 : U_ALO * 2)); \
                _Pragma("unroll") for (int rg = 0; rg < 3; ++rg) { if (rg < 2 || rsub == 0) pf[sg * 3 + rg] = *(const u32x4*)(gs_ + (size_t)(rg * 8 * NPAD * 2) + goff); } } } while (0)
        asm volatile("s_waitcnt vmcnt(0) lgkmcnt(0)" ::: "memory");
        if (par == 0) st_flag(&flags[F_SETUP], 1u); else wait_ge(&flags[F_SETUP], 1u);
        const f32x4 pg4 = *(const f32x4*)(P->in[18] + (size_t)l * 384 + h * 64 + 4 * fr), pb4 = *(const f32x4*)(P->in[19] + (size_t)l * 384 + h * 64 + 4 * fr);
        bf16_t* obp = (bf16_t*)(P->ws + WS_OB);
#define POST_CHUNK(cl_) do { const unsigned cg_ = (unsigned)(cl_); \
            u32x2 gwv_[4]; \
            _Pragma("unroll") for (int i = 0; i < 4; ++i) gwv_[i] = *(const u32x2*)(ub + (m0 + (cl_) * CH + 4 * i + fq) * NPAD + U_GA + h * 64 + 4 * fr); \
            _Pragma("unroll") for (int j = 0; j < 4; ++j) wait_ge(&flags[F_CONS + j], cg_ + 1); \
            LAS const float* yb_ = (LAS const float*)(lds + SC_Y + par * YBUF_BYTES); \
            f32x4 yv_[4], bv_[4]; \
            _Pragma("unroll") for (int i = 0; i < 4; ++i) { const int tl_ = 4 * i + fq; yv_[i] = *(LAS const f32x4*)(yb_ + tl_ * 128 + 4 * fr); bv_[i] = *(LAS const f32x4*)(yb_ + tl_ * 128 + 64 + 4 * fr); } \
            st_flag(&flags[par ? F_POSTB : F_POST], (cg_ >> 1) + 1); \
            _Pragma("unroll") for (int i = 0; i < 4; ++i) { const size_t m_ = m0 + (cl_) * CH + 4 * i + fq; \
                const f32x4 y4_ = yv_[i]; \
                const float mean_ = red16((y4_[0] + y4_[1]) + (y4_[2] + y4_[3])) * (1.f / 64.f); \
                const f32x4 d_ = y4_ - mean_; \
                const float var_ = red16((d_[0] * d_[0] + d_[1] * d_[1]) + (d_[2] * d_[2] + d_[3] * d_[3])) * (1.f / 64.f); \
                const float rstd_ = __builtin_amdgcn_rsqf(var_ + GN_EPS); \
                f32x4 o_ = d_ * rstd_ * pg4 + pb4 + bv_[i]; \
                o_[0] *= siluf_(bflo(gwv_[i].x)); o_[1] *= siluf_(bfhi(gwv_[i].x)); o_[2] *= siluf_(bflo(gwv_[i].y)); o_[3] *= siluf_(bfhi(gwv_[i].y)); \
                u32x2 w_; w_.x = cvtpk(o_[0], o_[1]); w_.y = cvtpk(o_[2], o_[3]); \
                if (!(dbg & 256)) *(u32x2*)(obp + m_ * DM + h * 64 + 4 * fr) = w_; } } while (0)
        float cr_[8][4];
#pragma unroll
        for (int a_ = 0; a_ < 8; ++a_)
#pragma unroll
            for (int j = 0; j < 4; ++j) cr_[a_][j] = cst[a_ * 64 + 16 * j + fr];
        PREP_FETCH(par);
        for (int c = par; c < nch; c += 2) { cgl = (unsigned)c;
            const int t0 = c * CH;
            LAS unsigned char* raw = lds + par * RAWBUF;
#pragma unroll
            for (int sg = 0; sg < 5; ++sg)
#pragma unroll
                for (int rg = 0; rg < 3; ++rg) { if (rg < 2 || rsub == 0) *(LAS u32x4*)(raw + (sg * 3 + rg) * 1024 + lane * 16) = pf[sg * 3 + rg]; }
            if (t0 == 0 && rsub == 0) {
#pragma unroll
                for (int sg = 0; sg < 5; ++sg) {
                    u32x4 v = (u32x4){0u, 0u, 0u, 0u};
                    if (sample) { const int col_ = (sg < 3 ? sg * 384 + h * 64 : (sg == 3 ? U_WLO : U_ALO)) + c8 * 8;
                        const f32x4 a = *(const f32x4*)(sh0 + col_), bq = *(const f32x4*)(sh0 + col_ + 4); v.x = cvtpk(a[0], a[1]); v.y = cvtpk(a[2], a[3]); v.z = cvtpk(bq[0], bq[1]); v.w = cvtpk(bq[2], bq[3]); }
                    *(LAS u32x4*)(raw + sg * 3 * 1024 + c8 * 16) = v;
                }
            }
            asm volatile("" ::: "memory");
            if (c + 2 < nch) PREP_FETCH(c + 2);
            int zz = 0; asm volatile("" : "+v"(zz));
            LAS const float* cz = cst + zz;
            f32x4 Dw[4], Da[4];
            {
                bf16x8 Aw[2], Aa[2];
#pragma unroll
                for (int ks = 0; ks < 2; ++ks) {
                    const u32x4 cw = *(LAS const u32x4*)(raw + RAWOFF(fr + 1, 3, 32 * ks + 8 * fq)), pwv = *(LAS const u32x4*)(raw + RAWOFF(fr, 3, 32 * ks + 8 * fq));
                    const u32x4 ca = *(LAS const u32x4*)(raw + RAWOFF(fr + 1, 4, 32 * ks + 8 * fq)), pav = *(LAS const u32x4*)(raw + RAWOFF(fr, 4, 32 * ks + 8 * fq));
                    const f32x4 mw0 = *(LAS const f32x4*)(cz + 8 * 64 + 32 * ks + 8 * fq), mw1 = *(LAS const f32x4*)(cz + 8 * 64 + 32 * ks + 8 * fq + 4);
                    const f32x4 ma0 = *(LAS const f32x4*)(cz + 9 * 64 + 32 * ks + 8 * fq), ma1 = *(LAS const f32x4*)(cz + 9 * 64 + 32 * ks + 8 * fq + 4);
                    u32x4 pw, pa;
#pragma unroll
                    for (int e = 0; e < 4; ++e) {
                        const float c0 = bflo(cw[e]), c1 = bfhi(cw[e]), p0 = bflo(pwv[e]), p1 = bfhi(pwv[e]);
                        const float m0_ = (e < 2 ? mw0[2 * e] : mw1[2 * e - 4]), m1_ = (e < 2 ? mw0[2 * e + 1] : mw1[2 * e - 3]);
                        const float z0 = c0 + (p0 - c0) * m0_, z1 = c1 + (p1 - c1) * m1_;
                        const float t0_ = 1.f - 2.f * fast_rcp(1.f + fast_exp2(2.f * LOG2E * z0)), t1_ = 1.f - 2.f * fast_rcp(1.f + fast_exp2(2.f * LOG2E * z1));
                        pw[e] = cvtpk(t0_, t1_);
                        const float d0 = bflo(ca[e]), d1 = bfhi(ca[e]), q0 = bflo(pav[e]), q1 = bfhi(pav[e]);
                        const float n0_ = (e < 2 ? ma0[2 * e] : ma1[2 * e - 4]), n1_ = (e < 2 ? ma0[2 * e + 1] : ma1[2 * e - 3]);
                        pa[e] = cvtpk(d0 + (q0 - d0) * n0_, d1 + (q1 - d1) * n1_);
                    }
                    Aw[ks] = __builtin_bit_cast(bf16x8, pw); Aa[ks] = __builtin_bit_cast(bf16x8, pa);
                }
#pragma unroll
                for (int j = 0; j < 4; ++j) {
                    const f32x4 z = (f32x4){0.f, 0.f, 0.f, 0.f};
                    LAS const unsigned char* bt = btab + zz + lane * 16;
                    Dw[j] = MFMA16(Aw[0], *(LAS const bf16x8*)(bt + ((0 * 4 + j) * 2 + 0) * 1024), z); Dw[j] = MFMA16(Aw[1], *(LAS const bf16x8*)(bt + ((0 * 4 + j) * 2 + 1) * 1024), Dw[j]);
                    Da[j] = MFMA16(Aa[0], *(LAS const bf16x8*)(bt + ((1 * 4 + j) * 2 + 0) * 1024), z); Da[j] = MFMA16(Aa[1], *(LAS const bf16x8*)(bt + ((1 * 4 + j) * 2 + 1) * 1024), Da[j]);
                }
            }
            if (cgl >= 2) {
#pragma unroll
                for (int j = 0; j < 4; ++j) wait_ge(&flags[F_CONS + j], cgl - 1);
            }
            LAS float* opb = (LAS float*)(lds + SC_OP + (cgl & 1) * OPBUF_BYTES);
            LAS float* bon = (LAS float*)(lds + SC_BON + (cgl & 1) * 64);
            float lr_[4], lk_[4], lv_[4];
#pragma unroll
            for (int i = 0; i < 4; ++i) {
                const int tl = 4 * fq + i; LAS const unsigned char* rc = raw + RAWOFF(tl + 1, 0, fr); LAS const unsigned char* rp = raw + RAWOFF(tl, 0, fr);
#define RB(p_, sg_, j_) bf2f(*(LAS const bf16_t*)((p_) + (sg_) * 3072 + (j_) * 32))
                float rr[4], kk[4], vv[4], aa[4], ww[4], kn[4]; float ss = 0.f;
#pragma unroll
                for (int j = 0; j < 4; ++j) {
                    const float cr = RB(rc, 0, j), ck = RB(rc, 1, j), cv = RB(rc, 2, j);
                    const float pr = i == 0 ? RB(rp, 0, j) : lr_[j], pk = i == 0 ? RB(rp, 1, j) : lk_[j], pv_ = i == 0 ? RB(rp, 2, j) : lv_[j];
                    lr_[j] = cr; lk_[j] = ck; lv_[j] = cv;
                    rr[j] = cr + (pr - cr) * cr_[0][j]; kk[j] = ck + (pk - ck) * cr_[1][j]; vv[j] = cv + (pv_ - cv) * cr_[2][j];
                    const float x = cr_[3][j] + Dw[j][i];
                    const float sg = fast_rcp(1.f + fast_exp2(-LOG2E * x));
                    ww[j] = fast_exp2(-0.60653066f * LOG2E * sg);
                    aa[j] = fast_rcp(1.f + fast_exp2(-LOG2E * (cr_[4][j] + Da[j][i])));
                    kn[j] = kk[j] * cr_[5][j]; ss += kn[j] * kn[j];
                }
                ss = red16(ss);
                const float rn = __builtin_amdgcn_rsqf(ss + 1e-12f);
                float bs = 0.f; LAS float* o = opb + tl * OPTOK + fr;
#pragma unroll
                for (int j = 0; j < 4; ++j) {
                    const float knn = kn[j] * rn, kp = kk[j] * (1.f + (aa[j] - 1.f) * cr_[6][j]);
                    bs += rr[j] * kp * cr_[7][j];
                    o[16 * j] = ww[j]; o[64 + 16 * j] = knn; o[128 + 16 * j] = knn * aa[j]; o[192 + 16 * j] = kp; o[256 + 16 * j] = rr[j]; o[320 + 16 * j] = vv[j];
                }
                bs = red16(bs);
                if (fr == 0) bon[tl] = bs;
#undef RB
            }
            st_flag(&flags[par ? F_PRODB : F_PROD], (cgl >> 1) + 1);
            if (c >= 2) POST_CHUNK(c - 2);
        }
        POST_CHUNK(nch - 2 + par);
        wait_ge(&flags[par ? F_PROD : F_PRODB], (unsigned)(nch / 2));
#undef POST_CHUNK
#undef PREP_FETCH
    }
}

DI void prep_simple(PP P, int l, LAS unsigned char* lds, int lane, int seq0, int nseq, bool sample, int dbg) {
    LAS unsigned* flags = (LAS unsigned*)(lds + SC_FLAGS);
    LAS float* Wd = (LAS float*)lds; LAS float* Wa = Wd + 4096;
    LAS float* lor = (LAS float*)(lds + 4 * WK_STRIDE);
    const bf16_t* ub = (const bf16_t*)(P->ws + WS_UB);
    const float* mu = P->in[10] + (size_t)l * SHW;
    unsigned cgl = 0;
    const int nch = sample ? TSS / CH : TP / CH;
    for (int s = 0; s < nseq; ++s) {
        const int seq = seq0 + s, b = seq / 6, h = seq % 6;
        const int kc = h * 64 + lane;
        const float mur = mu[U_R + kc], muk = mu[U_K + kc], muv = mu[U_V + kc], muw = mu[U_WLO + lane], mua = mu[U_ALO + lane];
        const float w0c = P->in[11][(size_t)l * 384 + kc], a0c = P->in[13][(size_t)l * 384 + kc], kkc = P->in[15][(size_t)l * 384 + kc], kac = P->in[16][(size_t)l * 384 + kc], rkc = P->in[17][(size_t)l * 384 + kc];
        const size_t m0 = sample ? (size_t)MP + (size_t)b * TSS : (size_t)b * TP;
        const int T = sample ? TSS : TP;
        const float* sh0 = P->in[8] + (size_t)(l * 32 + b) * SHW;
        { const float* wd = P->in[12] + (size_t)l * 64 * 384 + kc; const float* wa = P->in[14] + (size_t)l * 64 * 384 + kc;
#pragma unroll 4
          for (int i = 0; i < 64; ++i) { Wd[i * 64 + lane] = wd[(size_t)i * 384]; Wa[i * 64 + lane] = wa[(size_t)i * 384]; } }
        float pr = sample ? sh0[U_R + kc] : 0.f, pk = sample ? sh0[U_K + kc] : 0.f, pv = sample ? sh0[U_V + kc] : 0.f, pwl = sample ? sh0[U_WLO + lane] : 0.f, pal = sample ? sh0[U_ALO + lane] : 0.f;
        const bf16_t* row = ub + m0 * NPAD;
        unsigned short n_r = row[U_R + kc], n_k = row[U_K + kc], n_v = row[U_V + kc], n_wl = row[U_WLO + lane], n_al = row[U_ALO + lane];
        for (int c = 0; c < nch; ++c, ++cgl) {
            if (cgl >= 2) {
#pragma unroll
                for (int j = 0; j < 4; ++j) wait_ge(&flags[F_CONS + j], cgl - 1);
            }
            LAS float* opb = (LAS float*)(lds + SC_OP + (cgl & 1) * OPBUF_BYTES);
            LAS float* bon = (LAS float*)(lds + SC_BON + (cgl & 1) * 64);
#pragma unroll 1
            for (int tl = 0; tl < CH; ++tl) {
                const int t = c * CH + tl;
                const float cr = bf2f(n_r), ck = bf2f(n_k), cv = bf2f(n_v), cwl = bf2f(n_wl), cal = bf2f(n_al);
                { const bf16_t* nrow = ub + (m0 + (t + 1 < T ? t + 1 : t)) * NPAD;
                  n_r = nrow[U_R + kc]; n_k = nrow[U_K + kc]; n_v = nrow[U_V + kc]; n_wl = nrow[U_WLO + lane]; n_al = nrow[U_ALO + lane]; }
                const float r = cr + (pr - cr) * mur, k = ck + (pk - ck) * muk, v = cv + (pv - cv) * muv, zw = cwl + (pwl - cwl) * muw, za = cal + (pal - cal) * mua;
                pr = cr; pk = ck; pv = cv; pwl = cwl; pal = cal;
                lor[lane] = 1.f - 2.f * fast_rcp(1.f + fast_exp2(2.f * LOG2E * zw)); lor[64 + lane] = za;
                float dw = 0.f, da = 0.f;
#pragma unroll 2
                for (int i = 0; i < 64; i += 4) { const f32x4 tw = *(LAS const f32x4*)(lor + i), ta = *(LAS const f32x4*)(lor + 64 + i);
#pragma unroll
                    for (int e = 0; e < 4; ++e) { dw += tw[e] * Wd[(i + e) * 64 + lane]; da += ta[e] * Wa[(i + e) * 64 + lane]; } }
                const float x = w0c + dw;
                const float sg = fast_rcp(1.f + fast_exp2(-LOG2E * x));
                const float w = fast_exp2(-0.60653066f * LOG2E * sg);
                const float a = fast_rcp(1.f + fast_exp2(-LOG2E * (a0c + da)));
                const float kn = k * kkc; const float ss = wave_sum(kn * kn);
                const float knn = kn * (1.f / sqrtf(ss + 1e-12f));
                const float kp = k * (1.f + (a - 1.f) * kac);
                const float bs = wave_sum(r * kp * rkc);
                LAS float* o = opb + tl * OPTOK + lane;
                o[0] = w; o[64] = knn; o[128] = knn * a; o[192] = kp; o[256] = r; o[320] = v;
                if (lane == 0) bon[tl] = bs;
            }
            st_flag(&flags[F_PROD], cgl + 1);
        }
    }
}

DI void post_wave(PP P, int l, LAS unsigned char* lds, int lane, int seq0, int nseq, bool sample, int dbg) {
    const int r16 = lane & 15, tq = lane >> 4;
    LAS unsigned* flags = (LAS unsigned*)(lds + SC_FLAGS);
    const bf16_t* ub = (const bf16_t*)(P->ws + WS_UB); bf16_t* ob = (bf16_t*)(P->ws + WS_OB);
    unsigned cgl = 0;
    const int nch = sample ? TSS / CH : TP / CH;
    for (int s = 0; s < nseq; ++s) {
        const int seq = seq0 + s, b = seq / 6, h = seq % 6;
        const size_t m0 = sample ? (size_t)MP + (size_t)b * TSS : (size_t)b * TP;
        const f32x4 g4 = *(const f32x4*)(P->in[18] + (size_t)l * 384 + h * 64 + 4 * r16), b4 = *(const f32x4*)(P->in[19] + (size_t)l * 384 + h * 64 + 4 * r16);
        for (int c = 0; c < nch; ++c, ++cgl) {
            if (dbg & 1) { for (int j = 0; j < 4; ++j) wait_ge(&flags[F_CONS + j], cgl + 1); st_flag(&flags[F_POST], cgl + 1); continue; }
            u32x2 gwv[4];
#pragma unroll
            for (int i = 0; i < 4; ++i) gwv[i] = *(const u32x2*)(ub + (m0 + c * CH + 4 * i + tq) * NPAD + U_GA + h * 64 + 4 * r16);
#pragma unroll
            for (int j = 0; j < 4; ++j) wait_ge(&flags[F_CONS + j], cgl + 1);
            LAS const float* yb = (LAS const float*)(lds + SC_Y + (cgl & 1) * YBUF_BYTES);
#pragma unroll
            for (int i = 0; i < 4; ++i) {
                const int tl = 4 * i + tq; const size_t m = m0 + c * CH + tl;
                const f32x4 y4 = *(LAS const f32x4*)(yb + tl * 128 + 4 * r16), bv4 = *(LAS const f32x4*)(yb + tl * 128 + 64 + 4 * r16);
                const u32x2 gw = gwv[i];
                const float mean = red16((y4[0] + y4[1]) + (y4[2] + y4[3])) * (1.f / 64.f);
                const f32x4 d = y4 - mean;
                const float var = red16((d[0] * d[0] + d[1] * d[1]) + (d[2] * d[2] + d[3] * d[3])) * (1.f / 64.f);
                const float rstd = 1.f / sqrtf(var + GN_EPS);
                f32x4 o = d * rstd * g4 + b4 + bv4;
                o[0] *= siluf_(bflo(gw.x)); o[1] *= siluf_(bfhi(gw.x)); o[2] *= siluf_(bflo(gw.y)); o[3] *= siluf_(bfhi(gw.y));
                u32x2 w; w.x = cvtpk(o[0], o[1]); w.y = cvtpk(o[2], o[3]);
                if (!(dbg & 256)) *(u32x2*)(ob + m * DM + h * 64 + 4 * r16) = w;
            }
            st_flag(&flags[F_POST], cgl + 1);
        }
    }
}

DI void naive_seq(PP P, int l, LAS unsigned char* sl, int lane, int b, int h, bool sample) {
    LAS float* opl = (LAS float*)sl;
    LAS float* lor = opl + 384;
    const bf16_t* ub = (const bf16_t*)(P->ws + WS_UB); bf16_t* ob = (bf16_t*)(P->ws + WS_OB);
    const float* mu = P->in[10] + (size_t)l * SHW;
    const int kc = h * 64 + lane;
    const float mur = mu[U_R + kc], muk = mu[U_K + kc], muv = mu[U_V + kc], muw = mu[U_WLO + lane], mua = mu[U_ALO + lane];
    const float w0c = P->in[11][(size_t)l * 384 + kc], a0c = P->in[13][(size_t)l * 384 + kc], kkc = P->in[15][(size_t)l * 384 + kc], kac = P->in[16][(size_t)l * 384 + kc], rkc = P->in[17][(size_t)l * 384 + kc];
    const float gng = P->in[18][(size_t)l * 384 + kc], gnb = P->in[19][(size_t)l * 384 + kc];
    const size_t m0 = sample ? (size_t)MP + (size_t)b * TSS : (size_t)b * TP;
    const int T = sample ? TSS : TP;
    const float* sh0 = P->in[8] + (size_t)(l * 32 + b) * SHW;
    LAS float* Wd = opl + 512; LAS float* Wa = Wd + 4096;
    { const float* wd = P->in[12] + (size_t)l * 64 * 384 + kc; const float* wa = P->in[14] + (size_t)l * 64 * 384 + kc;
#pragma unroll 4
      for (int i = 0; i < 64; ++i) { Wd[i * 64 + lane] = wd[(size_t)i * 384]; Wa[i * 64 + lane] = wa[(size_t)i * 384]; } }
    float S[64];
    if (sample) { const float* sp = P->in[7] + ((size_t)((l * 32 + b) * 6 + h) * 64 + lane) * 64;
#pragma unroll
        for (int k = 0; k < 64; ++k) S[k] = sp[k]; }
    else {
#pragma unroll
        for (int k = 0; k < 64; ++k) S[k] = 0.f; }
    float pr = sample ? sh0[U_R + kc] : 0.f, pk = sample ? sh0[U_K + kc] : 0.f, pv = sample ? sh0[U_V + kc] : 0.f, pwl = sample ? sh0[U_WLO + lane] : 0.f, pal = sample ? sh0[U_ALO + lane] : 0.f;
    const bf16_t* row = ub + m0 * NPAD;
    unsigned short n_r = row[U_R + kc], n_k = row[U_K + kc], n_v = row[U_V + kc], n_wl = row[U_WLO + lane], n_al = row[U_ALO + lane], n_g = row[U_GA + kc];
#pragma unroll 1
    for (int t = 0; t < T; ++t) {
        const float cr = bf2f(n_r), ck = bf2f(n_k), cv = bf2f(n_v), cwl = bf2f(n_wl), cal = bf2f(n_al), cg = bf2f(n_g);
        { const bf16_t* nrow = ub + (m0 + (t + 1 < T ? t + 1 : t)) * NPAD;
          n_r = nrow[U_R + kc]; n_k = nrow[U_K + kc]; n_v = nrow[U_V + kc]; n_wl = nrow[U_WLO + lane]; n_al = nrow[U_ALO + lane]; n_g = nrow[U_GA + kc]; }
        const float r = cr + (pr - cr) * mur, k = ck + (pk - ck) * muk, v = cv + (pv - cv) * muv, zw = cwl + (pwl - cwl) * muw, za = cal + (pal - cal) * mua;
        pr = cr; pk = ck; pv = cv; pwl = cwl; pal = cal;
        lor[lane] = tanhf(zw); lor[64 + lane] = za;
        float dw = 0.f, da = 0.f;
#pragma unroll 1
        for (int i = 0; i < 64; i += 4) { const f32x4 tw = *(LAS const f32x4*)(lor + i), ta = *(LAS const f32x4*)(lor + 64 + i);
#pragma unroll
            for (int e = 0; e < 4; ++e) { dw += tw[e] * Wd[(i + e) * 64 + lane]; da += ta[e] * Wa[(i + e) * 64 + lane]; } }
        const float x = w0c + dw;
        const float wlog = -log1pf(expf(-x)) - 0.5f;
        const float w = expf(-expf(wlog));
        const float a = 1.f / (1.f + expf(-(a0c + da)));
        const float kn = k * kkc; const float ss = wave_sum(kn * kn);
        const float knn = kn * (1.f / sqrtf(ss + 1e-12f));
        const float kp = k * (1.f + (a - 1.f) * kac);
        const float bs = wave_sum(r * kp * rkc);
        opl[lane] = w; opl[64 + lane] = knn; opl[128 + lane] = knn * a; opl[192 + lane] = kp; opl[256 + lane] = r; opl[320 + lane] = v;
        const float vv = v;
        float sa = 0.f;
#pragma unroll
        for (int i = 0; i < 64; i += 4) { const f32x4 q = *(LAS const f32x4*)(opl + 64 + i);
#pragma unroll
            for (int e = 0; e < 4; ++e) sa += S[i + e] * q[e]; }
        float y = 0.f;
#pragma unroll
        for (int i = 0; i < 64; i += 4) { const f32x4 qw = *(LAS const f32x4*)(opl + i), qa = *(LAS const f32x4*)(opl + 128 + i), qk = *(LAS const f32x4*)(opl + 192 + i), qr = *(LAS const f32x4*)(opl + 256 + i);
#pragma unroll
            for (int e = 0; e < 4; ++e) { S[i + e] = S[i + e] * qw[e] - sa * qa[e] + vv * qk[e]; y += S[i + e] * qr[e]; } }
        const float mean = wave_sum(y) * (1.f / 64.f); const float d = y - mean;
        const float var = wave_sum(d * d) * (1.f / 64.f);
        float o = d * (1.f / sqrtf(var + GN_EPS)) * gng + gnb + bs * vv;
        o *= cg / (1.f + expf(-cg));
        ob[(m0 + t) * DM + kc] = (bf16_t)(cvtpk(o, o) & 0xffffu);
        asm volatile("" ::: "memory");
    }
    float* so = P->out + (sample ? O_SWKV : O_PWKV) + ((size_t)((l * 32 + b) * 6 + h) * 64 + lane) * 64;
#pragma unroll
    for (int k = 0; k < 64; k += 4) *(f32x4*)(so + k) = (f32x4){S[k], S[k + 1], S[k + 2], S[k + 3]};
}

DI bf16x8 ld_bf16x8(const bf16_t* p) { return *(const bf16x8*)p; }
DI bf16x8 cvt_f32x8(const float* p) { const f32x4 a = *(const f32x4*)p, b = *(const f32x4*)(p + 4); u32x4 w; w.x = cvtpk(a[0], a[1]); w.y = cvtpk(a[2], a[3]); w.z = cvtpk(b[0], b[1]); w.w = cvtpk(b[2], b[3]); return __builtin_bit_cast(bf16x8, w); }
DI bf16x8 pack8(const f32x16& x, int s) { u32x4 w; w.x = cvtpk(x[8 * s], x[8 * s + 1]); w.y = cvtpk(x[8 * s + 2], x[8 * s + 3]); w.z = cvtpk(x[8 * s + 4], x[8 * s + 5]); w.w = cvtpk(x[8 * s + 6], x[8 * s + 7]); return __builtin_bit_cast(bf16x8, w); }
DI bf16x8 vfrag(LAS const unsigned char* p) {
    const v4i16_t lo = __builtin_amdgcn_ds_read_tr16_b64_v4i16((LAS v4i16_t*)p), hi = __builtin_amdgcn_ds_read_tr16_b64_v4i16((LAS v4i16_t*)(p + 512));
    return (bf16x8){lo[0], lo[1], lo[2], lo[3], hi[0], hi[1], hi[2], hi[3]};
}

struct AttnState { f32x16 o0, o1; float m_run, l_run, carry; };

template <int KIND, bool F32>
DI void attn_tile(AttnState& st, const bf16x8 (&qr)[4], bf16x8 (&kf)[4], f32x4 (&kq)[8], bf16x8 (&vr)[4], f32x4 (&vq)[8], const char* knext, const char* vnext, unsigned vpitch16, float lf, bool diag, LAS unsigned char* wl, int lane) {
    const int r32 = lane & 31, hi = lane >> 5;
    LAS float* sm = (LAS float*)(wl + 8192);
#pragma unroll
    for (int pc = 0; pc < 4; ++pc) {
        if (F32) { u32x4 x; x.x = cvtpk(vq[2 * pc][0], vq[2 * pc][1]); x.y = cvtpk(vq[2 * pc][2], vq[2 * pc][3]); x.z = cvtpk(vq[2 * pc + 1][0], vq[2 * pc + 1][1]); x.w = cvtpk(vq[2 * pc + 1][2], vq[2 * pc + 1][3]);
            *(LAS u32x4*)(wl + pc * 1024 + lane * 16) = x; }
        else *(LAS bf16x8*)(wl + pc * 1024 + lane * 16) = vr[pc];
    }
#pragma unroll
    for (int pc = 0; pc < 4; ++pc) {
        if (F32) { const char* p_ = vnext + (size_t)((pc & 1) * vpitch16 + (pc >> 1) * 128); vq[2 * pc] = *(const f32x4*)p_; vq[2 * pc + 1] = *(const f32x4*)(p_ + 16); }
        else vr[pc] = *(const bf16x8*)(vnext + pc * 1024);
    }
    if (F32) {
#pragma unroll
        for (int i = 0; i < 4; ++i) { u32x4 w; w.x = cvtpk(kq[2 * i][0], kq[2 * i][1]); w.y = cvtpk(kq[2 * i][2], kq[2 * i][3]); w.z = cvtpk(kq[2 * i + 1][0], kq[2 * i + 1][1]); w.w = cvtpk(kq[2 * i + 1][2], kq[2 * i + 1][3]);
            kf[i] = __builtin_bit_cast(bf16x8, w); }
    }
    f32x16 p = {};
#pragma unroll
    for (int d0 = 0; d0 < 4; ++d0) p = MFMA32(kf[d0], qr[d0], p);
    asm volatile("" : "+v"(p));
    LAS const unsigned char* vb = wl + ((lane >> 4) & 1) * 32 + (lane & 3) * 8 + (4 * hi + ((lane & 15) >> 2)) * 64;
    const bf16x8 vf0 = vfrag(vb + 0 * 1024), vf1 = vfrag(vb + 1 * 1024), vf2 = vfrag(vb + 2 * 1024), vf3 = vfrag(vb + 3 * 1024);
    if (F32) {
#pragma unroll
        for (int d0 = 0; d0 < 4; ++d0) { kq[2 * d0] = *(const f32x4*)(knext + 64 * d0); kq[2 * d0 + 1] = *(const f32x4*)(knext + 64 * d0 + 16); }
    } else {
#pragma unroll
        for (int d0 = 0; d0 < 4; ++d0) kf[d0] = *(const bf16x8*)(knext + d0 * 1024);
    }
    if (KIND == 0) {
        float incl = lf;
#pragma unroll
        for (int off = 1; off < 32; off <<= 1) { const float t = __shfl_down(incl, off, 32); if (r32 + off < 32) incl += t; }
        const float bias = (st.carry + (incl - lf)) * LOG2E;
        const float tot = __shfl(incl, 0, 32);
        if (hi == 0) sm[r32] = bias;
        st.carry += tot;
        float s[16];
#pragma unroll
        for (int g = 0; g < 4; ++g) { const f32x4 b4 = *(LAS const f32x4*)(sm + 8 * g + 4 * hi);
#pragma unroll
            for (int e = 0; e < 4; ++e) s[4 * g + e] = p[4 * g + e] * QSCALE2 + b4[e]; }
        if (diag) {
#pragma unroll
            for (int r = 0; r < 16; ++r) if (crow(r, hi) > r32) s[r] = -1e30f;
        }
        if (diag) {
            float mt = s[0];
#pragma unroll
            for (int r = 1; r < 16; ++r) mt = fmaxf(mt, s[r]);
            { auto rr = __builtin_amdgcn_permlane32_swap(__float_as_uint(mt), __float_as_uint(mt), false, false); mt = fmaxf(__uint_as_float(rr[0]), __uint_as_float(rr[1])); }
            st.m_run = mt;
        }
        float ls = 0.f;
#pragma unroll
        for (int r = 0; r < 16; ++r) { p[r] = fast_exp2(s[r] - st.m_run); ls += p[r]; }
        st.l_run += ls;
    } else {
        float be[16], om[16];
#pragma unroll
        for (int r = 0; r < 16; ++r) {
            const float z2 = fmaxf(p[r] * QSCALE2, -80.f);
            const float e = fast_exp2(-z2); const float bt = fast_rcp(1.f + e);
            be[r] = bt; om[r] = e * bt;
        }
        if (diag) {
#pragma unroll
            for (int r = 0; r < 16; ++r) if (crow(r, hi) >= r32) { be[r] = 0.f; om[r] = 1.f; }
        }
        float H[4], oth[4];
#pragma unroll
        for (int g = 0; g < 4; ++g) { const float gp = (om[4 * g] * om[4 * g + 1]) * (om[4 * g + 2] * om[4 * g + 3]);
            auto rr = __builtin_amdgcn_permlane32_swap(__float_as_uint(gp), __float_as_uint(gp), false, false);
            const float a = __uint_as_float(rr[0]), b = __uint_as_float(rr[1]); H[g] = a * b; oth[g] = hi ? 1.f : b; }
        float suf[4]; suf[3] = 1.f; suf[2] = H[3]; suf[1] = H[3] * H[2]; suf[0] = suf[1] * H[1];
        const float cin = st.carry;
#pragma unroll
        for (int g = 0; g < 4; ++g) {
            float A = cin * suf[g] * oth[g];
            p[4 * g + 3] = be[4 * g + 3] * A; A *= om[4 * g + 3];
            p[4 * g + 2] = be[4 * g + 2] * A; A *= om[4 * g + 2];
            p[4 * g + 1] = be[4 * g + 1] * A; A *= om[4 * g + 1];
            p[4 * g + 0] = be[4 * g + 0] * A;
        }
        st.carry = cin * suf[0] * H[0];
    }
    const bf16x8 pa0 = pack8(p, 0), pa1 = pack8(p, 1);
    st.o0 = MFMA32(pa0, vf0, st.o0);
    st.o0 = MFMA32(pa1, vf1, st.o0);
    st.o1 = MFMA32(pa0, vf2, st.o1);
    st.o1 = MFMA32(pa1, vf3, st.o1);
    if (F32) {
#pragma unroll
        for (int i = 0; i < 8; ++i) { asm volatile("" : "+v"(kq[i])); asm volatile("" : "+v"(vq[i])); }
    } else {
#pragma unroll
        for (int i = 0; i < 4; ++i) { asm volatile("" : "+v"(kf[i])); asm volatile("" : "+v"(vr[i])); }
    }
}

template <int KIND>
DI void attn_item(PP P, int l, LAS unsigned char* wl, int lane, bool sample, int b, int h, int qb) {
    const int r32 = lane & 31, hi = lane >> 5;
    const char* ubb = (const char*)(P->ws + WS_UB);
    constexpr unsigned PITCH = NPAD * 2;
    constexpr int NH = KIND == 0 ? NHB : NHC;
    constexpr int QC = KIND == 0 ? U_QB : U_QC, KC = KIND == 0 ? U_KB : U_KC, VC = KIND == 0 ? U_VB : U_VC, GC = KIND == 0 ? U_GB : U_GC, OC = KIND == 0 ? 384 : 768;
    const int q0 = qb * 32, past = sample ? PAST : 0;
    const unsigned row0 = sample ? (unsigned)(MP + b * TSS) : (unsigned)(b * TP);
    const unsigned kl = (unsigned)(r32 * NPAD + KC + h * 64 + 8 * hi) * 2u;
    const unsigned vl = (unsigned)((lane >> 2) * NPAD + VC + h * 64 + (lane & 3) * 8) * 2u;
    bf16x8 qr[4];
    { const char* qp = ubb + (size_t)((row0 + q0) * PITCH + (unsigned)(r32 * NPAD + QC + h * 64 + 8 * hi) * 2u);
#pragma unroll
      for (int d0 = 0; d0 < 4; ++d0) qr[d0] = *(const bf16x8*)(qp + 32 * d0); }
    AttnState st; st.o0 = f32x16{}; st.o1 = f32x16{}; st.m_run = -1e30f; st.l_run = 0.f; st.carry = KIND == 0 ? 0.f : 1.f;
    const int tdiag = (past + q0) / 32, tnew0 = past / 32;
    const float* logf = (const float*)(P->ws + WS_LOGF) + h;
    bf16x8 kf[4], vr[4]; f32x4 kq[8], vq[8];
    {
        const unsigned tix0 = sample ? (unsigned)(32 * NH * 64 + (b * NH + h) * 2) : (unsigned)((b * NH + h) * 64);
        const char* kbb = (const char*)(P->ws + (KIND == 0 ? WS_BFK : WS_BSK)) + (size_t)tix0 * 4096 + lane * 16;
        const char* vbb = (const char*)(P->ws + (KIND == 0 ? WS_BFV : WS_BSV)) + (size_t)tix0 * 4096 + lane * 16;
        float lf = 0.f;
        { const unsigned tl_ = (unsigned)(tdiag - tnew0); const unsigned trow_ = row0 + tl_ * 32u;
#pragma unroll
          for (int d0 = 0; d0 < 4; ++d0) kf[d0] = *(const bf16x8*)(kbb + (size_t)(tl_ * 4096u) + d0 * 1024);
#pragma unroll
          for (int pc = 0; pc < 4; ++pc) vr[pc] = *(const bf16x8*)(vbb + (size_t)(tl_ * 4096u) + pc * 1024);
          if (KIND == 0) lf = logf[(size_t)(trow_ + r32) * 8]; }
        for (int tile = tdiag; tile >= tnew0; --tile) {
            const unsigned tn = (unsigned)((tile > tnew0 ? tile - 1 : tnew0) - tnew0);
            const unsigned trow_ = row0 + tn * 32u;
            const float lfc = lf;
            if (KIND == 0) lf = logf[(size_t)(trow_ + r32) * 8];
            attn_tile<KIND, false>(st, qr, kf, kq, vr, vq, kbb + (size_t)(tn * 4096u), vbb + (size_t)(tn * 4096u), 0u, lfc, tile == tdiag, wl, lane);
        }
    }
    if (sample) {
        const char* cK = (const char*)(P->in[KIND == 0 ? 2 : 5] + (size_t)(l * 32 + b) * PAST * NH * 64 + h * 64);
        const char* cV = (const char*)(P->in[KIND == 0 ? 3 : 6] + (size_t)(l * 32 + b) * PAST * NH * 64 + h * 64);
        const float* cL = P->in[4] + (size_t)(l * 32 + b) * PAST * 6 + h;
        constexpr unsigned CP = NH * 64 * 4;
        const unsigned klc = (unsigned)r32 * CP + 32u * hi, vlc = (unsigned)(lane >> 2) * CP + 32u * (lane & 3);
        float lf = 0.f;
        { const char* kb_ = cK + (size_t)((unsigned)(tnew0 - 1) * 32u * CP) + klc;
#pragma unroll
          for (int d0 = 0; d0 < 4; ++d0) { kq[2 * d0] = *(const f32x4*)(kb_ + 64 * d0); kq[2 * d0 + 1] = *(const f32x4*)(kb_ + 64 * d0 + 16); }
          const char* vb_ = cV + (size_t)((unsigned)(tnew0 - 1) * 32u * CP) + vlc;
#pragma unroll
          for (int pc = 0; pc < 4; ++pc) { const char* p_ = vb_ + (size_t)((pc & 1) * (16u * CP) + (pc >> 1) * 128); vq[2 * pc] = *(const f32x4*)p_; vq[2 * pc + 1] = *(const f32x4*)(p_ + 16); }
          if (KIND == 0) lf = cL[(size_t)((tnew0 - 1) * 32 + r32) * 6]; }
        for (int tile = tnew0 - 1; tile >= 0; --tile) {
            const int tn = tile > 0 ? tile - 1 : 0;
            const float lfc = lf;
            if (KIND == 0) lf = cL[(size_t)(tn * 32 + r32) * 6];
            attn_tile<KIND, true>(st, qr, kf, kq, vr, vq, cK + (size_t)((unsigned)tn * 32u * CP) + klc, cV + (size_t)((unsigned)tn * 32u * CP) + vlc, 16u * CP, lfc, false, wl, lane);
        }
    }
    LAS float* stg = (LAS float*)wl; LAS float* sm = (LAS float*)(wl + 8192);
    if (KIND == 0) {
        auto rr = __builtin_amdgcn_permlane32_swap(__float_as_uint(st.l_run), __float_as_uint(st.l_run), false, false);
        const float lt = __uint_as_float(rr[0]) + __uint_as_float(rr[1]);
        if (hi == 0) sm[r32] = 1.f / lt;
    }
#pragma unroll
    for (int r = 0; r < 16; ++r) { stg[crow(r, hi) * 64 + r32] = st.o0[r]; stg[crow(r, hi) * 64 + 32 + r32] = st.o1[r]; }
    char* obb = (char*)(P->ws + WS_OB);
#pragma unroll
    for (int i = 0; i < 4; ++i) {
        const int row = i * 8 + (lane >> 3), chn = lane & 7;
        const f32x4 a = *(LAS const f32x4*)(stg + row * 64 + chn * 8), c = *(LAS const f32x4*)(stg + row * 64 + chn * 8 + 4);
        const float li = KIND == 0 ? sm[row] : 1.f;
        const unsigned m = row0 + q0 + row;
        const u32x4 g = *(const u32x4*)(ubb + (size_t)(m * PITCH + (unsigned)(GC + h * 64 + chn * 8) * 2u));
        u32x4 w;
        w.x = cvtpk(a[0] * li * siluf_(bflo(g.x)), a[1] * li * siluf_(bfhi(g.x))); w.y = cvtpk(a[2] * li * siluf_(bflo(g.y)), a[3] * li * siluf_(bfhi(g.y)));
        w.z = cvtpk(c[0] * li * siluf_(bflo(g.z)), c[1] * li * siluf_(bfhi(g.z))); w.w = cvtpk(c[2] * li * siluf_(bflo(g.w)), c[3] * li * siluf_(bfhi(g.w)));
        *(u32x4*)(obb + (size_t)(m * (DM * 2) + (unsigned)(OC + h * 64 + chn * 8) * 2u)) = w;
    }
}

constexpr int Q_SAMPLE = 2 * (16 + 24), Q_ITEMS = Q_SAMPLE + 40 * 64;
DI unsigned xcc_id() { return (unsigned)__builtin_amdgcn_s_getreg((3 << 11) | 20) & 7u; }
DI void worker_loop(PP P, int l, int lq, LAS unsigned char* lds, int wave, int lane) {
    LAS unsigned char* wl = lds + wave * WK_STRIDE;
    unsigned* qbase = (unsigned*)(P->ws + WS_CTL) + 64 + lq * 128;
    const unsigned x0 = xcc_id();
    for (unsigned sx = 0; sx < 8; ++sx) {
        const unsigned x = (x0 + sx) & 7u;
        unsigned* qctr = qbase + x * 16;
        for (;;) {
            unsigned idx = 0;
            if (lane == 0) idx = atomicAdd(qctr, 1u);
            idx = (unsigned)__builtin_amdgcn_readfirstlane((int)idx);
            if (idx >= (unsigned)Q_ITEMS) break;
            int kind, smp, bh, qb;
            if (idx < (unsigned)Q_SAMPLE) {
                smp = 1;
                if (idx < 32u) { kind = 1; bh = (int)x + 8 * (int)(idx >> 1); qb = idx & 1; }
                else { const int i2 = idx - 32; kind = 0; bh = (int)x + 8 * (i2 >> 1); qb = i2 & 1; }
            } else {
                smp = 0;
                const int i2 = idx - Q_SAMPLE, g = i2 >> 6; qb = 63 - (i2 & 63);
                if (g < 16) { kind = 1; bh = (int)x + 8 * g; } else { kind = 0; bh = (int)x + 8 * (g - 16); }
            }
            if (kind) attn_item<1>(P, l, wl, lane, smp != 0, bh / NHC, bh % NHC, qb);
            else attn_item<0>(P, l, wl, lane, smp != 0, bh / NHB, bh % NHB, qb);
        }
    }
}

DI void phase_mix(PP P, int lq, LAS unsigned char* lds, int wave, int lane, int bidx, int gdim) {
    const int l = lq & 1; const int dbg = (lq & 2) ? (P->dbg | 256) : 0;
    if (wave == 0 && lane < 16) ((LAS unsigned*)(lds + SC_FLAGS))[lane] = 0u;
    __syncthreads();
    const int bx = bidx;
#ifdef NAIVE_SCAN
    if (wave == 0) {
        for (int sq = bx; sq < 384; sq += gdim) {
            if (sq < 192) naive_seq(P, l, lds + SC_OFF, lane, sq / 6, sq % 6, false);
            else naive_seq(P, l, lds + SC_OFF, lane, (sq - 192) / 6, (sq - 192) % 6, true);
        }
    }
#else
    if (gdim >= 256 && !(dbg & 16)) {
        if (bx < 192) {
#ifndef SK_SCAN
            if (wave < 4) scan_wave(P, l, lds, wave, lane, bx, 1, false, dbg, true);
#endif
#ifndef SK_PREP
            if (wave == 4 || wave == 5) helper2_wave(P, l, lds, lane, bx, wave - 4, dbg);
#endif
        } else if (bx < 256) {
            const int s0 = (bx - 192) * 3;
#ifndef SK_SCAN
            if (wave < 4) scan_wave(P, l, lds, wave, lane, s0, 3, true, dbg);
#endif
#ifndef SK_PREP
            if (wave == 4) PREPFN(P, l, lds, lane, s0, 3, true, dbg);
#endif
#ifndef SK_POST
            if (wave == 5) post_wave(P, l, lds, lane, s0, 3, true, dbg);
#endif
        }
    }
#endif
#ifndef SK_WORK
    if (!(dbg & 4)) worker_loop(P, l, lq, lds, wave, lane);
#endif
}

__global__ void __launch_bounds__(512, 2) fwd_kernel(Params Pv) {
    extern __shared__ __attribute__((aligned(16))) unsigned char lds_raw[];
    LAS unsigned char* lds = (LAS unsigned char*)lds_raw;
    const int tid = threadIdx.x, lane0 = tid & 63, wave0 = __builtin_amdgcn_readfirstlane(tid >> 6);
    PP P0 = (PP)__builtin_amdgcn_kernarg_segment_ptr();
    const int lo = Pv.ph_lo, hi = Pv.ph_hi;
    const int rep_ph = Pv.rep_ph;
#pragma unroll 1
    for (int ph2 = lo * 2; ph2 < hi * 2; ++ph2) {
        const int ph = ph2 >> 1, rep = ph2 & 1;
        if (rep && ph != rep_ph) continue;
        PP P = pp_launder(P0);
        int lane = lane0, wave = wave0, bidx = (int)blockIdx.x, gdim = (int)gridDim.x;
        asm volatile("" : "+v"(lane)); asm volatile("" : "+s"(wave)); asm volatile("" : "+s"(bidx)); asm volatile("" : "+s"(gdim));
        if (ph == 0) {
#ifndef SK_P0
            phase0(P, lds, wave, lane, bidx, gdim);
#endif
        } else {
            const int l = (ph - 1) >> 2, k = (ph - 1) & 3;
            if (k == 0 || k == 2) {
#ifndef SK_G1
                pg8::Gemm g; pg8::StaticOrder S; EpiU E;
                E.ws = P->ws; E.out = P->out; E.fb = P->in[20] + l * 6; E.l = l; E.mode = k;
                if (k == 0) { g = pg8::Gemm{(const bf16_t*)(P->ws + WS_XB), (const bf16_t*)(P->ws + WS_WIN) + (size_t)l * NPAD * DM, MT, NPAD, DM}; S.init(MT, NPAD, gdim, bidx); }
                else { g = pg8::Gemm{(const bf16_t*)(P->ws + WS_OB), (const bf16_t*)(P->ws + WS_WOUT) + (size_t)l * DM * DM, MT, DM, DM}; S.init(MT, DM, gdim, bidx); }
                pg8::gemm_phase<EpiU, pg8::StaticOrder, true, true>(lds, g, S, E);
#endif
            } else if (k == 1) {
#ifndef SK_MIX
                phase_mix(P, l + 2 * rep, lds, wave, lane, bidx, gdim);
#endif
            } else {
#ifndef SK_LN
                phase_ln(P, l, wave, lane, bidx, gdim);
#endif
            }
        }
        if (ph2 + 1 < hi * 2) cg::this_grid().sync();
    }
}

extern "C" void kernel_launch(void* const* d_in, const int* in_sizes, int n_in, void* d_out, int out_size, void* d_ws, size_t ws_size, hipStream_t stream) {
    static int grid = 0;
    if (grid == 0) {
        if (n_in != 24 || (size_t)out_size != O_END || ws_size < WS_END) { fprintf(stderr, "kernel_launch: unexpected shapes n_in %d out %d ws %zu\n", n_in, out_size, ws_size); grid = -1; return; }
        int dev = 0, cus = 0, per_cu = 0;
        (void)hipGetDevice(&dev); (void)hipDeviceGetAttribute(&cus, hipDeviceAttributeMultiprocessorCount, dev);
        if (hipFuncSetAttribute((const void*)fwd_kernel, hipFuncAttributeMaxDynamicSharedMemorySize, LDS_BYTES) != hipSuccess) { fprintf(stderr, "kernel_launch: hipFuncSetAttribute failed\n"); grid = -1; return; }
        if (hipOccupancyMaxActiveBlocksPerMultiprocessor(&per_cu, (const void*)fwd_kernel, 512, LDS_BYTES) != hipSuccess || per_cu < 1) { fprintf(stderr, "kernel_launch: occupancy query says %d\n", per_cu); per_cu = 1; }
        (void)hipGetLastError();
        grid = cus * 1;
        if (grid != 256) fprintf(stderr, "kernel_launch: grid %d (expected 256)\n", grid);
    }
    if (grid < 0) return;
    (void)hipMemsetAsync((char*)d_ws + WS_CTL, 0, CTL_BYTES, stream);
    Params p{};
    for (int i = 0; i < 24; ++i) p.in[i] = (const float*)d_in[i];
    p.out = (float*)d_out; p.ws = (unsigned char*)d_ws; p.ph_lo = 0; p.ph_hi = 9; p.rep_ph = -1; p.dbg = 0;
    void* args[] = {&p};
    hipError_t e = hipLaunchCooperativeKernel((const void*)fwd_kernel, dim3(grid), dim3(512), args, LDS_BYTES, stream);
    if (e != hipSuccess) fprintf(stderr, "cooperative launch failed: %s (grid %d)\n", hipGetErrorString(e), grid);
}
```

```cpp
#define PREPFN prep_wave
#include <hip/hip_runtime.h>
#include <hip/hip_cooperative_groups.h>
#include <cstdio>
#include <cstdint>
namespace cg = cooperative_groups;
namespace pg8 {
#define PG8_LAS __attribute__((address_space(3)))
typedef unsigned short bf16_t;
typedef short bf16x8 __attribute__((ext_vector_type(8)));
typedef float f32x4 __attribute__((ext_vector_type(4)));
typedef unsigned u32x4 __attribute__((ext_vector_type(4)));
constexpr int BM = 256, BK = 64, HALF = 128, HTB = HALF * BK * 2  , STAGE_BYTES = 8 * HTB, NXCD = 8, WGM = 8;

__host__ __device__ __forceinline__ int lds_byte(int r, int c) { const int st = (r >> 4) * 2 + (c >> 5), rr = r & 15, cc = c & 31, ob = rr * 64 + cc * 2; return st * 1024 + (ob ^ (((ob >> 9) & 1) << 5)); }
__host__ __device__ __forceinline__ void stage_rc(int b, int& R, int& C) { const int st = b / 1024, sb = b % 1024, swz = sb ^ (((sb >> 9) & 1) << 5); R = (st >> 1) * 16 + swz / 64; C = (st & 1) * 32 + (swz % 64) / 2; }
__host__ __device__ __forceinline__ int perm32(int rho) { const int n = rho >> 4, i = rho & 15; return 8 * (i >> 2) + 4 * n + (i & 3); }

struct Unit { int pm, pn; };
struct Gemm { const bf16_t* A; const bf16_t* Bt; int M, N, K; };

struct StaticOrder {
    int nM, nN, nwg, G, c;
    __host__ __device__ void init(int M, int N, int G_, int c_) { nM = M / BM; nN = N / BM; nwg = nM * nN; G = G_; c = c_; }
    __host__ __device__ bool next(int i, Unit& u) const {
        const long L = (long)i * G + c; if (L >= nwg) return false;
        int wgid = (int)L; { const int q = nwg / NXCD, r = nwg % NXCD, xcd = wgid % NXCD, off = wgid / NXCD; wgid = (xcd < r ? xcd * (q + 1) : r * (q + 1) + (xcd - r) * q) + off; }
        const int nig = WGM * nN, gid = wgid / nig, fm = gid * WGM, gsz = (nM - fm) < WGM ? (nM - fm) : WGM;
        u.pm = fm + ((wgid % nig) % gsz); u.pn = (wgid % nig) / gsz; return true;
    }
    __device__ __forceinline__ void a_ready(const Unit&) const {}
    __device__ __forceinline__ void done(const Unit&) const {}
};

template <class Epi, class Sched, bool ALIGN_EPI = false, bool SP2 = false>
__device__ __forceinline__ void gemm_phase(PG8_LAS unsigned char* lds, const Gemm g, const Sched& S, const Epi& E) {
    int tid_ = threadIdx.x; asm volatile("" : "+v"(tid_));
    const int tid = tid_, wid = __builtin_amdgcn_readfirstlane(tid >> 6), lane = tid & 63, wr = wid >> 2, wc = wid & 3, fr = lane & 15, fq = lane >> 4;
    const int K = g.K, nt = K / BK;
    unsigned voffA[2], voffB[2];
#pragma unroll
    for (int i = 0; i < 2; ++i) { int R, C; stage_rc(tid * 16 + i * 8192, R, C); const int Rb = Epi::PERM ? ((R & ~31) + perm32(R & 31)) : R;
        voffA[i] = (unsigned)(R * K + C) * 2u; voffB[i] = (unsigned)(Rb * K + C) * 2u; }
    const size_t kstep = (size_t)(BK * 2);
    const size_t hstep = (size_t)HALF * K * 2;
    const size_t tstep = 2 * hstep;
    const unsigned ldsw = (unsigned)wid * 1024u;
    const int aoff = lds_byte(wr * 64 + fr, fq * 8), boff = lds_byte(wc * 32 + fr, fq * 8);
#define PG8_SA(b, h) (((b) * 2 + (h)) * HTB)
#define PG8_SB(b, h) ((4 + (b) * 2 + (h)) * HTB)
#define PG8_STAGE(bufoff, gbase, voff) do { _Pragma("unroll") for (int _i = 0; _i < 2; ++_i) \
        __builtin_amdgcn_global_load_lds((const unsigned*)((const char*)(gbase) + (voff)[_i]), (PG8_LAS unsigned*)(lds + (bufoff) + ldsw + _i * 8192), 16, 0, 0); } while (0)
#define PG8_LDA(dst, b, h) do { _Pragma("unroll") for (int m = 0; m < 4; ++m) _Pragma("unroll") for (int k = 0; k < 2; ++k) dst[m][k] = *(const PG8_LAS bf16x8*)(lds + PG8_SA(b, h) + aoff + m * 2048 + k * 1024); } while (0)
#define PG8_LDB(dst, b, h) do { _Pragma("unroll") for (int n = 0; n < 2; ++n) _Pragma("unroll") for (int k = 0; k < 2; ++k) dst[n][k] = *(const PG8_LAS bf16x8*)(lds + PG8_SB(b, h) + boff + n * 2048 + k * 1024); } while (0)
#define PG8_MMA(ai, bj, At, Bt) do { __builtin_amdgcn_s_setprio(1); _Pragma("unroll") for (int m = 0; m < 4; ++m) _Pragma("unroll") for (int n = 0; n < 2; ++n) _Pragma("unroll") for (int k = 0; k < 2; ++k) \
        acc[ai][bj][m][n] = __builtin_amdgcn_mfma_f32_16x16x32_bf16(Bt[n][k], At[m][k], acc[ai][bj][m][n], 0, 0, 0); __builtin_amdgcn_s_setprio(0); } while (0)
#define PG8_WAIT_V(n) asm volatile("s_waitcnt vmcnt(" #n ")" ::: "memory")
#define PG8_WAIT_L(n) asm volatile("s_waitcnt lgkmcnt(" #n ")" ::: "memory")
#define PG8_BAR __builtin_amdgcn_s_barrier()
#define PG8_SCHED __builtin_amdgcn_sched_barrier(0)
    Unit cur, nxt; int ui = 0;
    if (!S.next(0, cur)) return;
    f32x4 acc[2][2][4][2];
#pragma unroll
    for (int a = 0; a < 2; ++a)
#pragma unroll
        for (int b = 0; b < 2; ++b)
#pragma unroll
            for (int m = 0; m < 4; ++m)
#pragma unroll
                for (int n = 0; n < 2; ++n) acc[a][b][m][n] = (f32x4){0.f, 0.f, 0.f, 0.f};
    bf16x8 At[4][2], B0[2][2], B1[2][2];
    const char* cA = (const char*)g.A + (size_t)cur.pm * tstep; const char* cB = (const char*)g.Bt + (size_t)cur.pn * tstep;
    S.a_ready(cur);
    if constexpr (SP2) {
        PG8_STAGE(PG8_SB(0, 0), cB, voffB); PG8_STAGE(PG8_SB(0, 1), cB + hstep, voffB); PG8_STAGE(PG8_SA(0, 0), cA, voffA); PG8_STAGE(PG8_SA(0, 1), cA + hstep, voffA);
        if (wr == 1) PG8_BAR;
        PG8_WAIT_V(2); PG8_BAR;
        PG8_STAGE(PG8_SB(1, 0), cB + kstep, voffB); PG8_STAGE(PG8_SA(1, 0), cA + kstep, voffA); PG8_STAGE(PG8_SB(1, 1), cB + hstep + kstep, voffB);
        PG8_WAIT_V(6); PG8_BAR;
    } else {
        PG8_STAGE(PG8_SB(0, 0), cB, voffB); PG8_STAGE(PG8_SA(0, 0), cA, voffA); PG8_STAGE(PG8_SB(0, 1), cB + hstep, voffB); PG8_STAGE(PG8_SA(0, 1), cA + hstep, voffA);
        if (wr == 1) PG8_BAR;
        PG8_WAIT_V(4); PG8_BAR;
        PG8_STAGE(PG8_SB(1, 0), cB + kstep, voffB); PG8_STAGE(PG8_SA(1, 0), cA + kstep, voffA); PG8_STAGE(PG8_SB(1, 1), cB + hstep + kstep, voffB);
        PG8_WAIT_V(6); PG8_BAR;
    }
    for (;;) {
        const bool has_next = S.next(ui + 1, nxt);
        const char* nA = has_next ? (const char*)g.A + (size_t)nxt.pm * tstep : cA; const char* nB = has_next ? (const char*)g.Bt + (size_t)nxt.pn * tstep : cB;
        for (int t = 0; t < nt; t += 2) {
            const bool last = (t == nt - 2);
            const char* a1 = cA + (size_t)(t + 1) * kstep;
            const char* a2 = last ? nA : cA + (size_t)(t + 2) * kstep; const char* b2 = last ? nB : cB + (size_t)(t + 2) * kstep;
            const char* a3 = a2 + kstep; const char* b3 = b2 + kstep;
            if (last && has_next) S.a_ready(nxt);
            if constexpr (SP2) {
            PG8_LDB(B0, 0, 0); PG8_LDB(B1, 0, 1); PG8_SCHED; PG8_LDA(At, 0, 0); PG8_STAGE(PG8_SA(1, 1), a1 + hstep, voffA);
            PG8_WAIT_V(8); PG8_WAIT_L(0); PG8_BAR; PG8_MMA(0, 0, At, B0); PG8_MMA(0, 1, At, B1); PG8_BAR; PG8_SCHED;
            PG8_LDA(At, 0, 1); PG8_STAGE(PG8_SB(0, 0), b2, voffB); PG8_STAGE(PG8_SB(0, 1), b2 + hstep, voffB); PG8_STAGE(PG8_SA(0, 0), a2, voffA);
            PG8_WAIT_V(8); PG8_WAIT_L(0); PG8_BAR; PG8_MMA(1, 0, At, B0); PG8_MMA(1, 1, At, B1); PG8_BAR; PG8_SCHED;
            PG8_LDB(B0, 1, 0); PG8_LDB(B1, 1, 1); PG8_SCHED; PG8_LDA(At, 1, 0); PG8_STAGE(PG8_SA(0, 1), a2 + hstep, voffA);
            PG8_WAIT_V(8); PG8_WAIT_L(0); PG8_BAR; PG8_MMA(0, 0, At, B0); PG8_MMA(0, 1, At, B1); PG8_BAR; PG8_SCHED;
            PG8_LDA(At, 1, 1); PG8_STAGE(PG8_SB(1, 0), b3, voffB); PG8_STAGE(PG8_SB(1, 1), b3 + hstep, voffB); PG8_STAGE(PG8_SA(1, 0), a3, voffA);
            PG8_WAIT_V(8); PG8_WAIT_L(0); PG8_BAR; PG8_MMA(1, 0, At, B0); PG8_MMA(1, 1, At, B1); PG8_BAR; PG8_SCHED;
            } else {
            PG8_LDB(B0, 0, 0); PG8_SCHED; PG8_LDA(At, 0, 0); PG8_STAGE(PG8_SA(1, 1), a1 + hstep, voffA);
            PG8_WAIT_L(8); PG8_BAR; PG8_WAIT_L(0); PG8_MMA(0, 0, At, B0); PG8_BAR; PG8_SCHED;
            PG8_LDB(B1, 0, 1); PG8_STAGE(PG8_SB(0, 0), b2, voffB);
            PG8_BAR; PG8_WAIT_L(0); PG8_MMA(0, 1, At, B1); PG8_BAR;
            PG8_LDA(At, 0, 1); PG8_STAGE(PG8_SA(0, 0), a2, voffA);
            PG8_BAR; PG8_WAIT_L(0); PG8_MMA(1, 0, At, B0); PG8_BAR; PG8_SCHED;
            PG8_STAGE(PG8_SB(0, 1), b2 + hstep, voffB);
            PG8_WAIT_V(6); PG8_BAR; PG8_MMA(1, 1, At, B1); PG8_BAR;
            PG8_LDB(B0, 1, 0); PG8_SCHED; PG8_LDA(At, 1, 0); PG8_STAGE(PG8_SA(0, 1), a2 + hstep, voffA);
            PG8_WAIT_L(8); PG8_BAR; PG8_WAIT_L(0); PG8_MMA(0, 0, At, B0); PG8_BAR; PG8_SCHED;
            PG8_LDB(B1, 1, 1); PG8_STAGE(PG8_SB(1, 0), b3, voffB);
            PG8_BAR; PG8_WAIT_L(0); PG8_MMA(0, 1, At, B1); PG8_BAR;
            PG8_LDA(At, 1, 1); PG8_STAGE(PG8_SA(1, 0), a3, voffA);
            PG8_BAR; PG8_WAIT_L(0); PG8_MMA(1, 0, At, B0); PG8_BAR; PG8_SCHED;
            PG8_STAGE(PG8_SB(1, 1), b3 + hstep, voffB);
            PG8_WAIT_V(6); PG8_BAR; PG8_MMA(1, 1, At, B1); PG8_BAR;
            }
        }
        if constexpr (ALIGN_EPI) { if (wr == 0) PG8_BAR; }
        if constexpr (!Epi::AFTER_DRAIN) { E(acc, cur, wr, wc, fr, fq); S.done(cur); }
        if (!has_next) break;
#pragma unroll
        for (int a = 0; a < 2; ++a)
#pragma unroll
            for (int b = 0; b < 2; ++b)
#pragma unroll
                for (int m = 0; m < 4; ++m)
#pragma unroll
                    for (int n = 0; n < 2; ++n) acc[a][b][m][n] = (f32x4){0.f, 0.f, 0.f, 0.f};
        cur = nxt; cA = nA; cB = nB; ++ui;
        if constexpr (ALIGN_EPI) { if (wr == 1) PG8_BAR; }
    }
    PG8_WAIT_V(0);
    if constexpr (!ALIGN_EPI) { if (wr == 0) PG8_BAR; }
    PG8_BAR;
    if constexpr (Epi::AFTER_DRAIN) { E.fused(acc, cur, wr, wc, fr, fq, lds, wid, lane); S.done(cur); }
#undef PG8_SA
#undef PG8_SB
#undef PG8_STAGE
#undef PG8_LDA
#undef PG8_LDB
#undef PG8_MMA
#undef PG8_WAIT_V
#undef PG8_WAIT_L
#undef PG8_BAR
#undef PG8_SCHED
}
}

#define DI __device__ __forceinline__
#define LAS __attribute__((address_space(3)))
typedef unsigned short bf16_t;
typedef short bf16x8 __attribute__((ext_vector_type(8)));
typedef short v4i16_t __attribute__((ext_vector_type(4)));
typedef float f32x2 __attribute__((ext_vector_type(2)));
typedef float f32x4 __attribute__((ext_vector_type(4)));
typedef float f32x16 __attribute__((ext_vector_type(16)));
typedef unsigned u32x2 __attribute__((ext_vector_type(2)));
typedef unsigned u32x4 __attribute__((ext_vector_type(4)));
typedef __bf16 bf16x2_t __attribute__((ext_vector_type(2)));

constexpr int DM = 1024, NBATCH = 32, TP = 2048, TSS = 64, PAST = 2048, HD = 64, NHA = 6, NHB = 6, NHC = 4;
constexpr int MP = NBATCH * TP, MS = NBATCH * TSS, MT = MP + MS;
constexpr int SHW = 1280, INC = 4230, NPAD = 4352;
constexpr int U_R = 0, U_K = 384, U_V = 768, U_WLO = 1152, U_ALO = 1216, U_GA = 1280, U_QB = 1664, U_KB = 2048, U_VB = 2432, U_GB = 2816,
              U_QC = 3200, U_KC = 3456, U_VC = 3712, U_GC = 3968, U_FB = 4224;
constexpr float ALPHA = 1.41421356237f;
constexpr float GN_EPS = 64e-5f, LN_EPS = 1e-5f;
constexpr float LOG2E = 1.4426950408889634f;
constexpr float QSCALE2 = 0.125f * LOG2E;

constexpr size_t O_YP = 0, O_YS = O_YP + (size_t)MP * DM, O_PFK = O_YS + (size_t)MS * DM, O_PFV = O_PFK + 2ull * MP * 384, O_PFL = O_PFV + 2ull * MP * 384,
                 O_PSK = O_PFL + 2ull * MP * 6, O_PSV = O_PSK + 2ull * MP * 256, O_PWKV = O_PSV + 2ull * MP * 256, O_PSH = O_PWKV + 2ull * 32 * 6 * 4096,
                 O_SFK = O_PSH + 2ull * 32 * 1280, O_SFV = O_SFK + 2ull * MS * 384, O_SFL = O_SFV + 2ull * MS * 384, O_SSK = O_SFL + 2ull * MS * 6,
                 O_SSV = O_SSK + 2ull * MS * 256, O_SWKV = O_SSV + 2ull * MS * 256, O_SSH = O_SWKV + 2ull * 32 * 6 * 4096, O_END = O_SSH + 2ull * 32 * 1280;
static_assert(O_END == 246341632ull, "output size");

constexpr size_t MiB = 1u << 20;
constexpr size_t WS_CTL = 0, CTL_BYTES = 4096, WS_WIN = 1 * MiB, WS_WOUT = 20 * MiB, WS_LOGF = 24 * MiB, WS_XB = 28 * MiB, WS_OB = 160 * MiB, WS_UB = 292 * MiB,
                 WS_BFK = WS_UB + (((size_t)MT * NPAD * 2 + MiB - 1) / MiB) * MiB,
                 BF_BYTES = (size_t)(32 * 6 * 66) * 4096, BS_BYTES = (size_t)(32 * 4 * 66) * 4096, WS_BFV = WS_BFK + BF_BYTES, WS_BSK = WS_BFV + BF_BYTES, WS_BSV = WS_BSK + BS_BYTES, WS_END = WS_BSV + BS_BYTES;
static_assert(WS_WIN + 2ull * NPAD * DM * 2 <= WS_WOUT && WS_WOUT + 2ull * DM * DM * 2 <= WS_LOGF && WS_LOGF + (size_t)MT * 8 * 4 <= WS_XB &&
              WS_XB + (size_t)MT * DM * 2 <= WS_OB && WS_OB + (size_t)MT * DM * 2 <= WS_UB && WS_END <= 1023 * MiB, "ws map");

constexpr int LDS_BYTES = 147456;
constexpr int WK_STRIDE = 8448;
constexpr int SC_OFF = 8 * WK_STRIDE;
constexpr int CH = 16;
constexpr int OPTOK = 384;
constexpr int OPBUF_BYTES = CH * OPTOK * 4;
constexpr int SC_OP = SC_OFF, SC_Y = SC_OP + 2 * OPBUF_BYTES, YBUF_BYTES = CH * 128 * 4  , SC_BON = SC_Y + 2 * YBUF_BYTES, SC_FLAGS = SC_BON + 2 * 64;
static_assert(SC_FLAGS + 64 <= LDS_BYTES, "scan LDS");
enum { F_PROD = 0, F_POST = 1, F_CONS = 2, F_PRODB = 6, F_POSTB = 7, F_SETUP = 8 };

struct Params { const float* in[24]; float* out; unsigned char* ws; int ph_lo, ph_hi, rep_ph, dbg; };
typedef const __attribute__((address_space(4))) Params* PP;
DI PP pp_launder(PP p) { asm volatile("" : "+s"(p)); return p; }

DI float bf2f(unsigned short h) { return __uint_as_float((unsigned)h << 16); }
DI float bflo(unsigned w) { return __uint_as_float(w << 16); }
DI float bfhi(unsigned w) { return __uint_as_float(w & 0xffff0000u); }
DI unsigned cvtpk(float lo, float hi) { f32x2 v = {lo, hi}; bf16x2_t b = __builtin_convertvector(v, bf16x2_t); return __builtin_bit_cast(unsigned, b); }
DI float fast_exp2(float x) { return __builtin_amdgcn_exp2f(x); }
DI float fast_rcp(float x) { return __builtin_amdgcn_rcpf(x); }
DI float sigmoidf_(float x) { return fast_rcp(1.f + fast_exp2(-LOG2E * x)); }
DI float siluf_(float x) { return x * sigmoidf_(x); }
DI float swap32_other(float x, float& mine_lo, float& mine_hi) { auto r = __builtin_amdgcn_permlane32_swap(__float_as_uint(x), __float_as_uint(x), false, false); mine_lo = __uint_as_float(r[0]); mine_hi = __uint_as_float(r[1]); return 0.f; }
DI float red4(float x) {
    auto a = __builtin_amdgcn_permlane16_swap(__float_as_uint(x), __float_as_uint(x), false, false);
    const float s = __uint_as_float(a[0]) + __uint_as_float(a[1]);
    auto b = __builtin_amdgcn_permlane32_swap(__float_as_uint(s), __float_as_uint(s), false, false);
    return __uint_as_float(b[0]) + __uint_as_float(b[1]);
}
template <int CTRL> DI float dpp_f(float x) { return __uint_as_float((unsigned)__builtin_amdgcn_update_dpp(0, (int)__float_as_uint(x), CTRL, 0xf, 0xf, false)); }
DI float red16(float x) {
    x += dpp_f<0x121>(x); x += dpp_f<0x122>(x); x += dpp_f<0x124>(x); x += dpp_f<0x128>(x); return x;
}
DI unsigned ld_flag(LAS unsigned* p) { return __hip_atomic_load(p, __ATOMIC_ACQUIRE, __HIP_MEMORY_SCOPE_WORKGROUP); }
DI void st_flag(LAS unsigned* p, unsigned v) { __hip_atomic_store(p, v, __ATOMIC_RELEASE, __HIP_MEMORY_SCOPE_WORKGROUP); }
DI void wait_ge(LAS unsigned* p, unsigned need) { while (ld_flag(p) < need) __builtin_amdgcn_s_sleep(1); }
DI int crow(int r, int hi) { return (r & 3) + 8 * (r >> 2) + 4 * hi; }
#define MFMA32(a, b, c) __builtin_amdgcn_mfma_f32_32x32x16_bf16((a), (b), (c), 0, 0, 0)
#define MFMA16(a, b, c) __builtin_amdgcn_mfma_f32_16x16x32_bf16((a), (b), (c), 0, 0, 0)

DI void p0_item(const float* W, int Nsrc, int kind, bf16_t* WT, LAS float* scr, int item, int nblk, int lane) {
    const int kb = item / nblk, nb = item % nblk, k0 = 64 * kb, n0 = 32 * nb;
    const int n = n0 + (lane & 31); int src = n; bool valid = true;
    if (kind == 0) { if (n < 2816) src = n; else if (n < 4224) src = n + 6; else if (n < 4230) src = n - 4224 + 2816; else { valid = false; src = 0; } }
#pragma unroll 8
    for (int i = 0; i < 32; ++i) { const int kk = 2 * i + (lane >> 5); scr[kk * 33 + (lane & 31)] = valid ? W[(size_t)(k0 + kk) * Nsrc + src] : 0.f; }
    asm volatile("s_waitcnt lgkmcnt(0)" ::: "memory");
    const int c = lane & 7;
#pragma unroll
    for (int j = 0; j < 4; ++j) { const int nn = (lane >> 3) + 8 * j; const LAS float* s = scr + (8 * c) * 33 + nn;
        u32x4 o; o.x = cvtpk(s[0 * 33], s[1 * 33]); o.y = cvtpk(s[2 * 33], s[3 * 33]); o.z = cvtpk(s[4 * 33], s[5 * 33]); o.w = cvtpk(s[6 * 33], s[7 * 33]);
        *(u32x4*)(WT + (size_t)(n0 + nn) * 1024 + k0 + 8 * c) = o; }
    asm volatile("s_waitcnt lgkmcnt(0)" ::: "memory");
}
DI void phase0(PP P, LAS unsigned char* lds, int wave, int lane, int bidx, int gdim) {
    LAS float* scr = (LAS float*)(lds + wave * 8448);
    const int gw = bidx * 8 + wave, NGW = gdim * 8;
    constexpr int I_IN = 16 * (NPAD / 32), I_OUT = 16 * 32, NITEMS = 2 * (I_IN + I_OUT);
    for (int it = gw; it < NITEMS; it += NGW) {
        int r = it; const int l = r / (I_IN + I_OUT); r -= l * (I_IN + I_OUT);
        if (r < I_IN) p0_item(P->in[9] + (size_t)l * DM * INC, INC, 0, (bf16_t*)(P->ws + WS_WIN) + (size_t)l * NPAD * DM, scr, r, NPAD / 32, lane);
        else p0_item(P->in[21] + (size_t)l * DM * DM, DM, 1, (bf16_t*)(P->ws + WS_WOUT) + (size_t)l * DM * DM, scr, r - I_IN, 32, lane);
    }
    bf16_t* xb = (bf16_t*)(P->ws + WS_XB);
    for (int m = gw; m < MT; m += NGW) {
        const float* xr = (m < MP) ? P->in[0] + (size_t)m * DM : P->in[1] + (size_t)(m - MP) * DM;
        const f32x4* x4 = (const f32x4*)xr + lane; u32x2* o = (u32x2*)(xb + (size_t)m * DM) + lane;
#pragma unroll
        for (int j = 0; j < 4; ++j) { const f32x4 v = x4[64 * j]; u32x2 w; w.x = cvtpk(v.x, v.y); w.y = cvtpk(v.z, v.w); o[64 * j] = w; }
    }
}

DI float log_sigmoid_f(float x) { return fminf(x, 0.f) - log1pf(expf(-fabsf(x))); }
struct EpiU {
    static constexpr bool PERM = true, AFTER_DRAIN = false;
    unsigned char* ws; float* out; const float* fb; int l, mode;
    DI void operator()(const pg8::f32x4 (&acc)[2][2][4][2], const pg8::Unit& u, int wr, int wc, int fr, int fq) const {
        const int row0 = u.pm * 256 + wr * 64 + fr;
        if (mode == 0) {
            bf16_t* U = (bf16_t*)(ws + WS_UB); float* logf = (float*)(ws + WS_LOGF);
#pragma unroll
            for (int bj = 0; bj < 2; ++bj) {
                const int ch = u.pn * 2 + bj, c0 = ch * 128 + wc * 32 + 8 * fq;
                int W = 0, cs = 0, isv = 0, NHx = 6; size_t op = 0, os = 0, wb = 0;
                if (ch >= 16 && ch < 19) { W = 384; cs = U_KB; op = O_PFK; os = O_SFK; wb = WS_BFK; }
                else if (ch >= 19 && ch < 22) { W = 384; cs = U_VB; op = O_PFV; os = O_SFV; wb = WS_BFV; isv = 1; }
                else if (ch == 27 || ch == 28) { W = 256; cs = U_KC; op = O_PSK; os = O_SSK; wb = WS_BSK; NHx = 4; }
                else if (ch == 29 || ch == 30) { W = 256; cs = U_VC; op = O_PSV; os = O_SSV; wb = WS_BSV; NHx = 4; isv = 1; }
                const int hh = (c0 - cs) >> 6, dd = (c0 - cs) & 63;
                const unsigned koff = (unsigned)((dd >> 4) * 1024 + ((dd >> 3) & 1) * 512), voff = (unsigned)((dd >> 5) * 2048 + ((dd & 31) >> 3) * 16);
                float* segp = out + op + (size_t)l * MP * W + (c0 - cs); float* segs = out + os + (size_t)l * MS * W + (c0 - cs);
#pragma unroll
                for (int ai = 0; ai < 2; ++ai)
#pragma unroll
                    for (int m = 0; m < 4; ++m) {
                        const int r = row0 + ai * 128 + m * 16;
                        const f32x4 v0 = acc[ai][bj][m][0], v1 = acc[ai][bj][m][1];
                        u32x4 w; w.x = cvtpk(v0[0], v0[1]); w.y = cvtpk(v0[2], v0[3]); w.z = cvtpk(v1[0], v1[1]); w.w = cvtpk(v1[2], v1[3]);
                        if (W) { float* d = (r < MP) ? segp + (size_t)r * W : segs + (size_t)(r - MP) * W; *(f32x4*)d = v0; *(f32x4*)(d + 4) = v1;
                            int bq, tq_, smp; if (r < MP) { bq = r >> 11; tq_ = r & 2047; smp = 0; } else { const int rs = r - MP; bq = rs >> 6; tq_ = rs & 63; smp = 1; }
                            const unsigned tix = smp ? (unsigned)(32 * NHx * 64 + (bq * NHx + hh) * 2 + (tq_ >> 5)) : (unsigned)((bq * NHx + hh) * 64 + (tq_ >> 5));
                            const int r32_ = tq_ & 31;
                            const unsigned off = isv ? voff + (unsigned)((r32_ >> 4) * 1024 + (r32_ & 15) * 64) : koff + (unsigned)(r32_ * 16);
                            *(u32x4*)(ws + wb + (size_t)tix * 4096 + off) = w; }
                        else *(u32x4*)(U + (size_t)r * NPAD + c0) = w;
                        if (ch < 10) {
                            if (r < MP) { if ((r & 2047) == 2047) { float* d = out + O_PSH + (size_t)(l * 32 + (r >> 11)) * SHW + c0; *(f32x4*)d = v0; *(f32x4*)(d + 4) = v1; } }
                            else { const int rs = r - MP; if ((rs & 63) == 63) { float* d = out + O_SSH + (size_t)(l * 32 + (rs >> 6)) * SHW + c0; *(f32x4*)d = v0; *(f32x4*)(d + 4) = v1; } }
                        }
                        if (ch == 33 && wc == 0 && fq == 0) {
                            float lf[6];
#pragma unroll
                            for (int h = 0; h < 6; ++h) { const float x = (h < 4 ? v0[h] : v1[h - 4]) + fb[h]; lf[h] = log_sigmoid_f(x); }
                            float* d = (r < MP) ? out + O_PFL + ((size_t)l * MP + r) * 6 : out + O_SFL + ((size_t)l * MS + (r - MP)) * 6;
#pragma unroll
                            for (int h = 0; h < 6; ++h) { d[h] = lf[h]; logf[(size_t)r * 8 + h] = lf[h]; }
                        }
                    }
            }
        } else {
            const bf16_t* X = (const bf16_t*)(ws + WS_XB); bf16_t* Z = (bf16_t*)(ws + WS_UB);
#pragma unroll
            for (int ai = 0; ai < 2; ++ai)
#pragma unroll
                for (int m = 0; m < 4; ++m) {
                    const size_t r = (size_t)(row0 + ai * 128 + m * 16);
#pragma unroll
                    for (int bj = 0; bj < 2; ++bj) {
                        const int c = u.pn * 256 + bj * 128 + wc * 32 + 8 * fq;
                        const u32x4 xw = *(const u32x4*)(X + r * DM + c);
                        f32x4 z0 = acc[ai][bj][m][0], z1 = acc[ai][bj][m][1];
                        z0[0] += ALPHA * bflo(xw.x); z0[1] += ALPHA * bfhi(xw.x); z0[2] += ALPHA * bflo(xw.y); z0[3] += ALPHA * bfhi(xw.y);
                        z1[0] += ALPHA * bflo(xw.z); z1[1] += ALPHA * bfhi(xw.z); z1[2] += ALPHA * bflo(xw.w); z1[3] += ALPHA * bfhi(xw.w);
                        u32x4 zw; zw.x = cvtpk(z0[0], z0[1]); zw.y = cvtpk(z0[2], z0[3]); zw.z = cvtpk(z1[0], z1[1]); zw.w = cvtpk(z1[2], z1[3]);
                        *(u32x4*)(Z + r * DM + c) = zw;
                    }
                }
        }
    }
};

DI float wave_sum(float v) {
#pragma unroll
    for (int o = 1; o < 64; o <<= 1) v += __shfl_xor(v, o);
    return v;
}
DI void phase_ln(PP P, int l, int wave, int lane, int bidx, int gdim) {
    const int gw = bidx * 8 + wave, NGW = gdim * 8;
    const bf16_t* Z = (const bf16_t*)(P->ws + WS_UB); bf16_t* xb = (bf16_t*)(P->ws + WS_XB);
    const f32x4* g4 = (const f32x4*)(P->in[22] + (size_t)l * DM) + lane; const f32x4* b4 = (const f32x4*)(P->in[23] + (size_t)l * DM) + lane;
    f32x4 g[4], bb[4];
#pragma unroll
    for (int j = 0; j < 4; ++j) { g[j] = g4[64 * j]; bb[j] = b4[64 * j]; }
    for (int m = gw; m < MT; m += NGW) {
        const u32x2* z4 = (const u32x2*)(Z + (size_t)m * DM) + lane;
        f32x4 v[4]; float s = 0.f;
#pragma unroll
        for (int j = 0; j < 4; ++j) { const u32x2 zz_ = z4[64 * j]; v[j] = (f32x4){bflo(zz_.x), bfhi(zz_.x), bflo(zz_.y), bfhi(zz_.y)}; s += (v[j].x + v[j].y) + (v[j].z + v[j].w); }
        const float mean = wave_sum(s) * (1.f / DM); float s2 = 0.f;
#pragma unroll
        for (int j = 0; j < 4; ++j) { v[j] = v[j] - mean; s2 += (v[j].x * v[j].x + v[j].y * v[j].y) + (v[j].z * v[j].z + v[j].w * v[j].w); }
        const float rstd = 1.f / sqrtf(wave_sum(s2) * (1.f / DM) + LN_EPS);
#pragma unroll
        for (int j = 0; j < 4; ++j) v[j] = v[j] * rstd * g[j] + bb[j];
        if (l == 0) { u32x2* o = (u32x2*)(xb + (size_t)m * DM) + lane;
#pragma unroll
            for (int j = 0; j < 4; ++j) { u32x2 w; w.x = cvtpk(v[j].x, v[j].y); w.y = cvtpk(v[j].z, v[j].w); o[64 * j] = w; } }
        else { f32x4* o = (f32x4*)(P->out + O_YP + (size_t)m * DM) + lane;
#pragma unroll
            for (int j = 0; j < 4; ++j) o[64 * j] = v[j]; }
    }
}

DI void scan_wave(PP P, int l, LAS unsigned char* lds, int wave, int lane, int seq0, int nseq, bool sample, int dbg, bool two = false) {
    const int row = wave * 16 + (lane & 15), kq = lane >> 4;
    LAS unsigned* flags = (LAS unsigned*)(lds + SC_FLAGS);
    unsigned cgl = 0;
    const int nch = sample ? TSS / CH : TP / CH;
    __builtin_amdgcn_s_setprio(3);
    for (int s = 0; s < nseq; ++s) {
        const int seq = seq0 + s, b = seq / 6, h = seq % 6;
        f32x4 S[4];
        if (sample) { const f32x4* sp = (const f32x4*)(P->in[7] + ((size_t)((l * 32 + b) * 6 + h) * 64 + row) * 64 + kq * 16);
#pragma unroll
            for (int i = 0; i < 4; ++i) S[i] = sp[i]; }
        else {
#pragma unroll
            for (int i = 0; i < 4; ++i) S[i] = (f32x4){0.f, 0.f, 0.f, 0.f}; }
        for (int c = 0; c < nch; ++c, ++cgl) {
            if (two) { wait_ge(&flags[(cgl & 1) ? F_PRODB : F_PROD], (cgl >> 1) + 1); if (cgl >= 2) wait_ge(&flags[(cgl & 1) ? F_POSTB : F_POST], cgl >> 1); }
            else { wait_ge(&flags[F_PROD], cgl + 1); if (cgl >= 2) wait_ge(&flags[F_POST], cgl - 1); }
            LAS const float* opb = (LAS const float*)(lds + SC_OP + (cgl & 1) * OPBUF_BYTES);
            LAS float* yb = (LAS float*)(lds + SC_Y + (cgl & 1) * YBUF_BYTES);
            LAS const float* bon = (LAS const float*)(lds + SC_BON + (cgl & 1) * 64);
            LAS const float* tp0 = opb + kq * 16; asm volatile("" : "+v"(tp0));
            LAS const float* vp0 = opb + 320 + row; asm volatile("" : "+v"(vp0));
            f32x4 w4[2][4], kk4[2][4], ka4[2][4], kp4[2][4], r4[2][4]; float vv[2], bt[2];
#define SC_LOAD(buf, t_) do { LAS const float* tp = tp0 + (t_) * OPTOK; \
                _Pragma("unroll") for (int i = 0; i < 4; ++i) { w4[buf][i] = *(LAS const f32x4*)(tp + 4 * i); kk4[buf][i] = *(LAS const f32x4*)(tp + 64 + 4 * i); ka4[buf][i] = *(LAS const f32x4*)(tp + 128 + 4 * i); \
                    kp4[buf][i] = *(LAS const f32x4*)(tp + 192 + 4 * i); r4[buf][i] = *(LAS const f32x4*)(tp + 256 + 4 * i); } \
                vv[buf] = vp0[(t_) * OPTOK]; bt[buf] = bon[t_]; } while (0)
            SC_LOAD(0, 0);
#pragma unroll
            for (int t = 0; t < CH; ++t) {
                if ((dbg & 8) && t >= 8) break;
                const int cb = t & 1, nb = cb ^ 1;
                if (t + 1 < CH) SC_LOAD(nb, t + 1);
                f32x4 a4 = S[0] * kk4[cb][0];
#pragma unroll
                for (int i = 1; i < 4; ++i) a4 += S[i] * kk4[cb][i];
                float sa = (a4[0] + a4[1]) + (a4[2] + a4[3]);
                sa = red4(sa);
                const float nsa = -sa;
                f32x4 y4 = (f32x4){0.f, 0.f, 0.f, 0.f};
#pragma unroll
                for (int i = 0; i < 4; ++i) { S[i] = S[i] * w4[cb][i] + nsa * ka4[cb][i] + vv[cb] * kp4[cb][i]; y4 += S[i] * r4[cb][i]; }
                float y = (y4[0] + y4[1]) + (y4[2] + y4[3]);
                y = red4(y);
                if (kq < 2) yb[t * 128 + kq * 64 + row] = kq == 0 ? y : bt[cb] * vv[cb];
            }
#undef SC_LOAD
            st_flag(&flags[F_CONS + wave], cgl + 1);
        }
        float* so = P->out + (sample ? O_SWKV : O_PWKV) + ((size_t)((l * 32 + b) * 6 + h) * 64 + row) * 64 + kq * 16;
        if (!(dbg & 256)) {
#pragma unroll
            for (int i = 0; i < 4; ++i) *(f32x4*)(so + 4 * i) = S[i]; }
    }
    __builtin_amdgcn_s_setprio(0);
}

constexpr int SC_CST = SC_FLAGS + 64, CST_BYTES = 10 * 64 * 4, RAWBUF = 16384;
static_assert(SC_CST + CST_BYTES <= LDS_BYTES && 2 * RAWBUF <= 4 * WK_STRIDE && 15 * 1024 <= RAWBUF, "prep LDS");
#define RAWOFF(R, sg, c) ((((sg) * 3 + ((R) >> 3)) * 1024) + (((R) & 7) * 128) + (c) * 2)
DI void prep_wave(PP P, int l, LAS unsigned char* lds, int lane, int seq0, int nseq, bool sample, int dbg) {
    const int fr = lane & 15, fq = lane >> 4;
    LAS unsigned* flags = (LAS unsigned*)(lds + SC_FLAGS);
    LAS float* cst = (LAS float*)(lds + SC_CST);
    const bf16_t* ub = (const bf16_t*)(P->ws + WS_UB);
    const float* mu = P->in[10] + (size_t)l * SHW;
    unsigned cgl = 0;
    const int nch = sample ? TSS / CH : TP / CH;
    const int c8 = lane & 7, rsub = lane >> 3;
    const unsigned goff = (unsigned)(rsub * NPAD + c8 * 8) * 2u;
    for (int s = 0; s < nseq; ++s) {
        const int seq = seq0 + s, b = seq / 6, h = seq % 6;
        const size_t m0 = sample ? (size_t)MP + (size_t)b * TSS : (size_t)b * TP;
        const float* sh0 = P->in[8] + (size_t)(l * 32 + b) * SHW;
        {
            const int kc = h * 64 + lane;
            cst[0 * 64 + lane] = mu[U_R + kc]; cst[1 * 64 + lane] = mu[U_K + kc]; cst[2 * 64 + lane] = mu[U_V + kc];
            cst[3 * 64 + lane] = P->in[11][(size_t)l * 384 + kc]; cst[4 * 64 + lane] = P->in[13][(size_t)l * 384 + kc]; cst[5 * 64 + lane] = P->in[15][(size_t)l * 384 + kc];
            cst[6 * 64 + lane] = P->in[16][(size_t)l * 384 + kc]; cst[7 * 64 + lane] = P->in[17][(size_t)l * 384 + kc];
            cst[8 * 64 + lane] = mu[U_WLO + lane]; cst[9 * 64 + lane] = mu[U_ALO + lane];
        }
        LAS unsigned char* btab = lds + 4 * WK_STRIDE;
        {
            LAS float* wst = (LAS float*)lds;
#pragma unroll
            for (int arr = 0; arr < 2; ++arr)
#pragma unroll
                for (int ks = 0; ks < 2; ++ks) {
                    const float* W = P->in[arr == 0 ? 12 : 14] + (size_t)l * 64 * 384 + (size_t)(32 * ks) * 384 + h * 64;
                    asm volatile("" ::: "memory");
#pragma unroll
                    for (int n = 0; n < 8; ++n) { const int row = (lane >> 4) + 4 * n; *(LAS f32x4*)(wst + row * 64 + (lane & 15) * 4) = *(const f32x4*)(W + (size_t)row * 384 + (lane & 15) * 4); }
                    asm volatile("" ::: "memory");
#pragma unroll
                    for (int j = 0; j < 4; ++j) { u32x4 pq;
#pragma unroll
                        for (int e = 0; e < 4; ++e) { const int k0 = 8 * fq + 2 * e; pq[e] = cvtpk(wst[k0 * 64 + 16 * j + fr], wst[(k0 + 1) * 64 + 16 * j + fr]); }
                        *(LAS u32x4*)(btab + (((arr * 4 + j) * 2 + ks) * 64 + lane) * 16) = pq; }
                    asm volatile("" ::: "memory");
                }
        }
        u32x4 pf[15];
#define PREP_FETCH(c_) do { const char* gb_ = (const char*)(ub + (m0 + (size_t)(c_) * CH - 1) * NPAD); \
            _Pragma("unroll") for (int sg = 0; sg < 5; ++sg) { const char* gs_ = gb_ + (sg < 3 ? (sg * 384 + h * 64) * 2 : (sg == 3 ? U_WLO * 2 : U_ALO * 2)); \
                _Pragma("unroll") for (int rg = 0; rg < 3; ++rg) { if (rg < 2 || rsub == 0) pf[sg * 3 + rg] = *(const u32x4*)(gs_ + (size_t)(rg * 8 * NPAD * 2) + goff); } } } while (0)
        asm volatile("s_waitcnt vmcnt(0) lgkmcnt(0)" ::: "memory");
        PREP_FETCH(0);
        for (int c = 0; c < nch; ++c, ++cgl) {
            if (dbg & 2) { if (cgl >= 2) { for (int j = 0; j < 4; ++j) wait_ge(&flags[F_CONS + j], cgl - 1); } st_flag(&flags[F_PROD], cgl + 1); continue; }
            const int t0 = c * CH;
            LAS unsigned char* raw = lds + (c & 1) * RAWBUF;
#pragma unroll
            for (int sg = 0; sg < 5; ++sg)
#pragma unroll
                for (int rg = 0; rg < 3; ++rg) { if (rg < 2 || rsub == 0) *(LAS u32x4*)(raw + (sg * 3 + rg) * 1024 + lane * 16) = pf[sg * 3 + rg]; }
            if (t0 == 0 && rsub == 0) {
#pragma unroll
                for (int sg = 0; sg < 5; ++sg) {
                    u32x4 v = (u32x4){0u, 0u, 0u, 0u};
                    if (sample) { const int col_ = (sg < 3 ? sg * 384 + h * 64 : (sg == 3 ? U_WLO : U_ALO)) + c8 * 8;
                        const f32x4 a = *(const f32x4*)(sh0 + col_), bq = *(const f32x4*)(sh0 + col_ + 4); v.x = cvtpk(a[0], a[1]); v.y = cvtpk(a[2], a[3]); v.z = cvtpk(bq[0], bq[1]); v.w = cvtpk(bq[2], bq[3]); }
                    *(LAS u32x4*)(raw + sg * 3 * 1024 + c8 * 16) = v;
                }
            }
            asm volatile("" ::: "memory");
            if (c + 1 < nch) PREP_FETCH(c + 1);
            int zz = 0; asm volatile("" : "+v"(zz));
            LAS const float* cz = cst + zz;
            f32x4 Dw[4], Da[4];
            {
                bf16x8 Aw[2], Aa[2];
#pragma unroll
                for (int ks = 0; ks < 2; ++ks) {
                    const u32x4 cw = *(LAS const u32x4*)(raw + RAWOFF(fr + 1, 3, 32 * ks + 8 * fq)), pwv = *(LAS const u32x4*)(raw + RAWOFF(fr, 3, 32 * ks + 8 * fq));
                    const u32x4 ca = *(LAS const u32x4*)(raw + RAWOFF(fr + 1, 4, 32 * ks + 8 * fq)), pav = *(LAS const u32x4*)(raw + RAWOFF(fr, 4, 32 * ks + 8 * fq));
                    const f32x4 mw0 = *(LAS const f32x4*)(cz + 8 * 64 + 32 * ks + 8 * fq), mw1 = *(LAS const f32x4*)(cz + 8 * 64 + 32 * ks + 8 * fq + 4);
                    const f32x4 ma0 = *(LAS const f32x4*)(cz + 9 * 64 + 32 * ks + 8 * fq), ma1 = *(LAS const f32x4*)(cz + 9 * 64 + 32 * ks + 8 * fq + 4);
                    u32x4 pw, pa;
#pragma unroll
                    for (int e = 0; e < 4; ++e) {
                        const float c0 = bflo(cw[e]), c1 = bfhi(cw[e]), p0 = bflo(pwv[e]), p1 = bfhi(pwv[e]);
                        const float m0_ = (e < 2 ? mw0[2 * e] : mw1[2 * e - 4]), m1_ = (e < 2 ? mw0[2 * e + 1] : mw1[2 * e - 3]);
                        const float z0 = c0 + (p0 - c0) * m0_, z1 = c1 + (p1 - c1) * m1_;
                        const float t0_ = 1.f - 2.f * fast_rcp(1.f + fast_exp2(2.f * LOG2E * z0)), t1_ = 1.f - 2.f * fast_rcp(1.f + fast_exp2(2.f * LOG2E * z1));
                        pw[e] = cvtpk(t0_, t1_);
                        const float d0 = bflo(ca[e]), d1 = bfhi(ca[e]), q0 = bflo(pav[e]), q1 = bfhi(pav[e]);
                        const float n0_ = (e < 2 ? ma0[2 * e] : ma1[2 * e - 4]), n1_ = (e < 2 ? ma0[2 * e + 1] : ma1[2 * e - 3]);
                        pa[e] = cvtpk(d0 + (q0 - d0) * n0_, d1 + (q1 - d1) * n1_);
                    }
                    Aw[ks] = __builtin_bit_cast(bf16x8, pw); Aa[ks] = __builtin_bit_cast(bf16x8, pa);
                }
#pragma unroll
                for (int j = 0; j < 4; ++j) {
                    const f32x4 z = (f32x4){0.f, 0.f, 0.f, 0.f};
                    LAS const unsigned char* bt = btab + zz + lane * 16;
                    Dw[j] = MFMA16(Aw[0], *(LAS const bf16x8*)(bt + ((0 * 4 + j) * 2 + 0) * 1024), z); Dw[j] = MFMA16(Aw[1], *(LAS const bf16x8*)(bt + ((0 * 4 + j) * 2 + 1) * 1024), Dw[j]);
                    Da[j] = MFMA16(Aa[0], *(LAS const bf16x8*)(bt + ((1 * 4 + j) * 2 + 0) * 1024), z); Da[j] = MFMA16(Aa[1], *(LAS const bf16x8*)(bt + ((1 * 4 + j) * 2 + 1) * 1024), Da[j]);
                }
            }
            if (cgl >= 2) {
#pragma unroll
                for (int j = 0; j < 4; ++j) wait_ge(&flags[F_CONS + j], cgl - 1);
            }
            LAS float* opb = (LAS float*)(lds + SC_OP + (cgl & 1) * OPBUF_BYTES);
            LAS float* bon = (LAS float*)(lds + SC_BON + (cgl & 1) * 64);
#pragma unroll
            for (int i = 0; i < 4; ++i) {
                const int tl = 4 * fq + i; LAS const unsigned char* rc = raw + RAWOFF(tl + 1, 0, fr); LAS const unsigned char* rp = raw + RAWOFF(tl, 0, fr);
#define RB(p_, sg_, j_) bf2f(*(LAS const bf16_t*)((p_) + (sg_) * 3072 + (j_) * 32))
                float rr[4], kk[4], vv[4], aa[4], ww[4], kn[4]; float ss = 0.f;
#pragma unroll
                for (int j = 0; j < 4; ++j) {
                    const float cr = RB(rc, 0, j), ck = RB(rc, 1, j), cv = RB(rc, 2, j);
                    const float pr = RB(rp, 0, j), pk = RB(rp, 1, j), pv_ = RB(rp, 2, j);
                    rr[j] = cr + (pr - cr) * cz[0 * 64 + 16 * j + fr]; kk[j] = ck + (pk - ck) * cz[1 * 64 + 16 * j + fr]; vv[j] = cv + (pv_ - cv) * cz[2 * 64 + 16 * j + fr];
                    const float x = cz[3 * 64 + 16 * j + fr] + Dw[j][i];
                    const float sg = fast_rcp(1.f + fast_exp2(-LOG2E * x));
                    ww[j] = fast_exp2(-0.60653066f * LOG2E * sg);
                    aa[j] = fast_rcp(1.f + fast_exp2(-LOG2E * (cz[4 * 64 + 16 * j + fr] + Da[j][i])));
                    kn[j] = kk[j] * cz[5 * 64 + 16 * j + fr]; ss += kn[j] * kn[j];
                }
                ss = red16(ss);
                const float rn = 1.f / sqrtf(ss + 1e-12f);
                float bs = 0.f; LAS float* o = opb + tl * OPTOK + fr;
#pragma unroll
                for (int j = 0; j < 4; ++j) {
                    const float knn = kn[j] * rn, kp = kk[j] * (1.f + (aa[j] - 1.f) * cz[6 * 64 + 16 * j + fr]);
                    bs += rr[j] * kp * cz[7 * 64 + 16 * j + fr];
                    o[16 * j] = ww[j]; o[64 + 16 * j] = knn; o[128 + 16 * j] = knn * aa[j]; o[192 + 16 * j] = kp; o[256 + 16 * j] = rr[j]; o[320 + 16 * j] = vv[j];
                }
                bs = red16(bs);
                if (fr == 0) bon[tl] = bs;
#undef RB
            }
            st_flag(&flags[F_PROD], cgl + 1);
        }
#undef PREP_FETCH
    }
}

DI void helper2_wave(PP P, int l, LAS unsigned char* lds, int lane, int seq0, int par, int dbg) {
    const int nseq = 1; const bool sample = false;
    const int fr = lane & 15, fq = lane >> 4;
    LAS unsigned* flags = (LAS unsigned*)(lds + SC_FLAGS);
    LAS float* cst = (LAS float*)(lds + SC_CST);
    const bf16_t* ub = (const bf16_t*)(P->ws + WS_UB);
    const float* mu = P->in[10] + (size_t)l * SHW;
    unsigned cgl = 0;
    const int nch = sample ? TSS / CH : TP / CH;
    const int c8 = lane & 7, rsub = lane >> 3;
    const unsigned goff = (unsigned)(rsub * NPAD + c8 * 8) * 2u;
    for (int s = 0; s < nseq; ++s) {
        const int seq = seq0 + s, b = seq / 6, h = seq % 6;
        const size_t m0 = sample ? (size_t)MP + (size_t)b * TSS : (size_t)b * TP;
        const float* sh0 = P->in[8] + (size_t)(l * 32 + b) * SHW;
        if (par == 0) {
            const int kc = h * 64 + lane;
            cst[0 * 64 + lane] = mu[U_R + kc]; cst[1 * 64 + lane] = mu[U_K + kc]; cst[2 * 64 + lane] = mu[U_V + kc];
            cst[3 * 64 + lane] = P->in[11][(size_t)l * 384 + kc]; cst[4 * 64 + lane] = P->in[13][(size_t)l * 384 + kc]; cst[5 * 64 + lane] = P->in[15][(size_t)l * 384 + kc];
            cst[6 * 64 + lane] = P->in[16][(size_t)l * 384 + kc]; cst[7 * 64 + lane] = P->in[17][(size_t)l * 384 + kc];
            cst[8 * 64 + lane] = mu[U_WLO + lane]; cst[9 * 64 + lane] = mu[U_ALO + lane];
        }
        LAS unsigned char* btab = lds + 4 * WK_STRIDE;
        if (par == 0) {
            LAS float* wst = (LAS float*)lds;
#pragma unroll
            for (int arr = 0; arr < 2; ++arr)
#pragma unroll
                for (int ks = 0; ks < 2; ++ks) {
                    const float* W = P->in[arr == 0 ? 12 : 14] + (size_t)l * 64 * 384 + (size_t)(32 * ks) * 384 + h * 64;
                    asm volatile("" ::: "memory");
#pragma unroll
                    for (int n = 0; n < 8; ++n) { const int row = (lane >> 4) + 4 * n; *(LAS f32x4*)(wst + row * 64 + (lane & 15) * 4) = *(const f32x4*)(W + (size_t)row * 384 + (lane & 15) * 4); }
                    asm volatile("" ::: "memory");
#pragma unroll
                    for (int j = 0; j < 4; ++j) { u32x4 pq;
#pragma unroll
                        for (int e = 0; e < 4; ++e) { const int k0 = 8 * fq + 2 * e; pq[e] = cvtpk(wst[k0 * 64 + 16 * j + fr], wst[(k0 + 1) * 64 + 16 * j + fr]); }
                        *(LAS u32x4*)(btab + (((arr * 4 + j) * 2 + ks) * 64 + lane) * 16) = pq; }
                    asm volatile("" ::: "memory");
                }
        }
        u32x4 pf[15];
#define PREP_FETCH(c_) do { const char* gb_ = (const char*)(ub + (m0 + (size_t)(c_) * CH - 1) * NPAD); \
            _Pragma("unroll") for (int sg = 0; sg < 5; ++sg) { const char* gs_ = gb_ + (sg < 3 ? (sg * 384 + h * 64) * 2 : (sg == 3 ? U_WLO * 2 : U_ALO * 2)); \
                _Pragma("unroll") for (int rg = 0; rg < 3; ++rg) { if (rg < 2 || rsub == 0) pf[sg * 3 + rg] = *(const u32x4*)(gs_ + (size_t)(rg * 8 * NPAD * 2) + goff); } } } while (0)
        asm volatile("s_waitcnt vmcnt(0) lgkmcnt(0)" ::: "memory");
        if (par == 0) st_flag(&flags[F_SETUP], 1u); else wait_ge(&flags[F_SETUP], 1u);
        const f32x4 pg4 = *(const f32x4*)(P->in[18] + (size_t)l * 384 + h * 64 + 4 * fr), pb4 = *(const f32x4*)(P->in[19] + (size_t)l * 384 + h * 64 + 4 * fr);
        bf16_t* obp = (bf16_t*)(P->ws + WS_OB);
#define POST_CHUNK(cl_) do { const unsigned cg_ = (unsigned)(cl_); \
            u32x2 gwv_[4]; \
            _Pragma("unroll") for (int i = 0; i < 4; ++i) gwv_[i] = *(const u32x2*)(ub + (m0 + (cl_) * CH + 4 * i + fq) * NPAD + U_GA + h * 64 + 4 * fr); \
            _Pragma("unroll") for (int j = 0; j < 4; ++j) wait_ge(&flags[F_CONS + j], cg_ + 1); \
            LAS const float* yb_ = (LAS const float*)(lds + SC_Y + par * YBUF_BYTES); \
            f32x4 yv_[4], bv_[4]; \
            _Pragma("unroll") for (int i = 0; i < 4; ++i) { const int tl_ = 4 * i + fq; yv_[i] = *(LAS const f32x4*)(yb_ + tl_ * 128 + 4 * fr); bv_[i] = *(LAS const f32x4*)(yb_ + tl_ * 128 + 64 + 4 * fr); } \
            st_flag(&flags[par ? F_POSTB : F_POST], (cg_ >> 1) + 1); \
            _Pragma("unroll") for (int i = 0; i < 4; ++i) { const size_t m_ = m0 + (cl_) * CH + 4 * i + fq; \
                const f32x4 y4_ = yv_[i]; \
                const float mean_ = red16((y4_[0] + y4_[1]) + (y4_[2] + y4_[3])) * (1.f / 64.f); \
                const f32x4 d_ = y4_ - mean_; \
                const float var_ = red16((d_[0] * d_[0] + d_[1] * d_[1]) + (d_[2] * d_[2] + d_[3] * d_[3])) * (1.f / 64.f); \
                const float rstd_ = __builtin_amdgcn_rsqf(var_ + GN_EPS); \
                f32x4 o_ = d_ * rstd_ * pg4 + pb4 + bv_[i]; \
                o_[0] *= siluf_(bflo(gwv_[i].x)); o_[1] *= siluf_(bfhi(gwv_[i].x)); o_[2] *= siluf_(bflo(gwv_[i].y)); o_[3] *= siluf_(bfhi(gwv_[i].y)); \
                u32x2 w_; w_.x = cvtpk(o_[0], o_[1]); w_.y = cvtpk(o_[2], o_[3]); \
                if (!(dbg & 256)) *(u32x2*)(obp + m_ * DM + h * 64 + 4 * fr) = w_; } } while (0)
        float cr_[8][4];
        f32x4 lmu_[2][4];
#pragma unroll
        for (int ks = 0; ks < 2; ++ks) { lmu_[ks][0] = *(LAS const f32x4*)(cst + 8 * 64 + 32 * ks + 8 * fq); lmu_[ks][1] = *(LAS const f32x4*)(cst + 8 * 64 + 32 * ks + 8 * fq + 4);
            lmu_[ks][2] = *(LAS const f32x4*)(cst + 9 * 64 + 32 * ks + 8 * fq); lmu_[ks][3] = *(LAS const f32x4*)(cst + 9 * 64 + 32 * ks + 8 * fq + 4); }
#pragma unroll
        for (int a_ = 0; a_ < 8; ++a_)
#pragma unroll
            for (int j = 0; j < 4; ++j) cr_[a_][j] = cst[a_ * 64 + 16 * j + fr];
        PREP_FETCH(par);
        for (int c = par; c < nch; c += 2) { cgl = (unsigned)c;
            const int t0 = c * CH;
            LAS unsigned char* raw = lds + par * RAWBUF;
#pragma unroll
            for (int sg = 0; sg < 5; ++sg)
#pragma unroll
                for (int rg = 0; rg < 3; ++rg) { if (rg < 2 || rsub == 0) *(LAS u32x4*)(raw + (sg * 3 + rg) * 1024 + lane * 16) = pf[sg * 3 + rg]; }
            if (t0 == 0 && rsub == 0) {
#pragma unroll
                for (int sg = 0; sg < 5; ++sg) {
                    u32x4 v = (u32x4){0u, 0u, 0u, 0u};
                    if (sample) { const int col_ = (sg < 3 ? sg * 384 + h * 64 : (sg == 3 ? U_WLO : U_ALO)) + c8 * 8;
                        const f32x4 a = *(const f32x4*)(sh0 + col_), bq = *(const f32x4*)(sh0 + col_ + 4); v.x = cvtpk(a[0], a[1]); v.y = cvtpk(a[2], a[3]); v.z = cvtpk(bq[0], bq[1]); v.w = cvtpk(bq[2], bq[3]); }
                    *(LAS u32x4*)(raw + sg * 3 * 1024 + c8 * 16) = v;
                }
            }
            asm volatile("" ::: "memory");
            if (c + 2 < nch) PREP_FETCH(c + 2);
            int zz = 0; asm volatile("" : "+v"(zz));
            LAS const float* cz = cst + zz;
            f32x4 Dw[4], Da[4];
            {
                bf16x8 Aw[2], Aa[2];
#pragma unroll
                for (int ks = 0; ks < 2; ++ks) {
                    const u32x4 cw = *(LAS const u32x4*)(raw + RAWOFF(fr + 1, 3, 32 * ks + 8 * fq)), pwv = *(LAS const u32x4*)(raw + RAWOFF(fr, 3, 32 * ks + 8 * fq));
                    const u32x4 ca = *(LAS const u32x4*)(raw + RAWOFF(fr + 1, 4, 32 * ks + 8 * fq)), pav = *(LAS const u32x4*)(raw + RAWOFF(fr, 4, 32 * ks + 8 * fq));
                    const f32x4 mw0 = lmu_[ks][0], mw1 = lmu_[ks][1], ma0 = lmu_[ks][2], ma1 = lmu_[ks][3];
                    u32x4 pw, pa;
#pragma unroll
                    for (int e = 0; e < 4; ++e) {
                        const float c0 = bflo(cw[e]), c1 = bfhi(cw[e]), p0 = bflo(pwv[e]), p1 = bfhi(pwv[e]);
                        const float m0_ = (e < 2 ? mw0[2 * e] : mw1[2 * e - 4]), m1_ = (e < 2 ? mw0[2 * e + 1] : mw1[2 * e - 3]);
                        const float z0 = c0 + (p0 - c0) * m0_, z1 = c1 + (p1 - c1) * m1_;
                        const float t0_ = 1.f - 2.f * fast_rcp(1.f + fast_exp2(2.f * LOG2E * z0)), t1_ = 1.f - 2.f * fast_rcp(1.f + fast_exp2(2.f * LOG2E * z1));
                        pw[e] = cvtpk(t0_, t1_);
                        const float d0 = bflo(ca[e]), d1 = bfhi(ca[e]), q0 = bflo(pav[e]), q1 = bfhi(pav[e]);
                        const float n0_ = (e < 2 ? ma0[2 * e] : ma1[2 * e - 4]), n1_ = (e < 2 ? ma0[2 * e + 1] : ma1[2 * e - 3]);
                        pa[e] = cvtpk(d0 + (q0 - d0) * n0_, d1 + (q1 - d1) * n1_);
                    }
                    Aw[ks] = __builtin_bit_cast(bf16x8, pw); Aa[ks] = __builtin_bit_cast(bf16x8, pa);
                }
#pragma unroll
                for (int j = 0; j < 4; ++j) {
                    const f32x4 z = (f32x4){0.f, 0.f, 0.f, 0.f};
                    LAS const unsigned char* bt = btab + zz + lane * 16;
                    Dw[j] = MFMA16(Aw[0], *(LAS const bf16x8*)(bt + ((0 * 4 + j) * 2 + 0) * 1024), z); Dw[j] = MFMA16(Aw[1], *(LAS const bf16x8*)(bt + ((0 * 4 + j) * 2 + 1) * 1024), Dw[j]);
                    Da[j] = MFMA16(Aa[0], *(LAS const bf16x8*)(bt + ((1 * 4 + j) * 2 + 0) * 1024), z); Da[j] = MFMA16(Aa[1], *(LAS const bf16x8*)(bt + ((1 * 4 + j) * 2 + 1) * 1024), Da[j]);
                }
            }
            if (cgl >= 2) {
#pragma unroll
                for (int j = 0; j < 4; ++j) wait_ge(&flags[F_CONS + j], cgl - 1);
            }
            LAS float* opb = (LAS float*)(lds + SC_OP + (cgl & 1) * OPBUF_BYTES);
            LAS float* bon = (LAS float*)(lds + SC_BON + (cgl & 1) * 64);
            float lr_[4], lk_[4], lv_[4];
#pragma unroll
            for (int i = 0; i < 4; ++i) {
                const int tl = 4 * fq + i; LAS const unsigned char* rc = raw + RAWOFF(tl + 1, 0, fr); LAS const unsigned char* rp = raw + RAWOFF(tl, 0, fr);
#define RB(p_, sg_, j_) bf2f(*(LAS const bf16_t*)((p_) + (sg_) * 3072 + (j_) * 32))
                float rr[4], kk[4], vv[4], aa[4], ww[4], kn[4]; float ss = 0.f;
#pragma unroll
                for (int j = 0; j < 4; ++j) {
                    const float cr = RB(rc, 0, j), ck = RB(rc, 1, j), cv = RB(rc, 2, j);
                    const float pr = i == 0 ? RB(rp, 0, j) : lr_[j], pk = i == 0 ? RB(rp, 1, j) : lk_[j], pv_ = i == 0 ? RB(rp, 2, j) : lv_[j];
                    lr_[j] = cr; lk_[j] = ck; lv_[j] = cv;
                    rr[j] = cr + (pr - cr) * cr_[0][j]; kk[j] = ck + (pk - ck) * cr_[1][j]; vv[j] = cv + (pv_ - cv) * cr_[2][j];
                    const float x = cr_[3][j] + Dw[j][i];
                    const float sg = fast_rcp(1.f + fast_exp2(-LOG2E * x));
                    ww[j] = fast_exp2(-0.60653066f * LOG2E * sg);
                    aa[j] = fast_rcp(1.f + fast_exp2(-LOG2E * (cr_[4][j] + Da[j][i])));
                    kn[j] = kk[j] * cr_[5][j]; ss += kn[j] * kn[j];
                }
                ss = red16(ss);
                const float rn = __builtin_amdgcn_rsqf(ss + 1e-12f);
                float bs = 0.f; LAS float* o = opb + tl * OPTOK + fr;
#pragma unroll
                for (int j = 0; j < 4; ++j) {
                    const float knn = kn[j] * rn, kp = kk[j] * (1.f + (aa[j] - 1.f) * cr_[6][j]);
                    bs += rr[j] * kp * cr_[7][j];
                    o[16 * j] = ww[j]; o[64 + 16 * j] = knn; o[128 + 16 * j] = knn * aa[j]; o[192 + 16 * j] = kp; o[256 + 16 * j] = rr[j]; o[320 + 16 * j] = vv[j];
                }
                bs = red16(bs);
                if (fr == 0) bon[tl] = bs;
#undef RB
            }
            st_flag(&flags[par ? F_PRODB : F_PROD], (cgl >> 1) + 1);
            if (c >= 2) POST_CHUNK(c - 2);
        }
        POST_CHUNK(nch - 2 + par);
        wait_ge(&flags[par ? F_PROD : F_PRODB], (unsigned)(nch / 2));
#undef POST_CHUNK
#undef PREP_FETCH
    }
}

DI void prep_simple(PP P, int l, LAS unsigned char* lds, int lane, int seq0, int nseq, bool sample, int dbg) {
    LAS unsigned* flags = (LAS unsigned*)(lds + SC_FLAGS);
    LAS float* Wd = (LAS float*)lds; LAS float* Wa = Wd + 4096;
    LAS float* lor = (LAS float*)(lds + 4 * WK_STRIDE);
    const bf16_t* ub = (const bf16_t*)(P->ws + WS_UB);
    const float* mu = P->in[10] + (size_t)l * SHW;
    unsigned cgl = 0;
    const int nch = sample ? TSS / CH : TP / CH;
    for (int s = 0; s < nseq; ++s) {
        const int seq = seq0 + s, b = seq / 6, h = seq % 6;
        const int kc = h * 64 + lane;
        const float mur = mu[U_R + kc], muk = mu[U_K + kc], muv = mu[U_V + kc], muw = mu[U_WLO + lane], mua = mu[U_ALO + lane];
        const float w0c = P->in[11][(size_t)l * 384 + kc], a0c = P->in[13][(size_t)l * 384 + kc], kkc = P->in[15][(size_t)l * 384 + kc], kac = P->in[16][(size_t)l * 384 + kc], rkc = P->in[17][(size_t)l * 384 + kc];
        const size_t m0 = sample ? (size_t)MP + (size_t)b * TSS : (size_t)b * TP;
        const int T = sample ? TSS : TP;
        const float* sh0 = P->in[8] + (size_t)(l * 32 + b) * SHW;
        { const float* wd = P->in[12] + (size_t)l * 64 * 384 + kc; const float* wa = P->in[14] + (size_t)l * 64 * 384 + kc;
#pragma unroll 4
          for (int i = 0; i < 64; ++i) { Wd[i * 64 + lane] = wd[(size_t)i * 384]; Wa[i * 64 + lane] = wa[(size_t)i * 384]; } }
        float pr = sample ? sh0[U_R + kc] : 0.f, pk = sample ? sh0[U_K + kc] : 0.f, pv = sample ? sh0[U_V + kc] : 0.f, pwl = sample ? sh0[U_WLO + lane] : 0.f, pal = sample ? sh0[U_ALO + lane] : 0.f;
        const bf16_t* row = ub + m0 * NPAD;
        unsigned short n_r = row[U_R + kc], n_k = row[U_K + kc], n_v = row[U_V + kc], n_wl = row[U_WLO + lane], n_al = row[U_ALO + lane];
        for (int c = 0; c < nch; ++c, ++cgl) {
            if (cgl >= 2) {
#pragma unroll
                for (int j = 0; j < 4; ++j) wait_ge(&flags[F_CONS + j], cgl - 1);
            }
            LAS float* opb = (LAS float*)(lds + SC_OP + (cgl & 1) * OPBUF_BYTES);
            LAS float* bon = (LAS float*)(lds + SC_BON + (cgl & 1) * 64);
#pragma unroll 1
            for (int tl = 0; tl < CH; ++tl) {
                const int t = c * CH + tl;
                const float cr = bf2f(n_r), ck = bf2f(n_k), cv = bf2f(n_v), cwl = bf2f(n_wl), cal = bf2f(n_al);
                { const bf16_t* nrow = ub + (m0 + (t + 1 < T ? t + 1 : t)) * NPAD;
                  n_r = nrow[U_R + kc]; n_k = nrow[U_K + kc]; n_v = nrow[U_V + kc]; n_wl = nrow[U_WLO + lane]; n_al = nrow[U_ALO + lane]; }
                const float r = cr + (pr - cr) * mur, k = ck + (pk - ck) * muk, v = cv + (pv - cv) * muv, zw = cwl + (pwl - cwl) * muw, za = cal + (pal - cal) * mua;
                pr = cr; pk = ck; pv = cv; pwl = cwl; pal = cal;
                lor[lane] = 1.f - 2.f * fast_rcp(1.f + fast_exp2(2.f * LOG2E * zw)); lor[64 + lane] = za;
                float dw = 0.f, da = 0.f;
#pragma unroll 2
                for (int i = 0; i < 64; i += 4) { const f32x4 tw = *(LAS const f32x4*)(lor + i), ta = *(LAS const f32x4*)(lor + 64 + i);
#pragma unroll
                    for (int e = 0; e < 4; ++e) { dw += tw[e] * Wd[(i + e) * 64 + lane]; da += ta[e] * Wa[(i + e) * 64 + lane]; } }
                const float x = w0c + dw;
                const float sg = fast_rcp(1.f + fast_exp2(-LOG2E * x));
                const float w = fast_exp2(-0.60653066f * LOG2E * sg);
                const float a = fast_rcp(1.f + fast_exp2(-LOG2E * (a0c + da)));
                const float kn = k * kkc; const float ss = wave_sum(kn * kn);
                const float knn = kn * (1.f / sqrtf(ss + 1e-12f));
                const float kp = k * (1.f + (a - 1.f) * kac);
                const float bs = wave_sum(r * kp * rkc);
                LAS float* o = opb + tl * OPTOK + lane;
                o[0] = w; o[64] = knn; o[128] = knn * a; o[192] = kp; o[256] = r; o[320] = v;
                if (lane == 0) bon[tl] = bs;
            }
            st_flag(&flags[F_PROD], cgl + 1);
        }
    }
}

DI void post_wave(PP P, int l, LAS unsigned char* lds, int lane, int seq0, int nseq, bool sample, int dbg) {
    const int r16 = lane & 15, tq = lane >> 4;
    LAS unsigned* flags = (LAS unsigned*)(lds + SC_FLAGS);
    const bf16_t* ub = (const bf16_t*)(P->ws + WS_UB); bf16_t* ob = (bf16_t*)(P->ws + WS_OB);
    unsigned cgl = 0;
    const int nch = sample ? TSS / CH : TP / CH;
    for (int s = 0; s < nseq; ++s) {
        const int seq = seq0 + s, b = seq / 6, h = seq % 6;
        const size_t m0 = sample ? (size_t)MP + (size_t)b * TSS : (size_t)b * TP;
        const f32x4 g4 = *(const f32x4*)(P->in[18] + (size_t)l * 384 + h * 64 + 4 * r16), b4 = *(const f32x4*)(P->in[19] + (size_t)l * 384 + h * 64 + 4 * r16);
        for (int c = 0; c < nch; ++c, ++cgl) {
            if (dbg & 1) { for (int j = 0; j < 4; ++j) wait_ge(&flags[F_CONS + j], cgl + 1); st_flag(&flags[F_POST], cgl + 1); continue; }
            u32x2 gwv[4];
#pragma unroll
            for (int i = 0; i < 4; ++i) gwv[i] = *(const u32x2*)(ub + (m0 + c * CH + 4 * i + tq) * NPAD + U_GA + h * 64 + 4 * r16);
#pragma unroll
            for (int j = 0; j < 4; ++j) wait_ge(&flags[F_CONS + j], cgl + 1);
            LAS const float* yb = (LAS const float*)(lds + SC_Y + (cgl & 1) * YBUF_BYTES);
#pragma unroll
            for (int i = 0; i < 4; ++i) {
                const int tl = 4 * i + tq; const size_t m = m0 + c * CH + tl;
                const f32x4 y4 = *(LAS const f32x4*)(yb + tl * 128 + 4 * r16), bv4 = *(LAS const f32x4*)(yb + tl * 128 + 64 + 4 * r16);
                const u32x2 gw = gwv[i];
                const float mean = red16((y4[0] + y4[1]) + (y4[2] + y4[3])) * (1.f / 64.f);
                const f32x4 d = y4 - mean;
                const float var = red16((d[0] * d[0] + d[1] * d[1]) + (d[2] * d[2] + d[3] * d[3])) * (1.f / 64.f);
                const float rstd = 1.f / sqrtf(var + GN_EPS);
                f32x4 o = d * rstd * g4 + b4 + bv4;
                o[0] *= siluf_(bflo(gw.x)); o[1] *= siluf_(bfhi(gw.x)); o[2] *= siluf_(bflo(gw.y)); o[3] *= siluf_(bfhi(gw.y));
                u32x2 w; w.x = cvtpk(o[0], o[1]); w.y = cvtpk(o[2], o[3]);
                if (!(dbg & 256)) *(u32x2*)(ob + m * DM + h * 64 + 4 * r16) = w;
            }
            st_flag(&flags[F_POST], cgl + 1);
        }
    }
}

DI void naive_seq(PP P, int l, LAS unsigned char* sl, int lane, int b, int h, bool sample) {
    LAS float* opl = (LAS float*)sl;
    LAS float* lor = opl + 384;
    const bf16_t* ub = (const bf16_t*)(P->ws + WS_UB); bf16_t* ob = (bf16_t*)(P->ws + WS_OB);
    const float* mu = P->in[10] + (size_t)l * SHW;
    const int kc = h * 64 + lane;
    const float mur = mu[U_R + kc], muk = mu[U_K + kc], muv = mu[U_V + kc], muw = mu[U_WLO + lane], mua = mu[U_ALO + lane];
    const float w0c = P->in[11][(size_t)l * 384 + kc], a0c = P->in[13][(size_t)l * 384 + kc], kkc = P->in[15][(size_t)l * 384 + kc], kac = P->in[16][(size_t)l * 384 + kc], rkc = P->in[17][(size_t)l * 384 + kc];
    const float gng = P->in[18][(size_t)l * 384 + kc], gnb = P->in[19][(size_t)l * 384 + kc];
    const size_t m0 = sample ? (size_t)MP + (size_t)b * TSS : (size_t)b * TP;
    const int T = sample ? TSS : TP;
    const float* sh0 = P->in[8] + (size_t)(l * 32 + b) * SHW;
    LAS float* Wd = opl + 512; LAS float* Wa = Wd + 4096;
    { const float* wd = P->in[12] + (size_t)l * 64 * 384 + kc; const float* wa = P->in[14] + (size_t)l * 64 * 384 + kc;
#pragma unroll 4
      for (int i = 0; i < 64; ++i) { Wd[i * 64 + lane] = wd[(size_t)i * 384]; Wa[i * 64 + lane] = wa[(size_t)i * 384]; } }
    float S[64];
    if (sample) { const float* sp = P->in[7] + ((size_t)((l * 32 + b) * 6 + h) * 64 + lane) * 64;
#pragma unroll
        for (int k = 0; k < 64; ++k) S[k] = sp[k]; }
    else {
#pragma unroll
        for (int k = 0; k < 64; ++k) S[k] = 0.f; }
    float pr = sample ? sh0[U_R + kc] : 0.f, pk = sample ? sh0[U_K + kc] : 0.f, pv = sample ? sh0[U_V + kc] : 0.f, pwl = sample ? sh0[U_WLO + lane] : 0.f, pal = sample ? sh0[U_ALO + lane] : 0.f;
    const bf16_t* row = ub + m0 * NPAD;
    unsigned short n_r = row[U_R + kc], n_k = row[U_K + kc], n_v = row[U_V + kc], n_wl = row[U_WLO + lane], n_al = row[U_ALO + lane], n_g = row[U_GA + kc];
#pragma unroll 1
    for (int t = 0; t < T; ++t) {
        const float cr = bf2f(n_r), ck = bf2f(n_k), cv = bf2f(n_v), cwl = bf2f(n_wl), cal = bf2f(n_al), cg = bf2f(n_g);
        { const bf16_t* nrow = ub + (m0 + (t + 1 < T ? t + 1 : t)) * NPAD;
          n_r = nrow[U_R + kc]; n_k = nrow[U_K + kc]; n_v = nrow[U_V + kc]; n_wl = nrow[U_WLO + lane]; n_al = nrow[U_ALO + lane]; n_g = nrow[U_GA + kc]; }
        const float r = cr + (pr - cr) * mur, k = ck + (pk - ck) * muk, v = cv + (pv - cv) * muv, zw = cwl + (pwl - cwl) * muw, za = cal + (pal - cal) * mua;
        pr = cr; pk = ck; pv = cv; pwl = cwl; pal = cal;
        lor[lane] = tanhf(zw); lor[64 + lane] = za;
        float dw = 0.f, da = 0.f;
#pragma unroll 1
        for (int i = 0; i < 64; i += 4) { const f32x4 tw = *(LAS const f32x4*)(lor + i), ta = *(LAS const f32x4*)(lor + 64 + i);
#pragma unroll
            for (int e = 0; e < 4; ++e) { dw += tw[e] * Wd[(i + e) * 64 + lane]; da += ta[e] * Wa[(i + e) * 64 + lane]; } }
        const float x = w0c + dw;
        const float wlog = -log1pf(expf(-x)) - 0.5f;
        const float w = expf(-expf(wlog));
        const float a = 1.f / (1.f + expf(-(a0c + da)));
        const float kn = k * kkc; const float ss = wave_sum(kn * kn);
        const float knn = kn * (1.f / sqrtf(ss + 1e-12f));
        const float kp = k * (1.f + (a - 1.f) * kac);
        const float bs = wave_sum(r * kp * rkc);
        opl[lane] = w; opl[64 + lane] = knn; opl[128 + lane] = knn * a; opl[192 + lane] = kp; opl[256 + lane] = r; opl[320 + lane] = v;
        const float vv = v;
        float sa = 0.f;
#pragma unroll
        for (int i = 0; i < 64; i += 4) { const f32x4 q = *(LAS const f32x4*)(opl + 64 + i);
#pragma unroll
            for (int e = 0; e < 4; ++e) sa += S[i + e] * q[e]; }
        float y = 0.f;
#pragma unroll
        for (int i = 0; i < 64; i += 4) { const f32x4 qw = *(LAS const f32x4*)(opl + i), qa = *(LAS const f32x4*)(opl + 128 + i), qk = *(LAS const f32x4*)(opl + 192 + i), qr = *(LAS const f32x4*)(opl + 256 + i);
#pragma unroll
            for (int e = 0; e < 4; ++e) { S[i + e] = S[i + e] * qw[e] - sa * qa[e] + vv * qk[e]; y += S[i + e] * qr[e]; } }
        const float mean = wave_sum(y) * (1.f / 64.f); const float d = y - mean;
        const float var = wave_sum(d * d) * (1.f / 64.f);
        float o = d * (1.f / sqrtf(var + GN_EPS)) * gng + gnb + bs * vv;
        o *= cg / (1.f + expf(-cg));
        ob[(m0 + t) * DM + kc] = (bf16_t)(cvtpk(o, o) & 0xffffu);
        asm volatile("" ::: "memory");
    }
    float* so = P->out + (sample ? O_SWKV : O_PWKV) + ((size_t)((l * 32 + b) * 6 + h) * 64 + lane) * 64;
#pragma unroll
    for (int k = 0; k < 64; k += 4) *(f32x4*)(so + k) = (f32x4){S[k], S[k + 1], S[k + 2], S[k + 3]};
}

DI bf16x8 ld_bf16x8(const bf16_t* p) { return *(const bf16x8*)p; }
DI bf16x8 cvt_f32x8(const float* p) { const f32x4 a = *(const f32x4*)p, b = *(const f32x4*)(p + 4); u32x4 w; w.x = cvtpk(a[0], a[1]); w.y = cvtpk(a[2], a[3]); w.z = cvtpk(b[0], b[1]); w.w = cvtpk(b[2], b[3]); return __builtin_bit_cast(bf16x8, w); }
DI bf16x8 pack8(const f32x16& x, int s) { u32x4 w; w.x = cvtpk(x[8 * s], x[8 * s + 1]); w.y = cvtpk(x[8 * s + 2], x[8 * s + 3]); w.z = cvtpk(x[8 * s + 4], x[8 * s + 5]); w.w = cvtpk(x[8 * s + 6], x[8 * s + 7]); return __builtin_bit_cast(bf16x8, w); }
DI bf16x8 vfrag(LAS const unsigned char* p) {
    const v4i16_t lo = __builtin_amdgcn_ds_read_tr16_b64_v4i16((LAS v4i16_t*)p), hi = __builtin_amdgcn_ds_read_tr16_b64_v4i16((LAS v4i16_t*)(p + 512));
    return (bf16x8){lo[0], lo[1], lo[2], lo[3], hi[0], hi[1], hi[2], hi[3]};
}

struct AttnState { f32x16 o0, o1; float m_run, l_run, carry; };

template <int KIND, bool F32>
DI void attn_tile(AttnState& st, const bf16x8 (&qr)[4], bf16x8 (&kf)[4], f32x4 (&kq)[8], bf16x8 (&vr)[4], f32x4 (&vq)[8], const char* knext, const char* vnext, unsigned vpitch16, float lf, bool diag, LAS unsigned char* wl, int lane) {
    const int r32 = lane & 31, hi = lane >> 5;
    LAS float* sm = (LAS float*)(wl + 8192);
#pragma unroll
    for (int pc = 0; pc < 4; ++pc) {
        if (F32) { u32x4 x; x.x = cvtpk(vq[2 * pc][0], vq[2 * pc][1]); x.y = cvtpk(vq[2 * pc][2], vq[2 * pc][3]); x.z = cvtpk(vq[2 * pc + 1][0], vq[2 * pc + 1][1]); x.w = cvtpk(vq[2 * pc + 1][2], vq[2 * pc + 1][3]);
            *(LAS u32x4*)(wl + pc * 1024 + lane * 16) = x; }
        else *(LAS bf16x8*)(wl + pc * 1024 + lane * 16) = vr[pc];
    }
#pragma unroll
    for (int pc = 0; pc < 4; ++pc) {
        if (F32) { const char* p_ = vnext + (size_t)((pc & 1) * vpitch16 + (pc >> 1) * 128); vq[2 * pc] = *(const f32x4*)p_; vq[2 * pc + 1] = *(const f32x4*)(p_ + 16); }
        else vr[pc] = *(const bf16x8*)(vnext + pc * 1024);
    }
    if (F32) {
#pragma unroll
        for (int i = 0; i < 4; ++i) { u32x4 w; w.x = cvtpk(kq[2 * i][0], kq[2 * i][1]); w.y = cvtpk(kq[2 * i][2], kq[2 * i][3]); w.z = cvtpk(kq[2 * i + 1][0], kq[2 * i + 1][1]); w.w = cvtpk(kq[2 * i + 1][2], kq[2 * i + 1][3]);
            kf[i] = __builtin_bit_cast(bf16x8, w); }
    }
    f32x16 p = {};
#pragma unroll
    for (int d0 = 0; d0 < 4; ++d0) p = MFMA32(kf[d0], qr[d0], p);
    asm volatile("" : "+v"(p));
    LAS const unsigned char* vb = wl + ((lane >> 4) & 1) * 32 + (lane & 3) * 8 + (4 * hi + ((lane & 15) >> 2)) * 64;
    const bf16x8 vf0 = vfrag(vb + 0 * 1024), vf1 = vfrag(vb + 1 * 1024), vf2 = vfrag(vb + 2 * 1024), vf3 = vfrag(vb + 3 * 1024);
    if (F32) {
#pragma unroll
        for (int d0 = 0; d0 < 4; ++d0) { kq[2 * d0] = *(const f32x4*)(knext + 64 * d0); kq[2 * d0 + 1] = *(const f32x4*)(knext + 64 * d0 + 16); }
    } else {
#pragma unroll
        for (int d0 = 0; d0 < 4; ++d0) kf[d0] = *(const bf16x8*)(knext + d0 * 1024);
    }
    if (KIND == 0) {
        float incl = lf;
#pragma unroll
        for (int off = 1; off < 32; off <<= 1) { const float t = __shfl_down(incl, off, 32); if (r32 + off < 32) incl += t; }
        const float bias = (st.carry + (incl - lf)) * LOG2E;
        const float tot = __shfl(incl, 0, 32);
        if (hi == 0) sm[r32] = bias;
        st.carry += tot;
        float s[16];
#pragma unroll
        for (int g = 0; g < 4; ++g) { const f32x4 b4 = *(LAS const f32x4*)(sm + 8 * g + 4 * hi);
#pragma unroll
            for (int e = 0; e < 4; ++e) s[4 * g + e] = p[4 * g + e] * QSCALE2 + b4[e]; }
        if (diag) {
#pragma unroll
            for (int r = 0; r < 16; ++r) if (crow(r, hi) > r32) s[r] = -1e30f;
        }
        if (diag) {
            float mt = s[0];
#pragma unroll
            for (int r = 1; r < 16; ++r) mt = fmaxf(mt, s[r]);
            { auto rr = __builtin_amdgcn_permlane32_swap(__float_as_uint(mt), __float_as_uint(mt), false, false); mt = fmaxf(__uint_as_float(rr[0]), __uint_as_float(rr[1])); }
            st.m_run = mt;
        }
        float ls = 0.f;
#pragma unroll
        for (int r = 0; r < 16; ++r) { p[r] = fast_exp2(s[r] - st.m_run); ls += p[r]; }
        st.l_run += ls;
    } else {
        float be[16], om[16];
#pragma unroll
        for (int r = 0; r < 16; ++r) {
            const float z2 = fmaxf(p[r] * QSCALE2, -80.f);
            const float e = fast_exp2(-z2); const float bt = fast_rcp(1.f + e);
            be[r] = bt; om[r] = e * bt;
        }
        if (diag) {
#pragma unroll
            for (int r = 0; r < 16; ++r) if (crow(r, hi) >= r32) { be[r] = 0.f; om[r] = 1.f; }
        }
        float H[4], oth[4];
#pragma unroll
        for (int g = 0; g < 4; ++g) { const float gp = (om[4 * g] * om[4 * g + 1]) * (om[4 * g + 2] * om[4 * g + 3]);
            auto rr = __builtin_amdgcn_permlane32_swap(__float_as_uint(gp), __float_as_uint(gp), false, false);
            const float a = __uint_as_float(rr[0]), b = __uint_as_float(rr[1]); H[g] = a * b; oth[g] = hi ? 1.f : b; }
        float suf[4]; suf[3] = 1.f; suf[2] = H[3]; suf[1] = H[3] * H[2]; suf[0] = suf[1] * H[1];
        const float cin = st.carry;
#pragma unroll
        for (int g = 0; g < 4; ++g) {
            float A = cin * suf[g] * oth[g];
            p[4 * g + 3] = be[4 * g + 3] * A; A *= om[4 * g + 3];
            p[4 * g + 2] = be[4 * g + 2] * A; A *= om[4 * g + 2];
            p[4 * g + 1] = be[4 * g + 1] * A; A *= om[4 * g + 1];
            p[4 * g + 0] = be[4 * g + 0] * A;
        }
        st.carry = cin * suf[0] * H[0];
    }
    const bf16x8 pa0 = pack8(p, 0), pa1 = pack8(p, 1);
    st.o0 = MFMA32(pa0, vf0, st.o0);
    st.o1 = MFMA32(pa0, vf2, st.o1);
    st.o0 = MFMA32(pa1, vf1, st.o0);
    st.o1 = MFMA32(pa1, vf3, st.o1);
    if (F32) {
#pragma unroll
        for (int i = 0; i < 8; ++i) { asm volatile("" : "+v"(kq[i])); asm volatile("" : "+v"(vq[i])); }
    } else {
#pragma unroll
        for (int i = 0; i < 4; ++i) { asm volatile("" : "+v"(kf[i])); asm volatile("" : "+v"(vr[i])); }
    }
}

template <int KIND>
DI void attn_item(PP P, int l, LAS unsigned char* wl, int lane, bool sample, int b, int h, int qb) {
    const int r32 = lane & 31, hi = lane >> 5;
    const char* ubb = (const char*)(P->ws + WS_UB);
    constexpr unsigned PITCH = NPAD * 2;
    constexpr int NH = KIND == 0 ? NHB : NHC;
    constexpr int QC = KIND == 0 ? U_QB : U_QC, KC = KIND == 0 ? U_KB : U_KC, VC = KIND == 0 ? U_VB : U_VC, GC = KIND == 0 ? U_GB : U_GC, OC = KIND == 0 ? 384 : 768;
    const int q0 = qb * 32, past = sample ? PAST : 0;
    const unsigned row0 = sample ? (unsigned)(MP + b * TSS) : (unsigned)(b * TP);
    const unsigned kl = (unsigned)(r32 * NPAD + KC + h * 64 + 8 * hi) * 2u;
    const unsigned vl = (unsigned)((lane >> 2) * NPAD + VC + h * 64 + (lane & 3) * 8) * 2u;
    bf16x8 qr[4];
    { const char* qp = ubb + (size_t)((row0 + q0) * PITCH + (unsigned)(r32 * NPAD + QC + h * 64 + 8 * hi) * 2u);
#pragma unroll
      for (int d0 = 0; d0 < 4; ++d0) qr[d0] = *(const bf16x8*)(qp + 32 * d0); }
    AttnState st; st.o0 = f32x16{}; st.o1 = f32x16{}; st.m_run = -1e30f; st.l_run = 0.f; st.carry = KIND == 0 ? 0.f : 1.f;
    const int tdiag = (past + q0) / 32, tnew0 = past / 32;
    const float* logf = (const float*)(P->ws + WS_LOGF) + h;
    bf16x8 kf[4], vr[4]; f32x4 kq[8], vq[8];
    {
        const unsigned tix0 = sample ? (unsigned)(32 * NH * 64 + (b * NH + h) * 2) : (unsigned)((b * NH + h) * 64);
        const char* kbb = (const char*)(P->ws + (KIND == 0 ? WS_BFK : WS_BSK)) + (size_t)tix0 * 4096 + lane * 16;
        const char* vbb = (const char*)(P->ws + (KIND == 0 ? WS_BFV : WS_BSV)) + (size_t)tix0 * 4096 + lane * 16;
        float lf = 0.f;
        { const unsigned tl_ = (unsigned)(tdiag - tnew0); const unsigned trow_ = row0 + tl_ * 32u;
#pragma unroll
          for (int d0 = 0; d0 < 4; ++d0) kf[d0] = *(const bf16x8*)(kbb + (size_t)(tl_ * 4096u) + d0 * 1024);
#pragma unroll
          for (int pc = 0; pc < 4; ++pc) vr[pc] = *(const bf16x8*)(vbb + (size_t)(tl_ * 4096u) + pc * 1024);
          if (KIND == 0) lf = logf[(size_t)(trow_ + r32) * 8]; }
        for (int tile = tdiag; tile >= tnew0; --tile) {
            const unsigned tn = (unsigned)((tile > tnew0 ? tile - 1 : tnew0) - tnew0);
            const unsigned trow_ = row0 + tn * 32u;
            const float lfc = lf;
            if (KIND == 0) lf = logf[(size_t)(trow_ + r32) * 8];
            attn_tile<KIND, false>(st, qr, kf, kq, vr, vq, kbb + (size_t)(tn * 4096u), vbb + (size_t)(tn * 4096u), 0u, lfc, tile == tdiag, wl, lane);
        }
    }
    if (sample) {
        const char* cK = (const char*)(P->in[KIND == 0 ? 2 : 5] + (size_t)(l * 32 + b) * PAST * NH * 64 + h * 64);
        const char* cV = (const char*)(P->in[KIND == 0 ? 3 : 6] + (size_t)(l * 32 + b) * PAST * NH * 64 + h * 64);
        const float* cL = P->in[4] + (size_t)(l * 32 + b) * PAST * 6 + h;
        constexpr unsigned CP = NH * 64 * 4;
        const unsigned klc = (unsigned)r32 * CP + 32u * hi, vlc = (unsigned)(lane >> 2) * CP + 32u * (lane & 3);
        float lf = 0.f;
        { const char* kb_ = cK + (size_t)((unsigned)(tnew0 - 1) * 32u * CP) + klc;
#pragma unroll
          for (int d0 = 0; d0 < 4; ++d0) { kq[2 * d0] = *(const f32x4*)(kb_ + 64 * d0); kq[2 * d0 + 1] = *(const f32x4*)(kb_ + 64 * d0 + 16); }
          const char* vb_ = cV + (size_t)((unsigned)(tnew0 - 1) * 32u * CP) + vlc;
#pragma unroll
          for (int pc = 0; pc < 4; ++pc) { const char* p_ = vb_ + (size_t)((pc & 1) * (16u * CP) + (pc >> 1) * 128); vq[2 * pc] = *(const f32x4*)p_; vq[2 * pc + 1] = *(const f32x4*)(p_ + 16); }
          if (KIND == 0) lf = cL[(size_t)((tnew0 - 1) * 32 + r32) * 6]; }
        for (int tile = tnew0 - 1; tile >= 0; --tile) {
            const int tn = tile > 0 ? tile - 1 : 0;
            const float lfc = lf;
            if (KIND == 0) lf = cL[(size_t)(tn * 32 + r32) * 6];
            attn_tile<KIND, true>(st, qr, kf, kq, vr, vq, cK + (size_t)((unsigned)tn * 32u * CP) + klc, cV + (size_t)((unsigned)tn * 32u * CP) + vlc, 16u * CP, lfc, false, wl, lane);
        }
    }
    LAS float* stg = (LAS float*)wl; LAS float* sm = (LAS float*)(wl + 8192);
    if (KIND == 0) {
        auto rr = __builtin_amdgcn_permlane32_swap(__float_as_uint(st.l_run), __float_as_uint(st.l_run), false, false);
        const float lt = __uint_as_float(rr[0]) + __uint_as_float(rr[1]);
        if (hi == 0) sm[r32] = 1.f / lt;
    }
#pragma unroll
    for (int r = 0; r < 16; ++r) { stg[crow(r, hi) * 64 + r32] = st.o0[r]; stg[crow(r, hi) * 64 + 32 + r32] = st.o1[r]; }
    char* obb = (char*)(P->ws + WS_OB);
#pragma unroll
    for (int i = 0; i < 4; ++i) {
        const int row = i * 8 + (lane >> 3), chn = lane & 7;
        const f32x4 a = *(LAS const f32x4*)(stg + row * 64 + chn * 8), c = *(LAS const f32x4*)(stg + row * 64 + chn * 8 + 4);
        const float li = KIND == 0 ? sm[row] : 1.f;
        const unsigned m = row0 + q0 + row;
        const u32x4 g = *(const u32x4*)(ubb + (size_t)(m * PITCH + (unsigned)(GC + h * 64 + chn * 8) * 2u));
        u32x4 w;
        w.x = cvtpk(a[0] * li * siluf_(bflo(g.x)), a[1] * li * siluf_(bfhi(g.x))); w.y = cvtpk(a[2] * li * siluf_(bflo(g.y)), a[3] * li * siluf_(bfhi(g.y)));
        w.z = cvtpk(c[0] * li * siluf_(bflo(g.z)), c[1] * li * siluf_(bfhi(g.z))); w.w = cvtpk(c[2] * li * siluf_(bflo(g.w)), c[3] * li * siluf_(bfhi(g.w)));
        *(u32x4*)(obb + (size_t)(m * (DM * 2) + (unsigned)(OC + h * 64 + chn * 8) * 2u)) = w;
    }
}

constexpr int Q_SAMPLE = 2 * (16 + 24), Q_ITEMS = Q_SAMPLE + 40 * 64;
DI unsigned xcc_id() { return (unsigned)__builtin_amdgcn_s_getreg((3 << 11) | 20) & 7u; }
DI void worker_loop(PP P, int l, int lq, LAS unsigned char* lds, int wave, int lane) {
    LAS unsigned char* wl = lds + wave * WK_STRIDE;
    unsigned* qbase = (unsigned*)(P->ws + WS_CTL) + 64 + lq * 128;
    const unsigned x0 = xcc_id();
    for (unsigned sx = 0; sx < 8; ++sx) {
        const unsigned x = (x0 + sx) & 7u;
        unsigned* qctr = qbase + x * 16;
        for (;;) {
            unsigned idx = 0;
            if (lane == 0) idx = atomicAdd(qctr, 1u);
            idx = (unsigned)__builtin_amdgcn_readfirstlane((int)idx);
            if (idx >= (unsigned)Q_ITEMS) break;
            int kind, smp, bh, qb;
            if (idx < (unsigned)Q_SAMPLE) {
                smp = 1;
                if (idx < 32u) { kind = 1; bh = (int)x + 8 * (int)(idx >> 1); qb = idx & 1; }
                else { const int i2 = idx - 32; kind = 0; bh = (int)x + 8 * (i2 >> 1); qb = i2 & 1; }
            } else {
                smp = 0;
                const int i2 = idx - Q_SAMPLE, g = i2 >> 6; qb = 63 - (i2 & 63);
                if (g < 16) { kind = 1; bh = (int)x + 8 * g; } else { kind = 0; bh = (int)x + 8 * (g - 16); }
            }
            if (kind) attn_item<1>(P, l, wl, lane, smp != 0, bh / NHC, bh % NHC, qb);
            else attn_item<0>(P, l, wl, lane, smp != 0, bh / NHB, bh % NHB, qb);
        }
    }
}

DI void phase_mix(PP P, int lq, LAS unsigned char* lds, int wave, int lane, int bidx, int gdim) {
    const int l = lq & 1; const int dbg = (lq & 2) ? (P->dbg | 256) : 0;
    if (wave == 0 && lane < 16) ((LAS unsigned*)(lds + SC_FLAGS))[lane] = 0u;
    __syncthreads();
    const int bx = bidx;
#ifdef NAIVE_SCAN
    if (wave == 0) {
        for (int sq = bx; sq < 384; sq += gdim) {
            if (sq < 192) naive_seq(P, l, lds + SC_OFF, lane, sq / 6, sq % 6, false);
            else naive_seq(P, l, lds + SC_OFF, lane, (sq - 192) / 6, (sq - 192) % 6, true);
        }
    }
#else
    if (gdim >= 256 && !(dbg & 16)) {
        if (bx < 192) {
#ifndef SK_SCAN
            if (wave < 4) scan_wave(P, l, lds, wave, lane, bx, 1, false, dbg, true);
#endif
#ifndef SK_PREP
            if (wave == 4 || wave == 5) helper2_wave(P, l, lds, lane, bx, wave - 4, dbg);
#endif
        } else if (bx < 256) {
            const int s0 = (bx - 192) * 3;
#ifndef SK_SCAN
            if (wave < 4) scan_wave(P, l, lds, wave, lane, s0, 3, true, dbg);
#endif
#ifndef SK_PREP
            if (wave == 4) PREPFN(P, l, lds, lane, s0, 3, true, dbg);
#endif
#ifndef SK_POST
            if (wave == 5) post_wave(P, l, lds, lane, s0, 3, true, dbg);
#endif
        }
    }
#endif
#ifndef SK_WORK
    if (!(dbg & 4)) worker_loop(P, l, lq, lds, wave, lane);
#endif
}

__global__ void __launch_bounds__(512, 2) fwd_kernel(Params Pv) {
    extern __shared__ __attribute__((aligned(16))) unsigned char lds_raw[];
    LAS unsigned char* lds = (LAS unsigned char*)lds_raw;
    const int tid = threadIdx.x, lane0 = tid & 63, wave0 = __builtin_amdgcn_readfirstlane(tid >> 6);
    PP P0 = (PP)__builtin_amdgcn_kernarg_segment_ptr();
    const int lo = Pv.ph_lo, hi = Pv.ph_hi;
    const int rep_ph = Pv.rep_ph;
#pragma unroll 1
    for (int ph2 = lo * 2; ph2 < hi * 2; ++ph2) {
        const int ph = ph2 >> 1, rep = ph2 & 1;
        if (rep && ph != rep_ph) continue;
        PP P = pp_launder(P0);
        int lane = lane0, wave = wave0, bidx = (int)blockIdx.x, gdim = (int)gridDim.x;
        asm volatile("" : "+v"(lane)); asm volatile("" : "+s"(wave)); asm volatile("" : "+s"(bidx)); asm volatile("" : "+s"(gdim));
        if (ph == 0) {
#ifndef SK_P0
            phase0(P, lds, wave, lane, bidx, gdim);
#endif
        } else {
            const int l = (ph - 1) >> 2, k = (ph - 1) & 3;
            if (k == 0 || k == 2) {
#ifndef SK_G1
                pg8::Gemm g; pg8::StaticOrder S; EpiU E;
                E.ws = P->ws; E.out = P->out; E.fb = P->in[20] + l * 6; E.l = l; E.mode = k;
                if (k == 0) { g = pg8::Gemm{(const bf16_t*)(P->ws + WS_XB), (const bf16_t*)(P->ws + WS_WIN) + (size_t)l * NPAD * DM, MT, NPAD, DM}; S.init(MT, NPAD, gdim, bidx); }
                else { g = pg8::Gemm{(const bf16_t*)(P->ws + WS_OB), (const bf16_t*)(P->ws + WS_WOUT) + (size_t)l * DM * DM, MT, DM, DM}; S.init(MT, DM, gdim, bidx); }
                pg8::gemm_phase<EpiU, pg8::StaticOrder, true, true>(lds, g, S, E);
#endif
            } else if (k == 1) {
#ifndef SK_MIX
                phase_mix(P, l + 2 * rep, lds, wave, lane, bidx, gdim);
#endif
            } else {
#ifndef SK_LN
                phase_ln(P, l, wave, lane, bidx, gdim);
#endif
            }
        }
        if (ph2 + 1 < hi * 2) cg::this_grid().sync();
    }
}

extern "C" void kernel_launch(void* const* d_in, const int* in_sizes, int n_in, void* d_out, int out_size, void* d_ws, size_t ws_size, hipStream_t stream) {
    static int grid = 0;
    if (grid == 0) {
        if (n_in != 24 || (size_t)out_size != O_END || ws_size < WS_END) { fprintf(stderr, "kernel_launch: unexpected shapes n_in %d out %d ws %zu\n", n_in, out_size, ws_size); grid = -1; return; }
        int dev = 0, cus = 0, per_cu = 0;
        (void)hipGetDevice(&dev); (void)hipDeviceGetAttribute(&cus, hipDeviceAttributeMultiprocessorCount, dev);
        if (hipFuncSetAttribute((const void*)fwd_kernel, hipFuncAttributeMaxDynamicSharedMemorySize, LDS_BYTES) != hipSuccess) { fprintf(stderr, "kernel_launch: hipFuncSetAttribute failed\n"); grid = -1; return; }
        if (hipOccupancyMaxActiveBlocksPerMultiprocessor(&per_cu, (const void*)fwd_kernel, 512, LDS_BYTES) != hipSuccess || per_cu < 1) { fprintf(stderr, "kernel_launch: occupancy query says %d\n", per_cu); per_cu = 1; }
        (void)hipGetLastError();
        grid = cus * 1;
        if (grid != 256) fprintf(stderr, "kernel_launch: grid %d (expected 256)\n", grid);
    }
    if (grid < 0) return;
    (void)hipMemsetAsync((char*)d_ws + WS_CTL, 0, CTL_BYTES, stream);
    Params p{};
    for (int i = 0; i < 24; ++i) p.in[i] = (const float*)d_in[i];
    p.out = (float*)d_out; p.ws = (unsigned char*)d_ws; p.ph_lo = 0; p.ph_hi = 9; p.rep_ph = -1; p.dbg = 0;
    void* args[] = {&p};
    hipError_t e = hipLaunchCooperativeKernel((const void*)fwd_kernel, dim3(grid), dim3(512), args, LDS_BYTES, stream);
    if (e != hipSuccess) fprintf(stderr, "cooperative launch failed: %s (grid %d)\n", hipGetErrorString(e), grid);
}
```

```cpp
#define PREPFN prep_wave
#include <hip/hip_runtime.h>
#include <hip/hip_cooperative_groups.h>
#include <cstdio>
#include <cstdint>
namespace cg = cooperative_groups;
namespace pg8 {
#define PG8_LAS __attribute__((address_space(3)))
typedef unsigned short bf16_t;
typedef short bf16x8 __attribute__((ext_vector_type(8)));
typedef float f32x4 __attribute__((ext_vector_type(4)));
typedef unsigned u32x4 __attribute__((ext_vector_type(4)));
constexpr int BM = 256, BK = 64, HALF = 128, HTB = HALF * BK * 2  , STAGE_BYTES = 8 * HTB, NXCD = 8, WGM = 8;

__host__ __device__ __forceinline__ int lds_byte(int r, int c) { const int st = (r >> 4) * 2 + (c >> 5), rr = r & 15, cc = c & 31, ob = rr * 64 + cc * 2; return st * 1024 + (ob ^ (((ob >> 9) & 1) << 5)); }
__host__ __device__ __forceinline__ void stage_rc(int b, int& R, int& C) { const int st = b / 1024, sb = b % 1024, swz = sb ^ (((sb >> 9) & 1) << 5); R = (st >> 1) * 16 + swz / 64; C = (st & 1) * 32 + (swz % 64) / 2; }
__host__ __device__ __forceinline__ int perm32(int rho) { const int n = rho >> 4, i = rho & 15; return 8 * (i >> 2) + 4 * n + (i & 3); }

struct Unit { int pm, pn; };
struct Gemm { const bf16_t* A; const bf16_t* Bt; int M, N, K; };

struct StaticOrder {
    int nM, nN, nwg, G, c;
    __host__ __device__ void init(int M, int N, int G_, int c_) { nM = M / BM; nN = N / BM; nwg = nM * nN; G = G_; c = c_; }
    __host__ __device__ bool next(int i, Unit& u) const {
        const long L = (long)i * G + c; if (L >= nwg) return false;
        int wgid = (int)L; { const int q = nwg / NXCD, r = nwg % NXCD, xcd = wgid % NXCD, off = wgid / NXCD; wgid = (xcd < r ? xcd * (q + 1) : r * (q + 1) + (xcd - r) * q) + off; }
        const int nig = WGM * nN, gid = wgid / nig, fm = gid * WGM, gsz = (nM - fm) < WGM ? (nM - fm) : WGM;
        u.pm = fm + ((wgid % nig) % gsz); u.pn = (wgid % nig) / gsz; return true;
    }
    __device__ __forceinline__ void a_ready(const Unit&) const {}
    __device__ __forceinline__ void done(const Unit&) const {}
};

template <class Epi, class Sched, bool ALIGN_EPI = false, bool SP2 = false>
__device__ __forceinline__ void gemm_phase(PG8_LAS unsigned char* lds, const Gemm g, const Sched& S, const Epi& E) {
    int tid_ = threadIdx.x; asm volatile("" : "+v"(tid_));
    const int tid = tid_, wid = __builtin_amdgcn_readfirstlane(tid >> 6), lane = tid & 63, wr = wid >> 2, wc = wid & 3, fr = lane & 15, fq = lane >> 4;
    const int K = g.K, nt = K / BK;
    unsigned voffA[2], voffB[2];
#pragma unroll
    for (int i = 0; i < 2; ++i) { int R, C; stage_rc(tid * 16 + i * 8192, R, C); const int Rb = Epi::PERM ? ((R & ~31) + perm32(R & 31)) : R;
        voffA[i] = (unsigned)(R * K + C) * 2u; voffB[i] = (unsigned)(Rb * K + C) * 2u; }
    const size_t kstep = (size_t)(BK * 2);
    const size_t hstep = (size_t)HALF * K * 2;
    const size_t tstep = 2 * hstep;
    const unsigned ldsw = (unsigned)wid * 1024u;
    const int aoff = lds_byte(wr * 64 + fr, fq * 8), boff = lds_byte(wc * 32 + fr, fq * 8);
#define PG8_SA(b, h) (((b) * 2 + (h)) * HTB)
#define PG8_SB(b, h) ((4 + (b) * 2 + (h)) * HTB)
#define PG8_STAGE(bufoff, gbase, voff) do { _Pragma("unroll") for (int _i = 0; _i < 2; ++_i) \
        __builtin_amdgcn_global_load_lds((const unsigned*)((const char*)(gbase) + (voff)[_i]), (PG8_LAS unsigned*)(lds + (bufoff) + ldsw + _i * 8192), 16, 0, 0); } while (0)
#define PG8_LDA(dst, b, h) do { _Pragma("unroll") for (int m = 0; m < 4; ++m) _Pragma("unroll") for (int k = 0; k < 2; ++k) dst[m][k] = *(const PG8_LAS bf16x8*)(lds + PG8_SA(b, h) + aoff + m * 2048 + k * 1024); } while (0)
#define PG8_LDB(dst, b, h) do { _Pragma("unroll") for (int n = 0; n < 2; ++n) _Pragma("unroll") for (int k = 0; k < 2; ++k) dst[n][k] = *(const PG8_LAS bf16x8*)(lds + PG8_SB(b, h) + boff + n * 2048 + k * 1024); } while (0)
#define PG8_MMA(ai, bj, At, Bt) do { __builtin_amdgcn_s_setprio(1); _Pragma("unroll") for (int m = 0; m < 4; ++m) _Pragma("unroll") for (int n = 0; n < 2; ++n) _Pragma("unroll") for (int k = 0; k < 2; ++k) \
        acc[ai][bj][m][n] = __builtin_amdgcn_mfma_f32_16x16x32_bf16(Bt[n][k], At[m][k], acc[ai][bj][m][n], 0, 0, 0); __builtin_amdgcn_s_setprio(0); } while (0)
#define PG8_WAIT_V(n) asm volatile("s_waitcnt vmcnt(" #n ")" ::: "memory")
#define PG8_WAIT_L(n) asm volatile("s_waitcnt lgkmcnt(" #n ")" ::: "memory")
#define PG8_BAR __builtin_amdgcn_s_barrier()
#define PG8_SCHED __builtin_amdgcn_sched_barrier(0)
    Unit cur, nxt; int ui = 0;
    if (!S.next(0, cur)) return;
    f32x4 acc[2][2][4][2];
#pragma unroll
    for (int a = 0; a < 2; ++a)
#pragma unroll
        for (int b = 0; b < 2; ++b)
#pragma unroll
            for (int m = 0; m < 4; ++m)
#pragma unroll
                for (int n = 0; n < 2; ++n) acc[a][b][m][n] = (f32x4){0.f, 0.f, 0.f, 0.f};
    bf16x8 At[4][2], B0[2][2], B1[2][2];
    const char* cA = (const char*)g.A + (size_t)cur.pm * tstep; const char* cB = (const char*)g.Bt + (size_t)cur.pn * tstep;
    S.a_ready(cur);
    if constexpr (SP2) {
        PG8_STAGE(PG8_SB(0, 0), cB, voffB); PG8_STAGE(PG8_SB(0, 1), cB + hstep, voffB); PG8_STAGE(PG8_SA(0, 0), cA, voffA); PG8_STAGE(PG8_SA(0, 1), cA + hstep, voffA);
        if (wr == 1) PG8_BAR;
        PG8_WAIT_V(2); PG8_BAR;
        PG8_STAGE(PG8_SB(1, 0), cB + kstep, voffB); PG8_STAGE(PG8_SA(1, 0), cA + kstep, voffA); PG8_STAGE(PG8_SB(1, 1), cB + hstep + kstep, voffB);
        PG8_WAIT_V(6); PG8_BAR;
    } else {
        PG8_STAGE(PG8_SB(0, 0), cB, voffB); PG8_STAGE(PG8_SA(0, 0), cA, voffA); PG8_STAGE(PG8_SB(0, 1), cB + hstep, voffB); PG8_STAGE(PG8_SA(0, 1), cA + hstep, voffA);
        if (wr == 1) PG8_BAR;
        PG8_WAIT_V(4); PG8_BAR;
        PG8_STAGE(PG8_SB(1, 0), cB + kstep, voffB); PG8_STAGE(PG8_SA(1, 0), cA + kstep, voffA); PG8_STAGE(PG8_SB(1, 1), cB + hstep + kstep, voffB);
        PG8_WAIT_V(6); PG8_BAR;
    }
    for (;;) {
        const bool has_next = S.next(ui + 1, nxt);
        const char* nA = has_next ? (const char*)g.A + (size_t)nxt.pm * tstep : cA; const char* nB = has_next ? (const char*)g.Bt + (size_t)nxt.pn * tstep : cB;
        for (int t = 0; t < nt; t += 2) {
            const bool last = (t == nt - 2);
            const char* a1 = cA + (size_t)(t + 1) * kstep;
            const char* a2 = last ? nA : cA + (size_t)(t + 2) * kstep; const char* b2 = last ? nB : cB + (size_t)(t + 2) * kstep;
            const char* a3 = a2 + kstep; const char* b3 = b2 + kstep;
            if (last && has_next) S.a_ready(nxt);
            if constexpr (SP2) {
            PG8_LDB(B0, 0, 0); PG8_LDB(B1, 0, 1); PG8_SCHED; PG8_LDA(At, 0, 0); PG8_STAGE(PG8_SA(1, 1), a1 + hstep, voffA);
            PG8_WAIT_V(8); PG8_WAIT_L(0); PG8_BAR; PG8_MMA(0, 0, At, B0); PG8_MMA(0, 1, At, B1); PG8_BAR; PG8_SCHED;
            PG8_LDA(At, 0, 1); PG8_STAGE(PG8_SB(0, 0), b2, voffB); PG8_STAGE(PG8_SB(0, 1), b2 + hstep, voffB); PG8_STAGE(PG8_SA(0, 0), a2, voffA);
            PG8_WAIT_V(8); PG8_WAIT_L(0); PG8_BAR; PG8_MMA(1, 0, At, B0); PG8_MMA(1, 1, At, B1); PG8_BAR; PG8_SCHED;
            PG8_LDB(B0, 1, 0); PG8_LDB(B1, 1, 1); PG8_SCHED; PG8_LDA(At, 1, 0); PG8_STAGE(PG8_SA(0, 1), a2 + hstep, voffA);
            PG8_WAIT_V(8); PG8_WAIT_L(0); PG8_BAR; PG8_MMA(0, 0, At, B0); PG8_MMA(0, 1, At, B1); PG8_BAR; PG8_SCHED;
            PG8_LDA(At, 1, 1); PG8_STAGE(PG8_SB(1, 0), b3, voffB); PG8_STAGE(PG8_SB(1, 1), b3 + hstep, voffB); PG8_STAGE(PG8_SA(1, 0), a3, voffA);
            PG8_WAIT_V(8); PG8_WAIT_L(0); PG8_BAR; PG8_MMA(1, 0, At, B0); PG8_MMA(1, 1, At, B1); PG8_BAR; PG8_SCHED;
            } else {
            PG8_LDB(B0, 0, 0); PG8_SCHED; PG8_LDA(At, 0, 0); PG8_STAGE(PG8_SA(1, 1), a1 + hstep, voffA);
            PG8_WAIT_L(8); PG8_BAR; PG8_WAIT_L(0); PG8_MMA(0, 0, At, B0); PG8_BAR; PG8_SCHED;
            PG8_LDB(B1, 0, 1); PG8_STAGE(PG8_SB(0, 0), b2, voffB);
            PG8_BAR; PG8_WAIT_L(0); PG8_MMA(0, 1, At, B1); PG8_BAR;
            PG8_LDA(At, 0, 1); PG8_STAGE(PG8_SA(0, 0), a2, voffA);
            PG8_BAR; PG8_WAIT_L(0); PG8_MMA(1, 0, At, B0); PG8_BAR; PG8_SCHED;
            PG8_STAGE(PG8_SB(0, 1), b2 + hstep, voffB);
            PG8_WAIT_V(6); PG8_BAR; PG8_MMA(1, 1, At, B1); PG8_BAR;
            PG8_LDB(B0, 1, 0); PG8_SCHED; PG8_LDA(At, 1, 0); PG8_STAGE(PG8_SA(0, 1), a2 + hstep, voffA);
            PG8_WAIT_L(8); PG8_BAR; PG8_WAIT_L(0); PG8_MMA(0, 0, At, B0); PG8_BAR; PG8_SCHED;
            PG8_LDB(B1, 1, 1); PG8_STAGE(PG8_SB(1, 0), b3, voffB);
            PG8_BAR; PG8_WAIT_L(0); PG8_MMA(0, 1, At, B1); PG8_BAR;
            PG8_LDA(At, 1, 1); PG8_STAGE(PG8_SA(1, 0), a3, voffA);
            PG8_BAR; PG8_WAIT_L(0); PG8_MMA(1, 0, At, B0); PG8_BAR; PG8_SCHED;
            PG8_STAGE(PG8_SB(1, 1), b3 + hstep, voffB);
            PG8_WAIT_V(6); PG8_BAR; PG8_MMA(1, 1, At, B1); PG8_BAR;
            }
        }
        if constexpr (ALIGN_EPI) { if (wr == 0) PG8_BAR; }
        if constexpr (!Epi::AFTER_DRAIN) { E(acc, cur, wr, wc, fr, fq); S.done(cur); }
        if (!has_next) break;
#pragma unroll
        for (int a = 0; a < 2; ++a)
#pragma unroll
            for (int b = 0; b < 2; ++b)
#pragma unroll
                for (int m = 0; m < 4; ++m)
#pragma unroll
                    for (int n = 0; n < 2; ++n) acc[a][b][m][n] = (f32x4){0.f, 0.f, 0.f, 0.f};
        cur = nxt; cA = nA; cB = nB; ++ui;
        if constexpr (ALIGN_EPI) { if (wr == 1) PG8_BAR; }
    }
    PG8_WAIT_V(0);
    if constexpr (!ALIGN_EPI) { if (wr == 0) PG8_BAR; }
    PG8_BAR;
    if constexpr (Epi::AFTER_DRAIN) { E.fused(acc, cur, wr, wc, fr, fq, lds, wid, lane); S.done(cur); }
#undef PG8_SA
#undef PG8_SB
#undef PG8_STAGE
#undef PG8_LDA
#undef PG8_LDB
#undef PG8_MMA
#undef PG8_WAIT_V
#undef PG8_WAIT_L
#undef PG8_BAR
#undef PG8_SCHED
}
}

#define DI __device__ __forceinline__
#define LAS __attribute__((address_space(3)))
typedef unsigned short bf16_t;
typedef short bf16x8 __attribute__((ext_vector_type(8)));
typedef short v4i16_t __attribute__((ext_vector_type(4)));
typedef float f32x2 __attribute__((ext_vector_type(2)));
typedef float f32x4 __attribute__((ext_vector_type(4)));
typedef float f32x16 __attribute__((ext_vector_type(16)));
typedef unsigned u32x2 __attribute__((ext_vector_type(2)));
typedef unsigned u32x4 __attribute__((ext_vector_type(4)));
typedef __bf16 bf16x2_t __attribute__((ext_vector_type(2)));

constexpr int DM = 1024, NBATCH = 32, TP = 2048, TSS = 64, PAST = 2048, HD = 64, NHA = 6, NHB = 6, NHC = 4;
constexpr int MP = NBATCH * TP, MS = NBATCH * TSS, MT = MP + MS;
constexpr int SHW = 1280, INC = 4230, NPAD = 4352;
constexpr int U_R = 0, U_K = 384, U_V = 768, U_WLO = 1152, U_ALO = 1216, U_GA = 1280, U_QB = 1664, U_KB = 2048, U_VB = 2432, U_GB = 2816,
              U_QC = 3200, U_KC = 3456, U_VC = 3712, U_GC = 3968, U_FB = 4224;
constexpr float ALPHA = 1.41421356237f;
constexpr float GN_EPS = 64e-5f, LN_EPS = 1e-5f;
constexpr float LOG2E = 1.4426950408889634f;
constexpr float QSCALE2 = 0.125f * LOG2E;

constexpr size_t O_YP = 0, O_YS = O_YP + (size_t)MP * DM, O_PFK = O_YS + (size_t)MS * DM, O_PFV = O_PFK + 2ull * MP * 384, O_PFL = O_PFV + 2ull * MP * 384,
                 O_PSK = O_PFL + 2ull * MP * 6, O_PSV = O_PSK + 2ull * MP * 256, O_PWKV = O_PSV + 2ull * MP * 256, O_PSH = O_PWKV + 2ull * 32 * 6 * 4096,
                 O_SFK = O_PSH + 2ull * 32 * 1280, O_SFV = O_SFK + 2ull * MS * 384, O_SFL = O_SFV + 2ull * MS * 384, O_SSK = O_SFL + 2ull * MS * 6,
                 O_SSV = O_SSK + 2ull * MS * 256, O_SWKV = O_SSV + 2ull * MS * 256, O_SSH = O_SWKV + 2ull * 32 * 6 * 4096, O_END = O_SSH + 2ull * 32 * 1280;
static_assert(O_END == 246341632ull, "output size");

constexpr size_t MiB = 1u << 20;
constexpr size_t WS_CTL = 0, CTL_BYTES = 4096, WS_WIN = 1 * MiB, WS_WOUT = 20 * MiB, WS_LOGF = 24 * MiB, WS_XB = 28 * MiB, WS_OB = 160 * MiB, WS_UB = 292 * MiB,
                 WS_BFK = WS_UB + (((size_t)MT * NPAD * 2 + MiB - 1) / MiB) * MiB,
                 BF_BYTES = (size_t)(32 * 6 * 66) * 4096, BS_BYTES = (size_t)(32 * 4 * 66) * 4096, WS_BFV = WS_BFK + BF_BYTES, WS_BSK = WS_BFV + BF_BYTES, WS_BSV = WS_BSK + BS_BYTES, WS_END = WS_BSV + BS_BYTES;
static_assert(WS_WIN + 2ull * NPAD * DM * 2 <= WS_WOUT && WS_WOUT + 2ull * DM * DM * 2 <= WS_LOGF && WS_LOGF + (size_t)MT * 8 * 4 <= WS_XB &&
              WS_XB + (size_t)MT * DM * 2 <= WS_OB && WS_OB + (size_t)MT * DM * 2 <= WS_UB && WS_END <= 1023 * MiB, "ws map");

constexpr int LDS_BYTES = 147456;
constexpr int WK_STRIDE = 8448;
constexpr int SC_OFF = 8 * WK_STRIDE;
constexpr int CH = 16;
constexpr int OPTOK = 384;
constexpr int OPBUF_BYTES = CH * OPTOK * 4;
constexpr int SC_OP = SC_OFF, SC_Y = SC_OP + 2 * OPBUF_BYTES, YBUF_BYTES = CH * 128 * 4  , SC_BON = SC_Y + 2 * YBUF_BYTES, SC_FLAGS = SC_BON + 2 * 64;
static_assert(SC_FLAGS + 64 <= LDS_BYTES, "scan LDS");
enum { F_PROD = 0, F_POST = 1, F_CONS = 2, F_PRODB = 6, F_POSTB = 7, F_SETUP = 8 };

struct Params { const float* in[24]; float* out; unsigned char* ws; int ph_lo, ph_hi, rep_ph, dbg; };
typedef const __attribute__((address_space(4))) Params* PP;
DI PP pp_launder(PP p) { asm volatile("" : "+s"(p)); return p; }

DI float bf2f(unsigned short h) { return __uint_as_float((unsigned)h << 16); }
DI float bflo(unsigned w) { return __uint_as_float(w << 16); }
DI float bfhi(unsigned w) { return __uint_as_float(w & 0xffff0000u); }
DI unsigned cvtpk(float lo, float hi) { f32x2 v = {lo, hi}; bf16x2_t b = __builtin_convertvector(v, bf16x2_t); return __builtin_bit_cast(unsigned, b); }
DI float fast_exp2(float x) { return __builtin_amdgcn_exp2f(x); }
DI float fast_rcp(float x) { return __builtin_amdgcn_rcpf(x); }
DI float sigmoidf_(float x) { return fast_rcp(1.f + fast_exp2(-LOG2E * x)); }
DI float siluf_(float x) { return x * sigmoidf_(x); }
DI float swap32_other(float x, float& mine_lo, float& mine_hi) { auto r = __builtin_amdgcn_permlane32_swap(__float_as_uint(x), __float_as_uint(x), false, false); mine_lo = __uint_as_float(r[0]); mine_hi = __uint_as_float(r[1]); return 0.f; }
DI float red4(float x) {
    auto a = __builtin_amdgcn_permlane16_swap(__float_as_uint(x), __float_as_uint(x), false, false);
    const float s = __uint_as_float(a[0]) + __uint_as_float(a[1]);
    auto b = __builtin_amdgcn_permlane32_swap(__float_as_uint(s), __float_as_uint(s), false, false);
    return __uint_as_float(b[0]) + __uint_as_float(b[1]);
}
template <int CTRL> DI float dpp_f(float x) { return __uint_as_float((unsigned)__builtin_amdgcn_update_dpp(0, (int)__float_as_uint(x), CTRL, 0xf, 0xf, false)); }
DI float red16(float x) {
    x += dpp_f<0x121>(x); x += dpp_f<0x122>(x); x += dpp_f<0x124>(x); x += dpp_f<0x128>(x); return x;
}
DI unsigned ld_flag(LAS unsigned* p) { return __hip_atomic_load(p, __ATOMIC_ACQUIRE, __HIP_MEMORY_SCOPE_WORKGROUP); }
DI void st_flag(LAS unsigned* p, unsigned v) { __hip_atomic_store(p, v, __ATOMIC_RELEASE, __HIP_MEMORY_SCOPE_WORKGROUP); }
DI void wait_ge(LAS unsigned* p, unsigned need) { while (ld_flag(p) < need) __builtin_amdgcn_s_sleep(1); }
DI int crow(int r, int hi) { return (r & 3) + 8 * (r >> 2) + 4 * hi; }
#define MFMA32(a, b, c) __builtin_amdgcn_mfma_f32_32x32x16_bf16((a), (b), (c), 0, 0, 0)
#define MFMA16(a, b, c) __builtin_amdgcn_mfma_f32_16x16x32_bf16((a), (b), (c), 0, 0, 0)

DI void p0_item(const float* W, int Nsrc, int kind, bf16_t* WT, LAS float* scr, int item, int nblk, int lane) {
    const int kb = item / nblk, nb = item % nblk, k0 = 64 * kb, n0 = 32 * nb;
    const int n = n0 + (lane & 31); int src = n; bool valid = true;
    if (kind == 0) { if (n < 2816) src = n; else if (n < 4224) src = n + 6; else if (n < 4230) src = n - 4224 + 2816; else { valid = false; src = 0; } }
#pragma unroll
    for (int i = 0; i < 32; ++i) { const int kk = 2 * i + (lane >> 5); scr[kk * 33 + (lane & 31)] = valid ? W[(size_t)(k0 + kk) * Nsrc + src] : 0.f; }
    asm volatile("s_waitcnt lgkmcnt(0)" ::: "memory");
    const int c = lane & 7;
#pragma unroll
    for (int j = 0; j < 4; ++j) { const int nn = (lane >> 3) + 8 * j; const LAS float* s = scr + (8 * c) * 33 + nn;
        u32x4 o; o.x = cvtpk(s[0 * 33], s[1 * 33]); o.y = cvtpk(s[2 * 33], s[3 * 33]); o.z = cvtpk(s[4 * 33], s[5 * 33]); o.w = cvtpk(s[6 * 33], s[7 * 33]);
        *(u32x4*)(WT + (size_t)(n0 + nn) * 1024 + k0 + 8 * c) = o; }
    asm volatile("s_waitcnt lgkmcnt(0)" ::: "memory");
}
DI void phase0(PP P, LAS unsigned char* lds, int wave, int lane, int bidx, int gdim) {
    LAS float* scr = (LAS float*)(lds + wave * 8448);
    const int gw = bidx * 8 + wave, NGW = gdim * 8;
    constexpr int I_IN = 16 * (NPAD / 32), I_OUT = 16 * 32, NITEMS = 2 * (I_IN + I_OUT);
    for (int it = gw; it < NITEMS; it += NGW) {
        int r = it; const int l = r / (I_IN + I_OUT); r -= l * (I_IN + I_OUT);
        if (r < I_IN) p0_item(P->in[9] + (size_t)l * DM * INC, INC, 0, (bf16_t*)(P->ws + WS_WIN) + (size_t)l * NPAD * DM, scr, r, NPAD / 32, lane);
        else p0_item(P->in[21] + (size_t)l * DM * DM, DM, 1, (bf16_t*)(P->ws + WS_WOUT) + (size_t)l * DM * DM, scr, r - I_IN, 32, lane);
    }
    bf16_t* xb = (bf16_t*)(P->ws + WS_XB);
    for (int m = gw; m < MT; m += NGW) {
        const float* xr = (m < MP) ? P->in[0] + (size_t)m * DM : P->in[1] + (size_t)(m - MP) * DM;
        const f32x4* x4 = (const f32x4*)xr + lane; u32x2* o = (u32x2*)(xb + (size_t)m * DM) + lane;
#pragma unroll
        for (int j = 0; j < 4; ++j) { const f32x4 v = x4[64 * j]; u32x2 w; w.x = cvtpk(v.x, v.y); w.y = cvtpk(v.z, v.w); o[64 * j] = w; }
    }
}

DI float log_sigmoid_f(float x) { return fminf(x, 0.f) - log1pf(expf(-fabsf(x))); }
struct EpiU {
    static constexpr bool PERM = true, AFTER_DRAIN = false;
    unsigned char* ws; float* out; const float* fb; int l, mode;
    DI void operator()(const pg8::f32x4 (&acc)[2][2][4][2], const pg8::Unit& u, int wr, int wc, int fr, int fq) const {
        const int row0 = u.pm * 256 + wr * 64 + fr;
        if (mode == 0) {
            bf16_t* U = (bf16_t*)(ws + WS_UB); float* logf = (float*)(ws + WS_LOGF);
#pragma unroll
            for (int bj = 0; bj < 2; ++bj) {
                const int ch = u.pn * 2 + bj, c0 = ch * 128 + wc * 32 + 8 * fq;
                int W = 0, cs = 0, isv = 0, NHx = 6; size_t op = 0, os = 0, wb = 0;
                if (ch >= 16 && ch < 19) { W = 384; cs = U_KB; op = O_PFK; os = O_SFK; wb = WS_BFK; }
                else if (ch >= 19 && ch < 22) { W = 384; cs = U_VB; op = O_PFV; os = O_SFV; wb = WS_BFV; isv = 1; }
                else if (ch == 27 || ch == 28) { W = 256; cs = U_KC; op = O_PSK; os = O_SSK; wb = WS_BSK; NHx = 4; }
                else if (ch == 29 || ch == 30) { W = 256; cs = U_VC; op = O_PSV; os = O_SSV; wb = WS_BSV; NHx = 4; isv = 1; }
                const int hh = (c0 - cs) >> 6, dd = (c0 - cs) & 63;
                const unsigned koff = (unsigned)((dd >> 4) * 1024 + ((dd >> 3) & 1) * 512), voff = (unsigned)((dd >> 5) * 2048 + ((dd & 31) >> 3) * 16);
                float* segp = out + op + (size_t)l * MP * W + (c0 - cs); float* segs = out + os + (size_t)l * MS * W + (c0 - cs);
#pragma unroll
                for (int ai = 0; ai < 2; ++ai)
#pragma unroll
                    for (int m = 0; m < 4; ++m) {
                        const int r = row0 + ai * 128 + m * 16;
                        const f32x4 v0 = acc[ai][bj][m][0], v1 = acc[ai][bj][m][1];
                        u32x4 w; w.x = cvtpk(v0[0], v0[1]); w.y = cvtpk(v0[2], v0[3]); w.z = cvtpk(v1[0], v1[1]); w.w = cvtpk(v1[2], v1[3]);
                        if (W) { float* d = (r < MP) ? segp + (size_t)r * W : segs + (size_t)(r - MP) * W; *(f32x4*)d = v0; *(f32x4*)(d + 4) = v1;
                            int bq, tq_, smp; if (r < MP) { bq = r >> 11; tq_ = r & 2047; smp = 0; } else { const int rs = r - MP; bq = rs >> 6; tq_ = rs & 63; smp = 1; }
                            const unsigned tix = smp ? (unsigned)(32 * NHx * 64 + (bq * NHx + hh) * 2 + (tq_ >> 5)) : (unsigned)((bq * NHx + hh) * 64 + (tq_ >> 5));
                            const int r32_ = tq_ & 31;
                            const unsigned off = isv ? voff + (unsigned)((r32_ >> 4) * 1024 + (r32_ & 15) * 64) : koff + (unsigned)(r32_ * 16);
                            *(u32x4*)(ws + wb + (size_t)tix * 4096 + off) = w; }
                        else *(u32x4*)(U + (size_t)r * NPAD + c0) = w;
                        if (ch < 10) {
                            if (r < MP) { if ((r & 2047) == 2047) { float* d = out + O_PSH + (size_t)(l * 32 + (r >> 11)) * SHW + c0; *(f32x4*)d = v0; *(f32x4*)(d + 4) = v1; } }
                            else { const int rs = r - MP; if ((rs & 63) == 63) { float* d = out + O_SSH + (size_t)(l * 32 + (rs >> 6)) * SHW + c0; *(f32x4*)d = v0; *(f32x4*)(d + 4) = v1; } }
                        }
                        if (ch == 33 && wc == 0 && fq == 0) {
                            float lf[6];
#pragma unroll
                            for (int h = 0; h < 6; ++h) { const float x = (h < 4 ? v0[h] : v1[h - 4]) + fb[h]; lf[h] = log_sigmoid_f(x); }
                            float* d = (r < MP) ? out + O_PFL + ((size_t)l * MP + r) * 6 : out + O_SFL + ((size_t)l * MS + (r - MP)) * 6;
#pragma unroll
                            for (int h = 0; h < 6; ++h) { d[h] = lf[h]; logf[(size_t)r * 8 + h] = lf[h]; }
                        }
                    }
            }
        } else {
            const bf16_t* X = (const bf16_t*)(ws + WS_XB); bf16_t* Z = (bf16_t*)(ws + WS_UB);
#pragma unroll
            for (int ai = 0; ai < 2; ++ai)
#pragma unroll
                for (int m = 0; m < 4; ++m) {
                    const size_t r = (size_t)(row0 + ai * 128 + m * 16);
#pragma unroll
                    for (int bj = 0; bj < 2; ++bj) {
                        const int c = u.pn * 256 + bj * 128 + wc * 32 + 8 * fq;
                        const u32x4 xw = *(const u32x4*)(X + r * DM + c);
                        f32x4 z0 = acc[ai][bj][m][0], z1 = acc[ai][bj][m][1];
                        z0[0] += ALPHA * bflo(xw.x); z0[1] += ALPHA * bfhi(xw.x); z0[2] += ALPHA * bflo(xw.y); z0[3] += ALPHA * bfhi(xw.y);
                        z1[0] += ALPHA * bflo(xw.z); z1[1] += ALPHA * bfhi(xw.z); z1[2] += ALPHA * bflo(xw.w); z1[3] += ALPHA * bfhi(xw.w);
                        u32x4 zw; zw.x = cvtpk(z0[0], z0[1]); zw.y = cvtpk(z0[2], z0[3]); zw.z = cvtpk(z1[0], z1[1]); zw.w = cvtpk(z1[2], z1[3]);
                        *(u32x4*)(Z + r * DM + c) = zw;
                    }
                }
        }
    }
};

DI float wave_sum(float v) {
#pragma unroll
    for (int o = 1; o < 64; o <<= 1) v += __shfl_xor(v, o);
    return v;
}
DI void phase_ln(PP P, int l, int wave, int lane, int bidx, int gdim) {
    const int gw = bidx * 8 + wave, NGW = gdim * 8;
    const bf16_t* Z = (const bf16_t*)(P->ws + WS_UB); bf16_t* xb = (bf16_t*)(P->ws + WS_XB);
    const f32x4* g4 = (const f32x4*)(P->in[22] + (size_t)l * DM) + lane; const f32x4* b4 = (const f32x4*)(P->in[23] + (size_t)l * DM) + lane;
    f32x4 g[4], bb[4];
#pragma unroll
    for (int j = 0; j < 4; ++j) { g[j] = g4[64 * j]; bb[j] = b4[64 * j]; }
    for (int m = gw; m < MT; m += NGW) {
        const u32x2* z4 = (const u32x2*)(Z + (size_t)m * DM) + lane;
        f32x4 v[4]; float s = 0.f;
#pragma unroll
        for (int j = 0; j < 4; ++j) { const u32x2 zz_ = z4[64 * j]; v[j] = (f32x4){bflo(zz_.x), bfhi(zz_.x), bflo(zz_.y), bfhi(zz_.y)}; s += (v[j].x + v[j].y) + (v[j].z + v[j].w); }
        const float mean = wave_sum(s) * (1.f / DM); float s2 = 0.f;
#pragma unroll
        for (int j = 0; j < 4; ++j) { v[j] = v[j] - mean; s2 += (v[j].x * v[j].x + v[j].y * v[j].y) + (v[j].z * v[j].z + v[j].w * v[j].w); }
        const float rstd = 1.f / sqrtf(wave_sum(s2) * (1.f / DM) + LN_EPS);
#pragma unroll
        for (int j = 0; j < 4; ++j) v[j] = v[j] * rstd * g[j] + bb[j];
        if (l == 0) { u32x2* o = (u32x2*)(xb + (size_t)m * DM) + lane;
#pragma unroll
            for (int j = 0; j < 4; ++j) { u32x2 w; w.x = cvtpk(v[j].x, v[j].y); w.y = cvtpk(v[j].z, v[j].w); o[64 * j] = w; } }
        else { f32x4* o = (f32x4*)(P->out + O_YP + (size_t)m * DM) + lane;
#pragma unroll
            for (int j = 0; j < 4; ++j) o[64 * j] = v[j]; }
    }
}

DI void scan_wave(PP P, int l, LAS unsigned char* lds, int wave, int lane, int seq0, int nseq, bool sample, int dbg, bool two = false) {
    const int row = wave * 16 + (lane & 15), kq = lane >> 4;
    LAS unsigned* flags = (LAS unsigned*)(lds + SC_FLAGS);
    unsigned cgl = 0;
    const int nch = sample ? TSS / CH : TP / CH;
    __builtin_amdgcn_s_setprio(3);
    for (int s = 0; s < nseq; ++s) {
        const int seq = seq0 + s, b = seq / 6, h = seq % 6;
        f32x4 S[4];
        if (sample) { const f32x4* sp = (const f32x4*)(P->in[7] + ((size_t)((l * 32 + b) * 6 + h) * 64 + row) * 64 + kq * 16);
#pragma unroll
            for (int i = 0; i < 4; ++i) S[i] = sp[i]; }
        else {
#pragma unroll
            for (int i = 0; i < 4; ++i) S[i] = (f32x4){0.f, 0.f, 0.f, 0.f}; }
        for (int c = 0; c < nch; ++c, ++cgl) {
            if (two) { wait_ge(&flags[(cgl & 1) ? F_PRODB : F_PROD], (cgl >> 1) + 1); if (cgl >= 2) wait_ge(&flags[(cgl & 1) ? F_POSTB : F_POST], cgl >> 1); }
            else { wait_ge(&flags[F_PROD], cgl + 1); if (cgl >= 2) wait_ge(&flags[F_POST], cgl - 1); }
            LAS const float* opb = (LAS const float*)(lds + SC_OP + (cgl & 1) * OPBUF_BYTES);
            LAS float* yb = (LAS float*)(lds + SC_Y + (cgl & 1) * YBUF_BYTES);
            LAS const float* bon = (LAS const float*)(lds + SC_BON + (cgl & 1) * 64);
            LAS const float* tp0 = opb + kq * 16; asm volatile("" : "+v"(tp0));
            LAS const float* vp0 = opb + 320 + row; asm volatile("" : "+v"(vp0));
            f32x4 w4[2][4], kk4[2][4], ka4[2][4], kp4[2][4], r4[2][4]; float vv[2], bt[2];
#define SC_LOAD(buf, t_) do { LAS const float* tp = tp0 + (t_) * OPTOK; \
                _Pragma("unroll") for (int i = 0; i < 4; ++i) { w4[buf][i] = *(LAS const f32x4*)(tp + 4 * i); kk4[buf][i] = *(LAS const f32x4*)(tp + 64 + 4 * i); ka4[buf][i] = *(LAS const f32x4*)(tp + 128 + 4 * i); \
                    kp4[buf][i] = *(LAS const f32x4*)(tp + 192 + 4 * i); r4[buf][i] = *(LAS const f32x4*)(tp + 256 + 4 * i); } \
                vv[buf] = vp0[(t_) * OPTOK]; bt[buf] = bon[t_]; } while (0)
            SC_LOAD(0, 0);
#pragma unroll
            for (int t = 0; t < CH; ++t) {
                if ((dbg & 8) && t >= 8) break;
                const int cb = t & 1, nb = cb ^ 1;
                if (t + 1 < CH) SC_LOAD(nb, t + 1);
                f32x4 a4 = S[0] * kk4[cb][0];
#pragma unroll
                for (int i = 1; i < 4; ++i) a4 += S[i] * kk4[cb][i];
                float sa = (a4[0] + a4[1]) + (a4[2] + a4[3]);
                sa = red4(sa);
                const float nsa = -sa;
                f32x4 y4 = (f32x4){0.f, 0.f, 0.f, 0.f};
#pragma unroll
                for (int i = 0; i < 4; ++i) { S[i] = S[i] * w4[cb][i] + nsa * ka4[cb][i] + vv[cb] * kp4[cb][i]; y4 += S[i] * r4[cb][i]; }
                float y = (y4[0] + y4[1]) + (y4[2] + y4[3]);
                y = red4(y);
                if (kq < 2) yb[t * 128 + kq * 64 + row] = kq == 0 ? y : bt[cb] * vv[cb];
            }
#undef SC_LOAD
            st_flag(&flags[F_CONS + wave], cgl + 1);
        }
        float* so = P->out + (sample ? O_SWKV : O_PWKV) + ((size_t)((l * 32 + b) * 6 + h) * 64 + row) * 64 + kq * 16;
        if (!(dbg & 256)) {
#pragma unroll
            for (int i = 0; i < 4; ++i) *(f32x4*)(so + 4 * i) = S[i]; }
    }
    __builtin_amdgcn_s_setprio(0);
}

constexpr int SC_CST = SC_FLAGS + 64, CST_BYTES = 10 * 64 * 4, RAWBUF = 16384;
static_assert(SC_CST + CST_BYTES <= LDS_BYTES && 2 * RAWBUF <= 4 * WK_STRIDE && 15 * 1024 <= RAWBUF, "prep LDS");
#define RAWOFF(R, sg, c) ((((sg) * 3 + ((R) >> 3)) * 1024) + (((R) & 7) * 128) + (c) * 2)
DI void prep_wave(PP P, int l, LAS unsigned char* lds, int lane, int seq0, int nseq, bool sample, int dbg) {
    const int fr = lane & 15, fq = lane >> 4;
    LAS unsigned* flags = (LAS unsigned*)(lds + SC_FLAGS);
    LAS float* cst = (LAS float*)(lds + SC_CST);
    const bf16_t* ub = (const bf16_t*)(P->ws + WS_UB);
    const float* mu = P->in[10] + (size_t)l * SHW;
    unsigned cgl = 0;
    const int nch = sample ? TSS / CH : TP / CH;
    const int c8 = lane & 7, rsub = lane >> 3;
    const unsigned goff = (unsigned)(rsub * NPAD + c8 * 8) * 2u;
    for (int s = 0; s < nseq; ++s) {
        const int seq = seq0 + s, b = seq / 6, h = seq % 6;
        const size_t m0 = sample ? (size_t)MP + (size_t)b * TSS : (size_t)b * TP;
        const float* sh0 = P->in[8] + (size_t)(l * 32 + b) * SHW;
        {
            const int kc = h * 64 + lane;
            cst[0 * 64 + lane] = mu[U_R + kc]; cst[1 * 64 + lane] = mu[U_K + kc]; cst[2 * 64 + lane] = mu[U_V + kc];
            cst[3 * 64 + lane] = P->in[11][(size_t)l * 384 + kc]; cst[4 * 64 + lane] = P->in[13][(size_t)l * 384 + kc]; cst[5 * 64 + lane] = P->in[15][(size_t)l * 384 + kc];
            cst[6 * 64 + lane] = P->in[16][(size_t)l * 384 + kc]; cst[7 * 64 + lane] = P->in[17][(size_t)l * 384 + kc];
            cst[8 * 64 + lane] = mu[U_WLO + lane]; cst[9 * 64 + lane] = mu[U_ALO + lane];
        }
        LAS unsigned char* btab = lds + 4 * WK_STRIDE;
        {
            LAS float* wst = (LAS float*)lds;
#pragma unroll
            for (int arr = 0; arr < 2; ++arr)
#pragma unroll
                for (int ks = 0; ks < 2; ++ks) {
                    const float* W = P->in[arr == 0 ? 12 : 14] + (size_t)l * 64 * 384 + (size_t)(32 * ks) * 384 + h * 64;
                    asm volatile("" ::: "memory");
#pragma unroll
                    for (int n = 0; n < 8; ++n) { const int row = (lane >> 4) + 4 * n; *(LAS f32x4*)(wst + row * 64 + (lane & 15) * 4) = *(const f32x4*)(W + (size_t)row * 384 + (lane & 15) * 4); }
                    asm volatile("" ::: "memory");
#pragma unroll
                    for (int j = 0; j < 4; ++j) { u32x4 pq;
#pragma unroll
                        for (int e = 0; e < 4; ++e) { const int k0 = 8 * fq + 2 * e; pq[e] = cvtpk(wst[k0 * 64 + 16 * j + fr], wst[(k0 + 1) * 64 + 16 * j + fr]); }
                        *(LAS u32x4*)(btab + (((arr * 4 + j) * 2 + ks) * 64 + lane) * 16) = pq; }
                    asm volatile("" ::: "memory");
                }
        }
        u32x4 pf[15];
#define PREP_FETCH(c_) do { const char* gb_ = (const char*)(ub + (m0 + (size_t)(c_) * CH - 1) * NPAD); \
            _Pragma("unroll") for (int sg = 0; sg < 5; ++sg) { const char* gs_ = gb_ + (sg < 3 ? (sg * 384 + h * 64) * 2 : (sg == 3 ? U_WLO * 2 : U_ALO * 2)); \
                _Pragma("unroll") for (int rg = 0; rg < 3; ++rg) { if (rg < 2 || rsub == 0) pf[sg * 3 + rg] = *(const u32x4*)(gs_ + (size_t)(rg * 8 * NPAD * 2) + goff); } } } while (0)
        asm volatile("s_waitcnt vmcnt(0) lgkmcnt(0)" ::: "memory");
        PREP_FETCH(0);
        for (int c = 0; c < nch; ++c, ++cgl) {
            if (dbg & 2) { if (cgl >= 2) { for (int j = 0; j < 4; ++j) wait_ge(&flags[F_CONS + j], cgl - 1); } st_flag(&flags[F_PROD], cgl + 1); continue; }
            const int t0 = c * CH;
            LAS unsigned char* raw = lds + (c & 1) * RAWBUF;
#pragma unroll
            for (int sg = 0; sg < 5; ++sg)
#pragma unroll
                for (int rg = 0; rg < 3; ++rg) { if (rg < 2 || rsub == 0) *(LAS u32x4*)(raw + (sg * 3 + rg) * 1024 + lane * 16) = pf[sg * 3 + rg]; }
            if (t0 == 0 && rsub == 0) {
#pragma unroll
                for (int sg = 0; sg < 5; ++sg) {
                    u32x4 v = (u32x4){0u, 0u, 0u, 0u};
                    if (sample) { const int col_ = (sg < 3 ? sg * 384 + h * 64 : (sg == 3 ? U_WLO : U_ALO)) + c8 * 8;
                        const f32x4 a = *(const f32x4*)(sh0 + col_), bq = *(const f32x4*)(sh0 + col_ + 4); v.x = cvtpk(a[0], a[1]); v.y = cvtpk(a[2], a[3]); v.z = cvtpk(bq[0], bq[1]); v.w = cvtpk(bq[2], bq[3]); }
                    *(LAS u32x4*)(raw + sg * 3 * 1024 + c8 * 16) = v;
                }
            }
            asm volatile("" ::: "memory");
            if (c + 1 < nch) PREP_FETCH(c + 1);
            int zz = 0; asm volatile("" : "+v"(zz));
            LAS const float* cz = cst + zz;
            f32x4 Dw[4], Da[4];
            {
                bf16x8 Aw[2], Aa[2];
#pragma unroll
                for (int ks = 0; ks < 2; ++ks) {
                    const u32x4 cw = *(LAS const u32x4*)(raw + RAWOFF(fr + 1, 3, 32 * ks + 8 * fq)), pwv = *(LAS const u32x4*)(raw + RAWOFF(fr, 3, 32 * ks + 8 * fq));
                    const u32x4 ca = *(LAS const u32x4*)(raw + RAWOFF(fr + 1, 4, 32 * ks + 8 * fq)), pav = *(LAS const u32x4*)(raw + RAWOFF(fr, 4, 32 * ks + 8 * fq));
                    const f32x4 mw0 = *(LAS const f32x4*)(cz + 8 * 64 + 32 * ks + 8 * fq), mw1 = *(LAS const f32x4*)(cz + 8 * 64 + 32 * ks + 8 * fq + 4);
                    const f32x4 ma0 = *(LAS const f32x4*)(cz + 9 * 64 + 32 * ks + 8 * fq), ma1 = *(LAS const f32x4*)(cz + 9 * 64 + 32 * ks + 8 * fq + 4);
                    u32x4 pw, pa;
#pragma unroll
                    for (int e = 0; e < 4; ++e) {
                        const float c0 = bflo(cw[e]), c1 = bfhi(cw[e]), p0 = bflo(pwv[e]), p1 = bfhi(pwv[e]);
                        const float m0_ = (e < 2 ? mw0[2 * e] : mw1[2 * e - 4]), m1_ = (e < 2 ? mw0[2 * e + 1] : mw1[2 * e - 3]);
                        const float z0 = c0 + (p0 - c0) * m0_, z1 = c1 + (p1 - c1) * m1_;
                        const float t0_ = 1.f - 2.f * fast_rcp(1.f + fast_exp2(2.f * LOG2E * z0)), t1_ = 1.f - 2.f * fast_rcp(1.f + fast_exp2(2.f * LOG2E * z1));
                        pw[e] = cvtpk(t0_, t1_);
                        const float d0 = bflo(ca[e]), d1 = bfhi(ca[e]), q0 = bflo(pav[e]), q1 = bfhi(pav[e]);
                        const float n0_ = (e < 2 ? ma0[2 * e] : ma1[2 * e - 4]), n1_ = (e < 2 ? ma0[2 * e + 1] : ma1[2 * e - 3]);
                        pa[e] = cvtpk(d0 + (q0 - d0) * n0_, d1 + (q1 - d1) * n1_);
                    }
                    Aw[ks] = __builtin_bit_cast(bf16x8, pw); Aa[ks] = __builtin_bit_cast(bf16x8, pa);
                }
#pragma unroll
                for (int j = 0; j < 4; ++j) {
                    const f32x4 z = (f32x4){0.f, 0.f, 0.f, 0.f};
                    LAS const unsigned char* bt = btab + zz + lane * 16;
                    Dw[j] = MFMA16(Aw[0], *(LAS const bf16x8*)(bt + ((0 * 4 + j) * 2 + 0) * 1024), z); Dw[j] = MFMA16(Aw[1], *(LAS const bf16x8*)(bt + ((0 * 4 + j) * 2 + 1) * 1024), Dw[j]);
                    Da[j] = MFMA16(Aa[0], *(LAS const bf16x8*)(bt + ((1 * 4 + j) * 2 + 0) * 1024), z); Da[j] = MFMA16(Aa[1], *(LAS const bf16x8*)(bt + ((1 * 4 + j) * 2 + 1) * 1024), Da[j]);
                }
            }
            if (cgl >= 2) {
#pragma unroll
                for (int j = 0; j < 4; ++j) wait_ge(&flags[F_CONS + j], cgl - 1);
            }
            LAS float* opb = (LAS float*)(lds + SC_OP + (cgl & 1) * OPBUF_BYTES);
            LAS float* bon = (LAS float*)(lds + SC_BON + (cgl & 1) * 64);
#pragma unroll
            for (int i = 0; i < 4; ++i) {
                const int tl = 4 * fq + i; LAS const unsigned char* rc = raw + RAWOFF(tl + 1, 0, fr); LAS const unsigned char* rp = raw + RAWOFF(tl, 0, fr);
#define RB(p_, sg_, j_) bf2f(*(LAS const bf16_t*)((p_) + (sg_) * 3072 + (j_) * 32))
                float rr[4], kk[4], vv[4], aa[4], ww[4], kn[4]; float ss = 0.f;
#pragma unroll
                for (int j = 0; j < 4; ++j) {
                    const float cr = RB(rc, 0, j), ck = RB(rc, 1, j), cv = RB(rc, 2, j);
                    const float pr = RB(rp, 0, j), pk = RB(rp, 1, j), pv_ = RB(rp, 2, j);
                    rr[j] = cr + (pr - cr) * cz[0 * 64 + 16 * j + fr]; kk[j] = ck + (pk - ck) * cz[1 * 64 + 16 * j + fr]; vv[j] = cv + (pv_ - cv) * cz[2 * 64 + 16 * j + fr];
                    const float x = cz[3 * 64 + 16 * j + fr] + Dw[j][i];
                    const float sg = fast_rcp(1.f + fast_exp2(-LOG2E * x));
                    ww[j] = fast_exp2(-0.60653066f * LOG2E * sg);
                    aa[j] = fast_rcp(1.f + fast_exp2(-LOG2E * (cz[4 * 64 + 16 * j + fr] + Da[j][i])));
                    kn[j] = kk[j] * cz[5 * 64 + 16 * j + fr]; ss += kn[j] * kn[j];
                }
                ss = red16(ss);
                const float rn = 1.f / sqrtf(ss + 1e-12f);
                float bs = 0.f; LAS float* o = opb + tl * OPTOK + fr;
#pragma unroll
                for (int j = 0; j < 4; ++j) {
                    const float knn = kn[j] * rn, kp = kk[j] * (1.f + (aa[j] - 1.f) * cz[6 * 64 + 16 * j + fr]);
                    bs += rr[j] * kp * cz[7 * 64 + 16 * j + fr];
                    o[16 * j] = ww[j]; o[64 + 16 * j] = knn; o[128 + 16 * j] = knn * aa[j]; o[192 + 16 * j] = kp; o[256 + 16 * j] = rr[j]; o[320 + 16 * j] = vv[j];
                }
                bs = red16(bs);
                if (fr == 0) bon[tl] = bs;
#undef RB
            }
            st_flag(&flags[F_PROD], cgl + 1);
        }
#undef PREP_FETCH
    }
}

DI void helper2_wave(PP P, int l, LAS unsigned char* lds, int lane, int seq0, int par, int dbg) {
    const int nseq = 1; const bool sample = false;
    const int fr = lane & 15, fq = lane >> 4;
    LAS unsigned* flags = (LAS unsigned*)(lds + SC_FLAGS);
    LAS float* cst = (LAS float*)(lds + SC_CST);
    const bf16_t* ub = (const bf16_t*)(P->ws + WS_UB);
    const float* mu = P->in[10] + (size_t)l * SHW;
    unsigned cgl = 0;
    const int nch = sample ? TSS / CH : TP / CH;
    const int c8 = lane & 7, rsub = lane >> 3;
    const unsigned goff = (unsigned)(rsub * NPAD + c8 * 8) * 2u;
    for (int s = 0; s < nseq; ++s) {
        const int seq = seq0 + s, b = seq / 6, h = seq % 6;
        const size_t m0 = sample ? (size_t)MP + (size_t)b * TSS : (size_t)b * TP;
        const float* sh0 = P->in[8] + (size_t)(l * 32 + b) * SHW;
        if (par == 0) {
            const int kc = h * 64 + lane;
            cst[0 * 64 + lane] = mu[U_R + kc]; cst[1 * 64 + lane] = mu[U_K + kc]; cst[2 * 64 + lane] = mu[U_V + kc];
            cst[3 * 64 + lane] = P->in[11][(size_t)l * 384 + kc]; cst[4 * 64 + lane] = P->in[13][(size_t)l * 384 + kc]; cst[5 * 64 + lane] = P->in[15][(size_t)l * 384 + kc];
            cst[6 * 64 + lane] = P->in[16][(size_t)l * 384 + kc]; cst[7 * 64 + lane] = P->in[17][(size_t)l * 384 + kc];
            cst[8 * 64 + lane] = mu[U_WLO + lane]; cst[9 * 64 + lane] = mu[U_ALO + lane];
        }
        LAS unsigned char* btab = lds + 4 * WK_STRIDE;
        if (par == 0) {
            LAS float* wst = (LAS float*)lds;
#pragma unroll
            for (int arr = 0; arr < 2; ++arr)
#pragma unroll
                for (int ks = 0; ks < 2; ++ks) {
                    const float* W = P->in[arr == 0 ? 12 : 14] + (size_t)l * 64 * 384 + (size_t)(32 * ks) * 384 + h * 64;
                    asm volatile("" ::: "memory");
#pragma unroll
                    for (int n = 0; n < 8; ++n) { const int row = (lane >> 4) + 4 * n; *(LAS f32x4*)(wst + row * 64 + (lane & 15) * 4) = *(const f32x4*)(W + (size_t)row * 384 + (lane & 15) * 4); }
                    asm volatile("" ::: "memory");
#pragma unroll
                    for (int j = 0; j < 4; ++j) { u32x4 pq;
#pragma unroll
                        for (int e = 0; e < 4; ++e) { const int k0 = 8 * fq + 2 * e; pq[e] = cvtpk(wst[k0 * 64 + 16 * j + fr], wst[(k0 + 1) * 64 + 16 * j + fr]); }
                        *(LAS u32x4*)(btab + (((arr * 4 + j) * 2 + ks) * 64 + lane) * 16) = pq; }
                    asm volatile("" ::: "memory");
                }
        }
        u32x4 pf[15];
#define PREP_FETCH(c_) do { const char* gb_ = (const char*)(ub + (m0 + (size_t)(c_) * CH - 1) * NPAD); \
            _Pragma("unroll") for (int sg = 0; sg < 5; ++sg) { const char* gs_ = gb_ + (sg < 3 ? (sg * 384 + h * 64) * 2 : (sg == 3 ? U_WLO * 2 : U_ALO * 2)); \
                _Pragma("unroll") for (int rg = 0; rg < 3; ++rg) { if (rg < 2 || rsub == 0) pf[sg * 3 + rg] = *(const u32x4*)(gs_ + (size_t)(rg * 8 * NPAD * 2) + goff); } } } while (0)
        asm volatile("s_waitcnt vmcnt(0) lgkmcnt(0)" ::: "memory");
        if (par == 0) st_flag(&flags[F_SETUP], 1u); else wait_ge(&flags[F_SETUP], 1u);
        const f32x4 pg4 = *(const f32x4*)(P->in[18] + (size_t)l * 384 + h * 64 + 4 * fr), pb4 = *(const f32x4*)(P->in[19] + (size_t)l * 384 + h * 64 + 4 * fr);
        bf16_t* obp = (bf16_t*)(P->ws + WS_OB);
#define POST_CHUNK(cl_) do { const unsigned cg_ = (unsigned)(cl_); \
            u32x2 gwv_[4]; \
            _Pragma("unroll") for (int i = 0; i < 4; ++i) gwv_[i] = *(const u32x2*)(ub + (m0 + (cl_) * CH + 4 * i + fq) * NPAD + U_GA + h * 64 + 4 * fr); \
            _Pragma("unroll") for (int j = 0; j < 4; ++j) wait_ge(&flags[F_CONS + j], cg_ + 1); \
            LAS const float* yb_ = (LAS const float*)(lds + SC_Y + par * YBUF_BYTES); \
            f32x4 yv_[4], bv_[4]; \
            _Pragma("unroll") for (int i = 0; i < 4; ++i) { const int tl_ = 4 * i + fq; yv_[i] = *(LAS const f32x4*)(yb_ + tl_ * 128 + 4 * fr); bv_[i] = *(LAS const f32x4*)(yb_ + tl_ * 128 + 64 + 4 * fr); } \
            st_flag(&flags[par ? F_POSTB : F_POST], (cg_ >> 1) + 1); \
            _Pragma("unroll") for (int i = 0; i < 4; ++i) { const size_t m_ = m0 + (cl_) * CH + 4 * i + fq; \
                const f32x4 y4_ = yv_[i]; \
                const float mean_ = red16((y4_[0] + y4_[1]) + (y4_[2] + y4_[3])) * (1.f / 64.f); \
                const f32x4 d_ = y4_ - mean_; \
                const float var_ = red16((d_[0] * d_[0] + d_[1] * d_[1]) + (d_[2] * d_[2] + d_[3] * d_[3])) * (1.f / 64.f); \
                const float rstd_ = __builtin_amdgcn_rsqf(var_ + GN_EPS); \
                f32x4 o_ = d_ * rstd_ * pg4 + pb4 + bv_[i]; \
                o_[0] *= siluf_(bflo(gwv_[i].x)); o_[1] *= siluf_(bfhi(gwv_[i].x)); o_[2] *= siluf_(bflo(gwv_[i].y)); o_[3] *= siluf_(bfhi(gwv_[i].y)); \
                u32x2 w_; w_.x = cvtpk(o_[0], o_[1]); w_.y = cvtpk(o_[2], o_[3]); \
                if (!(dbg & 256)) *(u32x2*)(obp + m_ * DM + h * 64 + 4 * fr) = w_; } } while (0)
        float cr_[8][4];
        f32x4 lmu_[2][4];
#pragma unroll
        for (int ks = 0; ks < 2; ++ks) { lmu_[ks][0] = *(LAS const f32x4*)(cst + 8 * 64 + 32 * ks + 8 * fq); lmu_[ks][1] = *(LAS const f32x4*)(cst + 8 * 64 + 32 * ks + 8 * fq + 4);
            lmu_[ks][2] = *(LAS const f32x4*)(cst + 9 * 64 + 32 * ks + 8 * fq); lmu_[ks][3] = *(LAS const f32x4*)(cst + 9 * 64 + 32 * ks + 8 * fq + 4); }
#pragma unroll
        for (int a_ = 0; a_ < 8; ++a_)
#pragma unroll
            for (int j = 0; j < 4; ++j) cr_[a_][j] = cst[a_ * 64 + 16 * j + fr];
        PREP_FETCH(par);
        for (int c = par; c < nch; c += 2) { cgl = (unsigned)c;
            const int t0 = c * CH;
            LAS unsigned char* raw = lds + par * RAWBUF;
#pragma unroll
            for (int sg = 0; sg < 5; ++sg)
#pragma unroll
                for (int rg = 0; rg < 3; ++rg) { if (rg < 2 || rsub == 0) *(LAS u32x4*)(raw + (sg * 3 + rg) * 1024 + lane * 16) = pf[sg * 3 + rg]; }
            if (t0 == 0 && rsub == 0) {
#pragma unroll
                for (int sg = 0; sg < 5; ++sg) {
                    u32x4 v = (u32x4){0u, 0u, 0u, 0u};
                    if (sample) { const int col_ = (sg < 3 ? sg * 384 + h * 64 : (sg == 3 ? U_WLO : U_ALO)) + c8 * 8;
                        const f32x4 a = *(const f32x4*)(sh0 + col_), bq = *(const f32x4*)(sh0 + col_ + 4); v.x = cvtpk(a[0], a[1]); v.y = cvtpk(a[2], a[3]); v.z = cvtpk(bq[0], bq[1]); v.w = cvtpk(bq[2], bq[3]); }
                    *(LAS u32x4*)(raw + sg * 3 * 1024 + c8 * 16) = v;
                }
            }
            asm volatile("" ::: "memory");
            if (c + 2 < nch) PREP_FETCH(c + 2);
            int zz = 0; asm volatile("" : "+v"(zz));
            LAS const float* cz = cst + zz;
            f32x4 Dw[4], Da[4];
            {
                bf16x8 Aw[2], Aa[2];
#pragma unroll
                for (int ks = 0; ks < 2; ++ks) {
                    const u32x4 cw = *(LAS const u32x4*)(raw + RAWOFF(fr + 1, 3, 32 * ks + 8 * fq)), pwv = *(LAS const u32x4*)(raw + RAWOFF(fr, 3, 32 * ks + 8 * fq));
                    const u32x4 ca = *(LAS const u32x4*)(raw + RAWOFF(fr + 1, 4, 32 * ks + 8 * fq)), pav = *(LAS const u32x4*)(raw + RAWOFF(fr, 4, 32 * ks + 8 * fq));
                    const f32x4 mw0 = lmu_[ks][0], mw1 = lmu_[ks][1], ma0 = lmu_[ks][2], ma1 = lmu_[ks][3];
                    u32x4 pw, pa;
#pragma unroll
                    for (int e = 0; e < 4; ++e) {
                        const float c0 = bflo(cw[e]), c1 = bfhi(cw[e]), p0 = bflo(pwv[e]), p1 = bfhi(pwv[e]);
                        const float m0_ = (e < 2 ? mw0[2 * e] : mw1[2 * e - 4]), m1_ = (e < 2 ? mw0[2 * e + 1] : mw1[2 * e - 3]);
                        const float z0 = c0 + (p0 - c0) * m0_, z1 = c1 + (p1 - c1) * m1_;
                        const float t0_ = 1.f - 2.f * fast_rcp(1.f + fast_exp2(2.f * LOG2E * z0)), t1_ = 1.f - 2.f * fast_rcp(1.f + fast_exp2(2.f * LOG2E * z1));
                        pw[e] = cvtpk(t0_, t1_);
                        const float d0 = bflo(ca[e]), d1 = bfhi(ca[e]), q0 = bflo(pav[e]), q1 = bfhi(pav[e]);
                        const float n0_ = (e < 2 ? ma0[2 * e] : ma1[2 * e - 4]), n1_ = (e < 2 ? ma0[2 * e + 1] : ma1[2 * e - 3]);
                        pa[e] = cvtpk(d0 + (q0 - d0) * n0_, d1 + (q1 - d1) * n1_);
                    }
                    Aw[ks] = __builtin_bit_cast(bf16x8, pw); Aa[ks] = __builtin_bit_cast(bf16x8, pa);
                }
#pragma unroll
                for (int j = 0; j < 4; ++j) {
                    const f32x4 z = (f32x4){0.f, 0.f, 0.f, 0.f};
                    LAS const unsigned char* bt = btab + zz + lane * 16;
                    Dw[j] = MFMA16(Aw[0], *(LAS const bf16x8*)(bt + ((0 * 4 + j) * 2 + 0) * 1024), z); Dw[j] = MFMA16(Aw[1], *(LAS const bf16x8*)(bt + ((0 * 4 + j) * 2 + 1) * 1024), Dw[j]);
                    Da[j] = MFMA16(Aa[0], *(LAS const bf16x8*)(bt + ((1 * 4 + j) * 2 + 0) * 1024), z); Da[j] = MFMA16(Aa[1], *(LAS const bf16x8*)(bt + ((1 * 4 + j) * 2 + 1) * 1024), Da[j]);
                }
            }
            if (cgl >= 2) {
#pragma unroll
                for (int j = 0; j < 4; ++j) wait_ge(&flags[F_CONS + j], cgl - 1);
            }
            LAS float* opb = (LAS float*)(lds + SC_OP + (cgl & 1) * OPBUF_BYTES);
            LAS float* bon = (LAS float*)(lds + SC_BON + (cgl & 1) * 64);
            float lr_[4], lk_[4], lv_[4];
#pragma unroll
            for (int i = 0; i < 4; ++i) {
                const int tl = 4 * fq + i; LAS const unsigned char* rc = raw + RAWOFF(tl + 1, 0, fr); LAS const unsigned char* rp = raw + RAWOFF(tl, 0, fr);
#define RB(p_, sg_, j_) bf2f(*(LAS const bf16_t*)((p_) + (sg_) * 3072 + (j_) * 32))
                float rr[4], kk[4], vv[4], aa[4], ww[4], kn[4]; float ss = 0.f;
#pragma unroll
                for (int j = 0; j < 4; ++j) {
                    const float cr = RB(rc, 0, j), ck = RB(rc, 1, j), cv = RB(rc, 2, j);
                    const float pr = i == 0 ? RB(rp, 0, j) : lr_[j], pk = i == 0 ? RB(rp, 1, j) : lk_[j], pv_ = i == 0 ? RB(rp, 2, j) : lv_[j];
                    lr_[j] = cr; lk_[j] = ck; lv_[j] = cv;
                    rr[j] = cr + (pr - cr) * cr_[0][j]; kk[j] = ck + (pk - ck) * cr_[1][j]; vv[j] = cv + (pv_ - cv) * cr_[2][j];
                    const float x = cr_[3][j] + Dw[j][i];
                    const float sg = fast_rcp(1.f + fast_exp2(-LOG2E * x));
                    ww[j] = fast_exp2(-0.60653066f * LOG2E * sg);
                    aa[j] = fast_rcp(1.f + fast_exp2(-LOG2E * (cr_[4][j] + Da[j][i])));
                    kn[j] = kk[j] * cr_[5][j]; ss += kn[j] * kn[j];
                }
                ss = red16(ss);
                const float rn = __builtin_amdgcn_rsqf(ss + 1e-12f);
                float bs = 0.f; LAS float* o = opb + tl * OPTOK + fr;
#pragma unroll
                for (int j = 0; j < 4; ++j) {
                    const float knn = kn[j] * rn, kp = kk[j] * (1.f + (aa[j] - 1.f) * cr_[6][j]);
                    bs += rr[j] * kp * cr_[7][j];
                    o[16 * j] = ww[j]; o[64 + 16 * j] = knn; o[128 + 16 * j] = knn * aa[j]; o[192 + 16 * j] = kp; o[256 + 16 * j] = rr[j]; o[320 + 16 * j] = vv[j];
                }
                bs = red16(bs);
                if (fr == 0) bon[tl] = bs;
#undef RB
            }
            st_flag(&flags[par ? F_PRODB : F_PROD], (cgl >> 1) + 1);
            if (c >= 2) POST_CHUNK(c - 2);
        }
        POST_CHUNK(nch - 2 + par);
        wait_ge(&flags[par ? F_PROD : F_PRODB], (unsigned)(nch / 2));
#undef POST_CHUNK
#undef PREP_FETCH
    }
}

DI void prep_simple(PP P, int l, LAS unsigned char* lds, int lane, int seq0, int nseq, bool sample, int dbg) {
    LAS unsigned* flags = (LAS unsigned*)(lds + SC_FLAGS);
    LAS float* Wd = (LAS float*)lds; LAS float* Wa = Wd + 4096;
    LAS float* lor = (LAS float*)(lds + 4 * WK_STRIDE);
    const bf16_t* ub = (const bf16_t*)(P->ws + WS_UB);
    const float* mu = P->in[10] + (size_t)l * SHW;
    unsigned cgl = 0;
    const int nch = sample ? TSS / CH : TP / CH;
    for (int s = 0; s < nseq; ++s) {
        const int seq = seq0 + s, b = seq / 6, h = seq % 6;
        const int kc = h * 64 + lane;
        const float mur = mu[U_R + kc], muk = mu[U_K + kc], muv = mu[U_V + kc], muw = mu[U_WLO + lane], mua = mu[U_ALO + lane];
        const float w0c = P->in[11][(size_t)l * 384 + kc], a0c = P->in[13][(size_t)l * 384 + kc], kkc = P->in[15][(size_t)l * 384 + kc], kac = P->in[16][(size_t)l * 384 + kc], rkc = P->in[17][(size_t)l * 384 + kc];
        const size_t m0 = sample ? (size_t)MP + (size_t)b * TSS : (size_t)b * TP;
        const int T = sample ? TSS : TP;
        const float* sh0 = P->in[8] + (size_t)(l * 32 + b) * SHW;
        { const float* wd = P->in[12] + (size_t)l * 64 * 384 + kc; const float* wa = P->in[14] + (size_t)l * 64 * 384 + kc;
#pragma unroll 4
          for (int i = 0; i < 64; ++i) { Wd[i * 64 + lane] = wd[(size_t)i * 384]; Wa[i * 64 + lane] = wa[(size_t)i * 384]; } }
        float pr = sample ? sh0[U_R + kc] : 0.f, pk = sample ? sh0[U_K + kc] : 0.f, pv = sample ? sh0[U_V + kc] : 0.f, pwl = sample ? sh0[U_WLO + lane] : 0.f, pal = sample ? sh0[U_ALO + lane] : 0.f;
        const bf16_t* row = ub + m0 * NPAD;
        unsigned short n_r = row[U_R + kc], n_k = row[U_K + kc], n_v = row[U_V + kc], n_wl = row[U_WLO + lane], n_al = row[U_ALO + lane];
        for (int c = 0; c < nch; ++c, ++cgl) {
            if (cgl >= 2) {
#pragma unroll
                for (int j = 0; j < 4; ++j) wait_ge(&flags[F_CONS + j], cgl - 1);
            }
            LAS float* opb = (LAS float*)(lds + SC_OP + (cgl & 1) * OPBUF_BYTES);
            LAS float* bon = (LAS float*)(lds + SC_BON + (cgl & 1) * 64);
#pragma unroll 1
            for (int tl = 0; tl < CH; ++tl) {
                const int t = c * CH + tl;
                const float cr = bf2f(n_r), ck = bf2f(n_k), cv = bf2f(n_v), cwl = bf2f(n_wl), cal = bf2f(n_al);
                { const bf16_t* nrow = ub + (m0 + (t + 1 < T ? t + 1 : t)) * NPAD;
                  n_r = nrow[U_R + kc]; n_k = nrow[U_K + kc]; n_v = nrow[U_V + kc]; n_wl = nrow[U_WLO + lane]; n_al = nrow[U_ALO + lane]; }
                const float r = cr + (pr - cr) * mur, k = ck + (pk - ck) * muk, v = cv + (pv - cv) * muv, zw = cwl + (pwl - cwl) * muw, za = cal + (pal - cal) * mua;
                pr = cr; pk = ck; pv = cv; pwl = cwl; pal = cal;
                lor[lane] = 1.f - 2.f * fast_rcp(1.f + fast_exp2(2.f * LOG2E * zw)); lor[64 + lane] = za;
                float dw = 0.f, da = 0.f;
#pragma unroll 2
                for (int i = 0; i < 64; i += 4) { const f32x4 tw = *(LAS const f32x4*)(lor + i), ta = *(LAS const f32x4*)(lor + 64 + i);
#pragma unroll
                    for (int e = 0; e < 4; ++e) { dw += tw[e] * Wd[(i + e) * 64 + lane]; da += ta[e] * Wa[(i + e) * 64 + lane]; } }
                const float x = w0c + dw;
                const float sg = fast_rcp(1.f + fast_exp2(-LOG2E * x));
                const float w = fast_exp2(-0.60653066f * LOG2E * sg);
                const float a = fast_rcp(1.f + fast_exp2(-LOG2E * (a0c + da)));
                const float kn = k * kkc; const float ss = wave_sum(kn * kn);
                const float knn = kn * (1.f / sqrtf(ss + 1e-12f));
                const float kp = k * (1.f + (a - 1.f) * kac);
                const float bs = wave_sum(r * kp * rkc);
                LAS float* o = opb + tl * OPTOK + lane;
                o[0] = w; o[64] = knn; o[128] = knn * a; o[192] = kp; o[256] = r; o[320] = v;
                if (lane == 0) bon[tl] = bs;
            }
            st_flag(&flags[F_PROD], cgl + 1);
        }
    }
}

DI void post_wave(PP P, int l, LAS unsigned char* lds, int lane, int seq0, int nseq, bool sample, int dbg) {
    const int r16 = lane & 15, tq = lane >> 4;
    LAS unsigned* flags = (LAS unsigned*)(lds + SC_FLAGS);
    const bf16_t* ub = (const bf16_t*)(P->ws + WS_UB); bf16_t* ob = (bf16_t*)(P->ws + WS_OB);
    unsigned cgl = 0;
    const int nch = sample ? TSS / CH : TP / CH;
    for (int s = 0; s < nseq; ++s) {
        const int seq = seq0 + s, b = seq / 6, h = seq % 6;
        const size_t m0 = sample ? (size_t)MP + (size_t)b * TSS : (size_t)b * TP;
        const f32x4 g4 = *(const f32x4*)(P->in[18] + (size_t)l * 384 + h * 64 + 4 * r16), b4 = *(const f32x4*)(P->in[19] + (size_t)l * 384 + h * 64 + 4 * r16);
        for (int c = 0; c < nch; ++c, ++cgl) {
            if (dbg & 1) { for (int j = 0; j < 4; ++j) wait_ge(&flags[F_CONS + j], cgl + 1); st_flag(&flags[F_POST], cgl + 1); continue; }
            u32x2 gwv[4];
#pragma unroll
            for (int i = 0; i < 4; ++i) gwv[i] = *(const u32x2*)(ub + (m0 + c * CH + 4 * i + tq) * NPAD + U_GA + h * 64 + 4 * r16);
#pragma unroll
            for (int j = 0; j < 4; ++j) wait_ge(&flags[F_CONS + j], cgl + 1);
            LAS const float* yb = (LAS const float*)(lds + SC_Y + (cgl & 1) * YBUF_BYTES);
#pragma unroll
            for (int i = 0; i < 4; ++i) {
                const int tl = 4 * i + tq; const size_t m = m0 + c * CH + tl;
                const f32x4 y4 = *(LAS const f32x4*)(yb + tl * 128 + 4 * r16), bv4 = *(LAS const f32x4*)(yb + tl * 128 + 64 + 4 * r16);
                const u32x2 gw = gwv[i];
                const float mean = red16((y4[0] + y4[1]) + (y4[2] + y4[3])) * (1.f / 64.f);
                const f32x4 d = y4 - mean;
                const float var = red16((d[0] * d[0] + d[1] * d[1]) + (d[2] * d[2] + d[3] * d[3])) * (1.f / 64.f);
                const float rstd = 1.f / sqrtf(var + GN_EPS);
                f32x4 o = d * rstd * g4 + b4 + bv4;
                o[0] *= siluf_(bflo(gw.x)); o[1] *= siluf_(bfhi(gw.x)); o[2] *= siluf_(bflo(gw.y)); o[3] *= siluf_(bfhi(gw.y));
                u32x2 w; w.x = cvtpk(o[0], o[1]); w.y = cvtpk(o[2], o[3]);
                if (!(dbg & 256)) *(u32x2*)(ob + m * DM + h * 64 + 4 * r16) = w;
            }
            st_flag(&flags[F_POST], cgl + 1);
        }
    }
}

DI void naive_seq(PP P, int l, LAS unsigned char* sl, int lane, int b, int h, bool sample) {
    LAS float* opl = (LAS float*)sl;
    LAS float* lor = opl + 384;
    const bf16_t* ub = (const bf16_t*)(P->ws + WS_UB); bf16_t* ob = (bf16_t*)(P->ws + WS_OB);
    const float* mu = P->in[10] + (size_t)l * SHW;
    const int kc = h * 64 + lane;
    const float mur = mu[U_R + kc], muk = mu[U_K + kc], muv = mu[U_V + kc], muw = mu[U_WLO + lane], mua = mu[U_ALO + lane];
    const float w0c = P->in[11][(size_t)l * 384 + kc], a0c = P->in[13][(size_t)l * 384 + kc], kkc = P->in[15][(size_t)l * 384 + kc], kac = P->in[16][(size_t)l * 384 + kc], rkc = P->in[17][(size_t)l * 384 + kc];
    const float gng = P->in[18][(size_t)l * 384 + kc], gnb = P->in[19][(size_t)l * 384 + kc];
    const size_t m0 = sample ? (size_t)MP + (size_t)b * TSS : (size_t)b * TP;
    const int T = sample ? TSS : TP;
    const float* sh0 = P->in[8] + (size_t)(l * 32 + b) * SHW;
    LAS float* Wd = opl + 512; LAS float* Wa = Wd + 4096;
    { const float* wd = P->in[12] + (size_t)l * 64 * 384 + kc; const float* wa = P->in[14] + (size_t)l * 64 * 384 + kc;
#pragma unroll 4
      for (int i = 0; i < 64; ++i) { Wd[i * 64 + lane] = wd[(size_t)i * 384]; Wa[i * 64 + lane] = wa[(size_t)i * 384]; } }
    float S[64];
    if (sample) { const float* sp = P->in[7] + ((size_t)((l * 32 + b) * 6 + h) * 64 + lane) * 64;
#pragma unroll
        for (int k = 0; k < 64; ++k) S[k] = sp[k]; }
    else {
#pragma unroll
        for (int k = 0; k < 64; ++k) S[k] = 0.f; }
    float pr = sample ? sh0[U_R + kc] : 0.f, pk = sample ? sh0[U_K + kc] : 0.f, pv = sample ? sh0[U_V + kc] : 0.f, pwl = sample ? sh0[U_WLO + lane] : 0.f, pal = sample ? sh0[U_ALO + lane] : 0.f;
    const bf16_t* row = ub + m0 * NPAD;
    unsigned short n_r = row[U_R + kc], n_k = row[U_K + kc], n_v = row[U_V + kc], n_wl = row[U_WLO + lane], n_al = row[U_ALO + lane], n_g = row[U_GA + kc];
#pragma unroll 1
    for (int t = 0; t < T; ++t) {
        const float cr = bf2f(n_r), ck = bf2f(n_k), cv = bf2f(n_v), cwl = bf2f(n_wl), cal = bf2f(n_al), cg = bf2f(n_g);
        { const bf16_t* nrow = ub + (m0 + (t + 1 < T ? t + 1 : t)) * NPAD;
          n_r = nrow[U_R + kc]; n_k = nrow[U_K + kc]; n_v = nrow[U_V + kc]; n_wl = nrow[U_WLO + lane]; n_al = nrow[U_ALO + lane]; n_g = nrow[U_GA + kc]; }
        const float r = cr + (pr - cr) * mur, k = ck + (pk - ck) * muk, v = cv + (pv - cv) * muv, zw = cwl + (pwl - cwl) * muw, za = cal + (pal - cal) * mua;
        pr = cr; pk = ck; pv = cv; pwl = cwl; pal = cal;
        lor[lane] = tanhf(zw); lor[64 + lane] = za;
        float dw = 0.f, da = 0.f;
#pragma unroll 1
        for (int i = 0; i < 64; i += 4) { const f32x4 tw = *(LAS const f32x4*)(lor + i), ta = *(LAS const f32x4*)(lor + 64 + i);
#pragma unroll
            for (int e = 0; e < 4; ++e) { dw += tw[e] * Wd[(i + e) * 64 + lane]; da += ta[e] * Wa[(i + e) * 64 + lane]; } }
        const float x = w0c + dw;
        const float wlog = -log1pf(expf(-x)) - 0.5f;
        const float w = expf(-expf(wlog));
        const float a = 1.f / (1.f + expf(-(a0c + da)));
        const float kn = k * kkc; const float ss = wave_sum(kn * kn);
        const float knn = kn * (1.f / sqrtf(ss + 1e-12f));
        const float kp = k * (1.f + (a - 1.f) * kac);
        const float bs = wave_sum(r * kp * rkc);
        opl[lane] = w; opl[64 + lane] = knn; opl[128 + lane] = knn * a; opl[192 + lane] = kp; opl[256 + lane] = r; opl[320 + lane] = v;
        const float vv = v;
        float sa = 0.f;
#pragma unroll
        for (int i = 0; i < 64; i += 4) { const f32x4 q = *(LAS const f32x4*)(opl + 64 + i);
#pragma unroll
            for (int e = 0; e < 4; ++e) sa += S[i + e] * q[e]; }
        float y = 0.f;
#pragma unroll
        for (int i = 0; i < 64; i += 4) { const f32x4 qw = *(LAS const f32x4*)(opl + i), qa = *(LAS const f32x4*)(opl + 128 + i), qk = *(LAS const f32x4*)(opl + 192 + i), qr = *(LAS const f32x4*)(opl + 256 + i);
#pragma unroll
            for (int e = 0; e < 4; ++e) { S[i + e] = S[i + e] * qw[e] - sa * qa[e] + vv * qk[e]; y += S[i + e] * qr[e]; } }
        const float mean = wave_sum(y) * (1.f / 64.f); const float d = y - mean;
        const float var = wave_sum(d * d) * (1.f / 64.f);
        float o = d * (1.f / sqrtf(var + GN_EPS)) * gng + gnb + bs * vv;
        o *= cg / (1.f + expf(-cg));
        ob[(m0 + t) * DM + kc] = (bf16_t)(cvtpk(o, o) & 0xffffu);
        asm volatile("" ::: "memory");
    }
    float* so = P->out + (sample ? O_SWKV : O_PWKV) + ((size_t)((l * 32 + b) * 6 + h) * 64 + lane) * 64;
#pragma unroll
    for (int k = 0; k < 64; k += 4) *(f32x4*)(so + k) = (f32x4){S[k], S[k + 1], S[k + 2], S[k + 3]};
}

DI bf16x8 ld_bf16x8(const bf16_t* p) { return *(const bf16x8*)p; }
DI bf16x8 cvt_f32x8(const float* p) { const f32x4 a = *(const f32x4*)p, b = *(const f32x4*)(p + 4); u32x4 w; w.x = cvtpk(a[0], a[1]); w.y = cvtpk(a[2], a[3]); w.z = cvtpk(b[0], b[1]); w.w = cvtpk(b[2], b[3]); return __builtin_bit_cast(bf16x8, w); }
DI bf16x8 pack8(const f32x16& x, int s) { u32x4 w; w.x = cvtpk(x[8 * s], x[8 * s + 1]); w.y = cvtpk(x[8 * s + 2], x[8 * s + 3]); w.z = cvtpk(x[8 * s + 4], x[8 * s + 5]); w.w = cvtpk(x[8 * s + 6], x[8 * s + 7]); return __builtin_bit_cast(bf16x8, w); }
DI bf16x8 vfrag(LAS const unsigned char* p) {
    const v4i16_t lo = __builtin_amdgcn_ds_read_tr16_b64_v4i16((LAS v4i16_t*)p), hi = __builtin_amdgcn_ds_read_tr16_b64_v4i16((LAS v4i16_t*)(p + 512));
    return (bf16x8){lo[0], lo[1], lo[2], lo[3], hi[0], hi[1], hi[2], hi[3]};
}

struct AttnState { f32x16 o0, o1; float m_run, l_run, carry; };

template <int KIND, bool F32>
DI void attn_tile(AttnState& st, const bf16x8 (&qr)[4], bf16x8 (&kf)[4], f32x4 (&kq)[8], bf16x8 (&vr)[4], f32x4 (&vq)[8], const char* knext, const char* vnext, unsigned vpitch16, float lf, bool diag, LAS unsigned char* wl, int lane) {
    const int r32 = lane & 31, hi = lane >> 5;
    LAS float* sm = (LAS float*)(wl + 8192);
#pragma unroll
    for (int pc = 0; pc < 4; ++pc) {
        if (F32) { u32x4 x; x.x = cvtpk(vq[2 * pc][0], vq[2 * pc][1]); x.y = cvtpk(vq[2 * pc][2], vq[2 * pc][3]); x.z = cvtpk(vq[2 * pc + 1][0], vq[2 * pc + 1][1]); x.w = cvtpk(vq[2 * pc + 1][2], vq[2 * pc + 1][3]);
            *(LAS u32x4*)(wl + pc * 1024 + lane * 16) = x; }
        else *(LAS bf16x8*)(wl + pc * 1024 + lane * 16) = vr[pc];
    }
#pragma unroll
    for (int pc = 0; pc < 4; ++pc) {
        if (F32) { const char* p_ = vnext + (size_t)((pc & 1) * vpitch16 + (pc >> 1) * 128); vq[2 * pc] = *(const f32x4*)p_; vq[2 * pc + 1] = *(const f32x4*)(p_ + 16); }
        else vr[pc] = *(const bf16x8*)(vnext + pc * 1024);
    }
    if (F32) {
#pragma unroll
        for (int i = 0; i < 4; ++i) { u32x4 w; w.x = cvtpk(kq[2 * i][0], kq[2 * i][1]); w.y = cvtpk(kq[2 * i][2], kq[2 * i][3]); w.z = cvtpk(kq[2 * i + 1][0], kq[2 * i + 1][1]); w.w = cvtpk(kq[2 * i + 1][2], kq[2 * i + 1][3]);
            kf[i] = __builtin_bit_cast(bf16x8, w); }
    }
    f32x16 p = {};
    __builtin_amdgcn_s_setprio(1);
#pragma unroll
    for (int d0 = 0; d0 < 4; ++d0) p = MFMA32(kf[d0], qr[d0], p);
    __builtin_amdgcn_s_setprio(0);
    asm volatile("" : "+v"(p));
    LAS const unsigned char* vb = wl + ((lane >> 4) & 1) * 32 + (lane & 3) * 8 + (4 * hi + ((lane & 15) >> 2)) * 64;
    const bf16x8 vf0 = vfrag(vb + 0 * 1024), vf1 = vfrag(vb + 1 * 1024), vf2 = vfrag(vb + 2 * 1024), vf3 = vfrag(vb + 3 * 1024);
    if (F32) {
#pragma unroll
        for (int d0 = 0; d0 < 4; ++d0) { kq[2 * d0] = *(const f32x4*)(knext + 64 * d0); kq[2 * d0 + 1] = *(const f32x4*)(knext + 64 * d0 + 16); }
    } else {
#pragma unroll
        for (int d0 = 0; d0 < 4; ++d0) kf[d0] = *(const bf16x8*)(knext + d0 * 1024);
    }
    if (KIND == 0) {
        float incl = lf;
#pragma unroll
        for (int off = 1; off < 32; off <<= 1) { const float t = __shfl_down(incl, off, 32); if (r32 + off < 32) incl += t; }
        const float bias = (st.carry + (incl - lf)) * LOG2E;
        const float tot = __shfl(incl, 0, 32);
        if (hi == 0) sm[r32] = bias;
        st.carry += tot;
        float s[16];
#pragma unroll
        for (int g = 0; g < 4; ++g) { const f32x4 b4 = *(LAS const f32x4*)(sm + 8 * g + 4 * hi);
#pragma unroll
            for (int e = 0; e < 4; ++e) s[4 * g + e] = p[4 * g + e] * QSCALE2 + b4[e]; }
        if (diag) {
#pragma unroll
            for (int r = 0; r < 16; ++r) if (crow(r, hi) > r32) s[r] = -1e30f;
        }
        if (diag) {
            float mt = s[0];
#pragma unroll
            for (int r = 1; r < 16; ++r) mt = fmaxf(mt, s[r]);
            { auto rr = __builtin_amdgcn_permlane32_swap(__float_as_uint(mt), __float_as_uint(mt), false, false); mt = fmaxf(__uint_as_float(rr[0]), __uint_as_float(rr[1])); }
            st.m_run = mt;
        }
        float ls = 0.f;
#pragma unroll
        for (int r = 0; r < 16; ++r) { p[r] = fast_exp2(s[r] - st.m_run); ls += p[r]; }
        st.l_run += ls;
    } else {
        float be[16], om[16];
#pragma unroll
        for (int r = 0; r < 16; ++r) {
            const float z2 = fmaxf(p[r] * QSCALE2, -80.f);
            const float e = fast_exp2(-z2); const float bt = fast_rcp(1.f + e);
            be[r] = bt; om[r] = e * bt;
        }
        if (diag) {
#pragma unroll
            for (int r = 0; r < 16; ++r) if (crow(r, hi) >= r32) { be[r] = 0.f; om[r] = 1.f; }
        }
        float H[4], oth[4];
#pragma unroll
        for (int g = 0; g < 4; ++g) { const float gp = (om[4 * g] * om[4 * g + 1]) * (om[4 * g + 2] * om[4 * g + 3]);
            auto rr = __builtin_amdgcn_permlane32_swap(__float_as_uint(gp), __float_as_uint(gp), false, false);
            const float a = __uint_as_float(rr[0]), b = __uint_as_float(rr[1]); H[g] = a * b; oth[g] = hi ? 1.f : b; }
        float suf[4]; suf[3] = 1.f; suf[2] = H[3]; suf[1] = H[3] * H[2]; suf[0] = suf[1] * H[1];
        const float cin = st.carry;
#pragma unroll
        for (int g = 0; g < 4; ++g) {
            float A = cin * suf[g] * oth[g];
            p[4 * g + 3] = be[4 * g + 3] * A; A *= om[4 * g + 3];
            p[4 * g + 2] = be[4 * g + 2] * A; A *= om[4 * g + 2];
            p[4 * g + 1] = be[4 * g + 1] * A; A *= om[4 * g + 1];
            p[4 * g + 0] = be[4 * g + 0] * A;
        }
        st.carry = cin * suf[0] * H[0];
    }
    const bf16x8 pa0 = pack8(p, 0), pa1 = pack8(p, 1);
    __builtin_amdgcn_s_setprio(1);
    st.o0 = MFMA32(pa0, vf0, st.o0);
    st.o1 = MFMA32(pa0, vf2, st.o1);
    st.o0 = MFMA32(pa1, vf1, st.o0);
    st.o1 = MFMA32(pa1, vf3, st.o1);
    __builtin_amdgcn_s_setprio(0);
    if (F32) {
#pragma unroll
        for (int i = 0; i < 8; ++i) { asm volatile("" : "+v"(kq[i])); asm volatile("" : "+v"(vq[i])); }
    } else {
#pragma unroll
        for (int i = 0; i < 4; ++i) { asm volatile("" : "+v"(kf[i])); asm volatile("" : "+v"(vr[i])); }
    }
}

template <int KIND>
DI void attn_item(PP P, int l, LAS unsigned char* wl, int lane, bool sample, int b, int h, int qb) {
    const int r32 = lane & 31, hi = lane >> 5;
    const char* ubb = (const char*)(P->ws + WS_UB);
    constexpr unsigned PITCH = NPAD * 2;
    constexpr int NH = KIND == 0 ? NHB : NHC;
    constexpr int QC = KIND == 0 ? U_QB : U_QC, KC = KIND == 0 ? U_KB : U_KC, VC = KIND == 0 ? U_VB : U_VC, GC = KIND == 0 ? U_GB : U_GC, OC = KIND == 0 ? 384 : 768;
    const int q0 = qb * 32, past = sample ? PAST : 0;
    const unsigned row0 = sample ? (unsigned)(MP + b * TSS) : (unsigned)(b * TP);
    const unsigned kl = (unsigned)(r32 * NPAD + KC + h * 64 + 8 * hi) * 2u;
    const unsigned vl = (unsigned)((lane >> 2) * NPAD + VC + h * 64 + (lane & 3) * 8) * 2u;
    bf16x8 qr[4];
    { const char* qp = ubb + (size_t)((row0 + q0) * PITCH + (unsigned)(r32 * NPAD + QC + h * 64 + 8 * hi) * 2u);
#pragma unroll
      for (int d0 = 0; d0 < 4; ++d0) qr[d0] = *(const bf16x8*)(qp + 32 * d0); }
    AttnState st; st.o0 = f32x16{}; st.o1 = f32x16{}; st.m_run = -1e30f; st.l_run = 0.f; st.carry = KIND == 0 ? 0.f : 1.f;
    const int tdiag = (past + q0) / 32, tnew0 = past / 32;
    const float* logf = (const float*)(P->ws + WS_LOGF) + h;
    bf16x8 kf[4], vr[4]; f32x4 kq[8], vq[8];
    {
        const unsigned tix0 = sample ? (unsigned)(32 * NH * 64 + (b * NH + h) * 2) : (unsigned)((b * NH + h) * 64);
        const char* kbb = (const char*)(P->ws + (KIND == 0 ? WS_BFK : WS_BSK)) + (size_t)tix0 * 4096 + lane * 16;
        const char* vbb = (const char*)(P->ws + (KIND == 0 ? WS_BFV : WS_BSV)) + (size_t)tix0 * 4096 + lane * 16;
        float lf = 0.f;
        { const unsigned tl_ = (unsigned)(tdiag - tnew0); const unsigned trow_ = row0 + tl_ * 32u;
#pragma unroll
          for (int d0 = 0; d0 < 4; ++d0) kf[d0] = *(const bf16x8*)(kbb + (size_t)(tl_ * 4096u) + d0 * 1024);
#pragma unroll
          for (int pc = 0; pc < 4; ++pc) vr[pc] = *(const bf16x8*)(vbb + (size_t)(tl_ * 4096u) + pc * 1024);
          if (KIND == 0) lf = logf[(size_t)(trow_ + r32) * 8]; }
        for (int tile = tdiag; tile >= tnew0; --tile) {
            const unsigned tn = (unsigned)((tile > tnew0 ? tile - 1 : tnew0) - tnew0);
            const unsigned trow_ = row0 + tn * 32u;
            const float lfc = lf;
            if (KIND == 0) lf = logf[(size_t)(trow_ + r32) * 8];
            attn_tile<KIND, false>(st, qr, kf, kq, vr, vq, kbb + (size_t)(tn * 4096u), vbb + (size_t)(tn * 4096u), 0u, lfc, tile == tdiag, wl, lane);
        }
    }
    if (sample) {
        const char* cK = (const char*)(P->in[KIND == 0 ? 2 : 5] + (size_t)(l * 32 + b) * PAST * NH * 64 + h * 64);
        const char* cV = (const char*)(P->in[KIND == 0 ? 3 : 6] + (size_t)(l * 32 + b) * PAST * NH * 64 + h * 64);
        const float* cL = P->in[4] + (size_t)(l * 32 + b) * PAST * 6 + h;
        constexpr unsigned CP = NH * 64 * 4;
        const unsigned klc = (unsigned)r32 * CP + 32u * hi, vlc = (unsigned)(lane >> 2) * CP + 32u * (lane & 3);
        float lf = 0.f;
        { const char* kb_ = cK + (size_t)((unsigned)(tnew0 - 1) * 32u * CP) + klc;
#pragma unroll
          for (int d0 = 0; d0 < 4; ++d0) { kq[2 * d0] = *(const f32x4*)(kb_ + 64 * d0); kq[2 * d0 + 1] = *(const f32x4*)(kb_ + 64 * d0 + 16); }
          const char* vb_ = cV + (size_t)((unsigned)(tnew0 - 1) * 32u * CP) + vlc;
#pragma unroll
          for (int pc = 0; pc < 4; ++pc) { const char* p_ = vb_ + (size_t)((pc & 1) * (16u * CP) + (pc >> 1) * 128); vq[2 * pc] = *(const f32x4*)p_; vq[2 * pc + 1] = *(const f32x4*)(p_ + 16); }
          if (KIND == 0) lf = cL[(size_t)((tnew0 - 1) * 32 + r32) * 6]; }
        for (int tile = tnew0 - 1; tile >= 0; --tile) {
            const int tn = tile > 0 ? tile - 1 : 0;
            const float lfc = lf;
            if (KIND == 0) lf = cL[(size_t)(tn * 32 + r32) * 6];
            attn_tile<KIND, true>(st, qr, kf, kq, vr, vq, cK + (size_t)((unsigned)tn * 32u * CP) + klc, cV + (size_t)((unsigned)tn * 32u * CP) + vlc, 16u * CP, lfc, false, wl, lane);
        }
    }
    LAS float* stg = (LAS float*)wl; LAS float* sm = (LAS float*)(wl + 8192);
    if (KIND == 0) {
        auto rr = __builtin_amdgcn_permlane32_swap(__float_as_uint(st.l_run), __float_as_uint(st.l_run), false, false);
        const float lt = __uint_as_float(rr[0]) + __uint_as_float(rr[1]);
        if (hi == 0) sm[r32] = 1.f / lt;
    }
#pragma unroll
    for (int r = 0; r < 16; ++r) { stg[crow(r, hi) * 64 + r32] = st.o0[r]; stg[crow(r, hi) * 64 + 32 + r32] = st.o1[r]; }
    char* obb = (char*)(P->ws + WS_OB);
#pragma unroll
    for (int i = 0; i < 4; ++i) {
        const int row = i * 8 + (lane >> 3), chn = lane & 7;
        const f32x4 a = *(LAS const f32x4*)(stg + row * 64 + chn * 8), c = *(LAS const f32x4*)(stg + row * 64 + chn * 8 + 4);
        const float li = KIND == 0 ? sm[row] : 1.f;
        const unsigned m = row0 + q0 + row;
        const u32x4 g = *(const u32x4*)(ubb + (size_t)(m * PITCH + (unsigned)(GC + h * 64 + chn * 8) * 2u));
        u32x4 w;
        w.x = cvtpk(a[0] * li * siluf_(bflo(g.x)), a[1] * li * siluf_(bfhi(g.x))); w.y = cvtpk(a[2] * li * siluf_(bflo(g.y)), a[3] * li * siluf_(bfhi(g.y)));
        w.z = cvtpk(c[0] * li * siluf_(bflo(g.z)), c[1] * li * siluf_(bfhi(g.z))); w.w = cvtpk(c[2] * li * siluf_(bflo(g.w)), c[3] * li * siluf_(bfhi(g.w)));
        *(u32x4*)(obb + (size_t)(m * (DM * 2) + (unsigned)(OC + h * 64 + chn * 8) * 2u)) = w;
    }
}

constexpr int Q_SAMPLE = 2 * (16 + 24), Q_ITEMS = Q_SAMPLE + 40 * 64;
DI unsigned xcc_id() { return (unsigned)__builtin_amdgcn_s_getreg((3 << 11) | 20) & 7u; }
DI void worker_loop(PP P, int l, int lq, LAS unsigned char* lds, int wave, int lane) {
    LAS unsigned char* wl = lds + wave * WK_STRIDE;
    unsigned* qbase = (unsigned*)(P->ws + WS_CTL) + 64 + lq * 128;
    const unsigned x0 = xcc_id();
    for (unsigned sx = 0; sx < 8; ++sx) {
        const unsigned x = (x0 + sx) & 7u;
        unsigned* qctr = qbase + x * 16;
        for (;;) {
            unsigned idx = 0;
            if (lane == 0) idx = atomicAdd(qctr, 1u);
            idx = (unsigned)__builtin_amdgcn_readfirstlane((int)idx);
            if (idx >= (unsigned)Q_ITEMS) break;
            int kind, smp, bh, qb;
            if (idx < (unsigned)Q_SAMPLE) {
                smp = 1;
                if (idx < 32u) { kind = 1; bh = (int)x + 8 * (int)(idx >> 1); qb = idx & 1; }
                else { const int i2 = idx - 32; kind = 0; bh = (int)x + 8 * (i2 >> 1); qb = i2 & 1; }
            } else {
                smp = 0;
                const int i2 = idx - Q_SAMPLE, g = i2 >> 6; qb = 63 - (i2 & 63);
                if (g < 16) { kind = 1; bh = (int)x + 8 * g; } else { kind = 0; bh = (int)x + 8 * (g - 16); }
            }
            if (kind) attn_item<1>(P, l, wl, lane, smp != 0, bh / NHC, bh % NHC, qb);
            else attn_item<0>(P, l, wl, lane, smp != 0, bh / NHB, bh % NHB, qb);
        }
    }
}

DI void phase_mix(PP P, int lq, LAS unsigned char* lds, int wave, int lane, int bidx, int gdim) {
    const int l = lq & 1; const int dbg = (lq & 2) ? (P->dbg | 256) : 0;
    if (wave == 0 && lane < 16) ((LAS unsigned*)(lds + SC_FLAGS))[lane] = 0u;
    __syncthreads();
    const int bx = bidx;
#ifdef NAIVE_SCAN
    if (wave == 0) {
        for (int sq = bx; sq < 384; sq += gdim) {
            if (sq < 192) naive_seq(P, l, lds + SC_OFF, lane, sq / 6, sq % 6, false);
            else naive_seq(P, l, lds + SC_OFF, lane, (sq - 192) / 6, (sq - 192) % 6, true);
        }
    }
#else
    if (gdim >= 256 && !(dbg & 16)) {
        if (bx < 192) {
#ifndef SK_SCAN
            if (wave < 4) scan_wave(P, l, lds, wave, lane, bx, 1, false, dbg, true);
#endif
#ifndef SK_PREP
            if (wave == 4 || wave == 5) helper2_wave(P, l, lds, lane, bx, wave - 4, dbg);
#endif
        } else if (bx < 256) {
            const int s0 = (bx - 192) * 3;
#ifndef SK_SCAN
            if (wave < 4) scan_wave(P, l, lds, wave, lane, s0, 3, true, dbg);
#endif
#ifndef SK_PREP
            if (wave == 4) PREPFN(P, l, lds, lane, s0, 3, true, dbg);
#endif
#ifndef SK_POST
            if (wave == 5) post_wave(P, l, lds, lane, s0, 3, true, dbg);
#endif
        }
    }
#endif
#ifndef SK_WORK
    if (!(dbg & 4)) worker_loop(P, l, lq, lds, wave, lane);
#endif
}

__global__ void __launch_bounds__(512, 2) fwd_kernel(Params Pv) {
    extern __shared__ __attribute__((aligned(16))) unsigned char lds_raw[];
    LAS unsigned char* lds = (LAS unsigned char*)lds_raw;
    const int tid = threadIdx.x, lane0 = tid & 63, wave0 = __builtin_amdgcn_readfirstlane(tid >> 6);
    PP P0 = (PP)__builtin_amdgcn_kernarg_segment_ptr();
    const int lo = Pv.ph_lo, hi = Pv.ph_hi;
    const int rep_ph = Pv.rep_ph;
#pragma unroll 1
    for (int ph2 = lo * 2; ph2 < hi * 2; ++ph2) {
        const int ph = ph2 >> 1, rep = ph2 & 1;
        if (rep && ph != rep_ph) continue;
        PP P = pp_launder(P0);
        int lane = lane0, wave = wave0, bidx = (int)blockIdx.x, gdim = (int)gridDim.x;
        asm volatile("" : "+v"(lane)); asm volatile("" : "+s"(wave)); asm volatile("" : "+s"(bidx)); asm volatile("" : "+s"(gdim));
        if (ph == 0) {
#ifndef SK_P0
            phase0(P, lds, wave, lane, bidx, gdim);
#endif
        } else {
            const int l = (ph - 1) >> 2, k = (ph - 1) & 3;
            if (k == 0 || k == 2) {
#ifndef SK_G1
                pg8::Gemm g; pg8::StaticOrder S; EpiU E;
                E.ws = P->ws; E.out = P->out; E.fb = P->in[20] + l * 6; E.l = l; E.mode = k;
                if (k == 0) { g = pg8::Gemm{(const bf16_t*)(P->ws + WS_XB), (const bf16_t*)(P->ws + WS_WIN) + (size_t)l * NPAD * DM, MT, NPAD, DM}; S.init(MT, NPAD, gdim, bidx); }
                else { g = pg8::Gemm{(const bf16_t*)(P->ws + WS_OB), (const bf16_t*)(P->ws + WS_WOUT) + (size_t)l * DM * DM, MT, DM, DM}; S.init(MT, DM, gdim, bidx); }
                pg8::gemm_phase<EpiU, pg8::StaticOrder, true, true>(lds, g, S, E);
#endif
            } else if (k == 1) {
#ifndef SK_MIX
                phase_mix(P, l + 2 * rep, lds, wave, lane, bidx, gdim);
#endif
            } else {
#ifndef SK_LN
                phase_ln(P, l, wave, lane, bidx, gdim);
#endif
            }
        }
        if (ph2 + 1 < hi * 2) cg::this_grid().sync();
    }
}

extern "C" void kernel_launch(void* const* d_in, const int* in_sizes, int n_in, void* d_out, int out_size, void* d_ws, size_t ws_size, hipStream_t stream) {
    static int grid = 0;
    if (grid == 0) {
        if (n_in != 24 || (size_t)out_size != O_END || ws_size < WS_END) { fprintf(stderr, "kernel_launch: unexpected shapes n_in %d out %d ws %zu\n", n_in, out_size, ws_size); grid = -1; return; }
        int dev = 0, cus = 0, per_cu = 0;
        (void)hipGetDevice(&dev); (void)hipDeviceGetAttribute(&cus, hipDeviceAttributeMultiprocessorCount, dev);
        if (hipFuncSetAttribute((const void*)fwd_kernel, hipFuncAttributeMaxDynamicSharedMemorySize, LDS_BYTES) != hipSuccess) { fprintf(stderr, "kernel_launch: hipFuncSetAttribute failed\n"); grid = -1; return; }
        if (hipOccupancyMaxActiveBlocksPerMultiprocessor(&per_cu, (const void*)fwd_kernel, 512, LDS_BYTES) != hipSuccess || per_cu < 1) { fprintf(stderr, "kernel_launch: occupancy query says %d\n", per_cu); per_cu = 1; }
        (void)hipGetLastError();
        grid = cus * 1;
        if (grid != 256) fprintf(stderr, "kernel_launch: grid %d (expected 256)\n", grid);
    }
    if (grid < 0) return;
    (void)hipMemsetAsync((char*)d_ws + WS_CTL, 0, CTL_BYTES, stream);
    Params p{};
    for (int i = 0; i < 24; ++i) p.in[i] = (const float*)d_in[i];
    p.out = (float*)d_out; p.ws = (unsigned char*)d_ws; p.ph_lo = 0; p.ph_hi = 9; p.rep_ph = -1; p.dbg = 0;
    void* args[] = {&p};
    hipError_t e = hipLaunchCooperativeKernel((const void*)fwd_kernel, dim3(grid), dim3(512), args, LDS_BYTES, stream);
    if (e != hipSuccess) fprintf(stderr, "cooperative launch failed: %s (grid %d)\n", hipGetErrorString(e), grid);
}
```

```cpp
#define PREPFN prep_wave
#include <hip/hip_runtime.h>
#include <hip/hip_cooperative_groups.h>
#include <cstdio>
#include <cstdint>
namespace cg = cooperative_groups;
namespace pg8 {
#define PG8_LAS __attribute__((address_space(3)))
typedef unsigned short bf16_t;
typedef short bf16x8 __attribute__((ext_vector_type(8)));
typedef float f32x4 __attribute__((ext_vector_type(4)));
typedef unsigned u32x4 __attribute__((ext_vector_type(4)));
constexpr int BM = 256, BK = 64, HALF = 128, HTB = HALF * BK * 2  , STAGE_BYTES = 8 * HTB, NXCD = 8, WGM = 8;

__host__ __device__ __forceinline__ int lds_byte(int r, int c) { const int st = (r >> 4) * 2 + (c >> 5), rr = r & 15, cc = c & 31, ob = rr * 64 + cc * 2; return st * 1024 + (ob ^ (((ob >> 9) & 1) << 5)); }
__host__ __device__ __forceinline__ void stage_rc(int b, int& R, int& C) { const int st = b / 1024, sb = b % 1024, swz = sb ^ (((sb >> 9) & 1) << 5); R = (st >> 1) * 16 + swz / 64; C = (st & 1) * 32 + (swz % 64) / 2; }
__host__ __device__ __forceinline__ int perm32(int rho) { const int n = rho >> 4, i = rho & 15; return 8 * (i >> 2) + 4 * n + (i & 3); }

struct Unit { int pm, pn; };
struct Gemm { const bf16_t* A; const bf16_t* Bt; int M, N, K; };

struct StaticOrder {
    int nM, nN, nwg, G, c;
    __host__ __device__ void init(int M, int N, int G_, int c_) { nM = M / BM; nN = N / BM; nwg = nM * nN; G = G_; c = c_; }
    __host__ __device__ bool next(int i, Unit& u) const {
        const long L = (long)i * G + c; if (L >= nwg) return false;
        int wgid = (int)L; { const int q = nwg / NXCD, r = nwg % NXCD, xcd = wgid % NXCD, off = wgid / NXCD; wgid = (xcd < r ? xcd * (q + 1) : r * (q + 1) + (xcd - r) * q) + off; }
        const int nig = WGM * nN, gid = wgid / nig, fm = gid * WGM, gsz = (nM - fm) < WGM ? (nM - fm) : WGM;
        u.pm = fm + ((wgid % nig) % gsz); u.pn = (wgid % nig) / gsz; return true;
    }
    __device__ __forceinline__ void a_ready(const Unit&) const {}
    __device__ __forceinline__ void done(const Unit&) const {}
};

template <class Epi, class Sched, bool ALIGN_EPI = false, bool SP2 = false>
__device__ __forceinline__ void gemm_phase(PG8_LAS unsigned char* lds, const Gemm g, const Sched& S, const Epi& E) {
    int tid_ = threadIdx.x; asm volatile("" : "+v"(tid_));
    const int tid = tid_, wid = __builtin_amdgcn_readfirstlane(tid >> 6), lane = tid & 63, wr = wid >> 2, wc = wid & 3, fr = lane & 15, fq = lane >> 4;
    const int K = g.K, nt = K / BK;
    unsigned voffA[2], voffB[2];
#pragma unroll
    for (int i = 0; i < 2; ++i) { int R, C; stage_rc(tid * 16 + i * 8192, R, C); const int Rb = Epi::PERM ? ((R & ~31) + perm32(R & 31)) : R;
        voffA[i] = (unsigned)(R * K + C) * 2u; voffB[i] = (unsigned)(Rb * K + C) * 2u; }
    const size_t kstep = (size_t)(BK * 2);
    const size_t hstep = (size_t)HALF * K * 2;
    const size_t tstep = 2 * hstep;
    const unsigned ldsw = (unsigned)wid * 1024u;
    const int aoff = lds_byte(wr * 64 + fr, fq * 8), boff = lds_byte(wc * 32 + fr, fq * 8);
#define PG8_SA(b, h) (((b) * 2 + (h)) * HTB)
#define PG8_SB(b, h) ((4 + (b) * 2 + (h)) * HTB)
#define PG8_STAGE(bufoff, gbase, voff) do { _Pragma("unroll") for (int _i = 0; _i < 2; ++_i) \
        __builtin_amdgcn_global_load_lds((const unsigned*)((const char*)(gbase) + (voff)[_i]), (PG8_LAS unsigned*)(lds + (bufoff) + ldsw + _i * 8192), 16, 0, 0); } while (0)
#define PG8_LDA(dst, b, h) do { _Pragma("unroll") for (int m = 0; m < 4; ++m) _Pragma("unroll") for (int k = 0; k < 2; ++k) dst[m][k] = *(const PG8_LAS bf16x8*)(lds + PG8_SA(b, h) + aoff + m * 2048 + k * 1024); } while (0)
#define PG8_LDB(dst, b, h) do { _Pragma("unroll") for (int n = 0; n < 2; ++n) _Pragma("unroll") for (int k = 0; k < 2; ++k) dst[n][k] = *(const PG8_LAS bf16x8*)(lds + PG8_SB(b, h) + boff + n * 2048 + k * 1024); } while (0)
#define PG8_MMA(ai, bj, At, Bt) do { __builtin_amdgcn_s_setprio(1); _Pragma("unroll") for (int m = 0; m < 4; ++m) _Pragma("unroll") for (int n = 0; n < 2; ++n) _Pragma("unroll") for (int k = 0; k < 2; ++k) \
        acc[ai][bj][m][n] = __builtin_amdgcn_mfma_f32_16x16x32_bf16(Bt[n][k], At[m][k], acc[ai][bj][m][n], 0, 0, 0); __builtin_amdgcn_s_setprio(0); } while (0)
#define PG8_WAIT_V(n) asm volatile("s_waitcnt vmcnt(" #n ")" ::: "memory")
#define PG8_WAIT_L(n) asm volatile("s_waitcnt lgkmcnt(" #n ")" ::: "memory")
#define PG8_BAR __builtin_amdgcn_s_barrier()
#define PG8_SCHED __builtin_amdgcn_sched_barrier(0)
    Unit cur, nxt; int ui = 0;
    if (!S.next(0, cur)) return;
    f32x4 acc[2][2][4][2];
#pragma unroll
    for (int a = 0; a < 2; ++a)
#pragma unroll
        for (int b = 0; b < 2; ++b)
#pragma unroll
            for (int m = 0; m < 4; ++m)
#pragma unroll
                for (int n = 0; n < 2; ++n) acc[a][b][m][n] = (f32x4){0.f, 0.f, 0.f, 0.f};
    bf16x8 At[4][2], B0[2][2], B1[2][2];
    const char* cA = (const char*)g.A + (size_t)cur.pm * tstep; const char* cB = (const char*)g.Bt + (size_t)cur.pn * tstep;
    S.a_ready(cur);
    if constexpr (SP2) {
        PG8_STAGE(PG8_SB(0, 0), cB, voffB); PG8_STAGE(PG8_SB(0, 1), cB + hstep, voffB); PG8_STAGE(PG8_SA(0, 0), cA, voffA); PG8_STAGE(PG8_SA(0, 1), cA + hstep, voffA);
        if (wr == 1) PG8_BAR;
        PG8_WAIT_V(2); PG8_BAR;
        PG8_STAGE(PG8_SB(1, 0), cB + kstep, voffB); PG8_STAGE(PG8_SA(1, 0), cA + kstep, voffA); PG8_STAGE(PG8_SB(1, 1), cB + hstep + kstep, voffB);
        PG8_WAIT_V(6); PG8_BAR;
    } else {
        PG8_STAGE(PG8_SB(0, 0), cB, voffB); PG8_STAGE(PG8_SA(0, 0), cA, voffA); PG8_STAGE(PG8_SB(0, 1), cB + hstep, voffB); PG8_STAGE(PG8_SA(0, 1), cA + hstep, voffA);
        if (wr == 1) PG8_BAR;
        PG8_WAIT_V(4); PG8_BAR;
        PG8_STAGE(PG8_SB(1, 0), cB + kstep, voffB); PG8_STAGE(PG8_SA(1, 0), cA + kstep, voffA); PG8_STAGE(PG8_SB(1, 1), cB + hstep + kstep, voffB);
        PG8_WAIT_V(6); PG8_BAR;
    }
    for (;;) {
        const bool has_next = S.next(ui + 1, nxt);
        const char* nA = has_next ? (const char*)g.A + (size_t)nxt.pm * tstep : cA; const char* nB = has_next ? (const char*)g.Bt + (size_t)nxt.pn * tstep : cB;
        for (int t = 0; t < nt; t += 2) {
            const bool last = (t == nt - 2);
            const char* a1 = cA + (size_t)(t + 1) * kstep;
            const char* a2 = last ? nA : cA + (size_t)(t + 2) * kstep; const char* b2 = last ? nB : cB + (size_t)(t + 2) * kstep;
            const char* a3 = a2 + kstep; const char* b3 = b2 + kstep;
            if (last && has_next) S.a_ready(nxt);
            if constexpr (SP2) {
            PG8_LDB(B0, 0, 0); PG8_LDB(B1, 0, 1); PG8_SCHED; PG8_LDA(At, 0, 0); PG8_STAGE(PG8_SA(1, 1), a1 + hstep, voffA);
            PG8_WAIT_V(8); PG8_WAIT_L(0); PG8_BAR; PG8_MMA(0, 0, At, B0); PG8_MMA(0, 1, At, B1); PG8_BAR; PG8_SCHED;
            PG8_LDA(At, 0, 1); PG8_STAGE(PG8_SB(0, 0), b2, voffB); PG8_STAGE(PG8_SB(0, 1), b2 + hstep, voffB); PG8_STAGE(PG8_SA(0, 0), a2, voffA);
            PG8_WAIT_V(8); PG8_WAIT_L(0); PG8_BAR; PG8_MMA(1, 0, At, B0); PG8_MMA(1, 1, At, B1); PG8_BAR; PG8_SCHED;
            PG8_LDB(B0, 1, 0); PG8_LDB(B1, 1, 1); PG8_SCHED; PG8_LDA(At, 1, 0); PG8_STAGE(PG8_SA(0, 1), a2 + hstep, voffA);
            PG8_WAIT_V(8); PG8_WAIT_L(0); PG8_BAR; PG8_MMA(0, 0, At, B0); PG8_MMA(0, 1, At, B1); PG8_BAR; PG8_SCHED;
            PG8_LDA(At, 1, 1); PG8_STAGE(PG8_SB(1, 0), b3, voffB); PG8_STAGE(PG8_SB(1, 1), b3 + hstep, voffB); PG8_STAGE(PG8_SA(1, 0), a3, voffA);
            PG8_WAIT_V(8); PG8_WAIT_L(0); PG8_BAR; PG8_MMA(1, 0, At, B0); PG8_MMA(1, 1, At, B1); PG8_BAR; PG8_SCHED;
            } else {
            PG8_LDB(B0, 0, 0); PG8_SCHED; PG8_LDA(At, 0, 0); PG8_STAGE(PG8_SA(1, 1), a1 + hstep, voffA);
            PG8_WAIT_L(8); PG8_BAR; PG8_WAIT_L(0); PG8_MMA(0, 0, At, B0); PG8_BAR; PG8_SCHED;
            PG8_LDB(B1, 0, 1); PG8_STAGE(PG8_SB(0, 0), b2, voffB);
            PG8_BAR; PG8_WAIT_L(0); PG8_MMA(0, 1, At, B1); PG8_BAR;
            PG8_LDA(At, 0, 1); PG8_STAGE(PG8_SA(0, 0), a2, voffA);
            PG8_BAR; PG8_WAIT_L(0); PG8_MMA(1, 0, At, B0); PG8_BAR; PG8_SCHED;
            PG8_STAGE(PG8_SB(0, 1), b2 + hstep, voffB);
            PG8_WAIT_V(6); PG8_BAR; PG8_MMA(1, 1, At, B1); PG8_BAR;
            PG8_LDB(B0, 1, 0); PG8_SCHED; PG8_LDA(At, 1, 0); PG8_STAGE(PG8_SA(0, 1), a2 + hstep, voffA);
            PG8_WAIT_L(8); PG8_BAR; PG8_WAIT_L(0); PG8_MMA(0, 0, At, B0); PG8_BAR; PG8_SCHED;
            PG8_LDB(B1, 1, 1); PG8_STAGE(PG8_SB(1, 0), b3, voffB);
            PG8_BAR; PG8_WAIT_L(0); PG8_MMA(0, 1, At, B1); PG8_BAR;
            PG8_LDA(At, 1, 1); PG8_STAGE(PG8_SA(1, 0), a3, voffA);
            PG8_BAR; PG8_WAIT_L(0); PG8_MMA(1, 0, At, B0); PG8_BAR; PG8_SCHED;
            PG8_STAGE(PG8_SB(1, 1), b3 + hstep, voffB);
            PG8_WAIT_V(6); PG8_BAR; PG8_MMA(1, 1, At, B1); PG8_BAR;
            }
        }
        if constexpr (ALIGN_EPI) { if (wr == 0) PG8_BAR; }
        if constexpr (!Epi::AFTER_DRAIN) { E(acc, cur, wr, wc, fr, fq); S.done(cur); }
        if (!has_next) break;
#pragma unroll
        for (int a = 0; a < 2; ++a)
#pragma unroll
            for (int b = 0; b < 2; ++b)
#pragma unroll
                for (int m = 0; m < 4; ++m)
#pragma unroll
                    for (int n = 0; n < 2; ++n) acc[a][b][m][n] = (f32x4){0.f, 0.f, 0.f, 0.f};
        cur = nxt; cA = nA; cB = nB; ++ui;
        if constexpr (ALIGN_EPI) { if (wr == 1) PG8_BAR; }
    }
    PG8_WAIT_V(0);
    if constexpr (!ALIGN_EPI) { if (wr == 0) PG8_BAR; }
    PG8_BAR;
    if constexpr (Epi::AFTER_DRAIN) { E.fused(acc, cur, wr, wc, fr, fq, lds, wid, lane); S.done(cur); }
#undef PG8_SA
#undef PG8_SB
#undef PG8_STAGE
#undef PG8_LDA
#undef PG8_LDB
#undef PG8_MMA
#undef PG8_WAIT_V
#undef PG8_WAIT_L
#undef PG8_BAR
#undef PG8_SCHED
}
}

#define DI __device__ __forceinline__
#define LAS __attribute__((address_space(3)))
typedef unsigned short bf16_t;
typedef short bf16x8 __attribute__((ext_vector_type(8)));
typedef short v4i16_t __attribute__((ext_vector_type(4)));
typedef float f32x2 __attribute__((ext_vector_type(2)));
typedef float f32x4 __attribute__((ext_vector_type(4)));
typedef float f32x16 __attribute__((ext_vector_type(16)));
typedef unsigned u32x2 __attribute__((ext_vector_type(2)));
typedef unsigned u32x4 __attribute__((ext_vector_type(4)));
typedef __bf16 bf16x2_t __attribute__((ext_vector_type(2)));

constexpr int DM = 1024, NBATCH = 32, TP = 2048, TSS = 64, PAST = 2048, HD = 64, NHA = 6, NHB = 6, NHC = 4;
constexpr int MP = NBATCH * TP, MS = NBATCH * TSS, MT = MP + MS;
constexpr int SHW = 1280, INC = 4230, NPAD = 4352;
constexpr int U_R = 0, U_K = 384, U_V = 768, U_WLO = 1152, U_ALO = 1216, U_GA = 1280, U_QB = 1664, U_KB = 2048, U_VB = 2432, U_GB = 2816,
              U_QC = 3200, U_KC = 3456, U_VC = 3712, U_GC = 3968, U_FB = 4224;
constexpr float ALPHA = 1.41421356237f;
constexpr float GN_EPS = 64e-5f, LN_EPS = 1e-5f;
constexpr float LOG2E = 1.4426950408889634f;
constexpr float QSCALE2 = 0.125f * LOG2E;

constexpr size_t O_YP = 0, O_YS = O_YP + (size_t)MP * DM, O_PFK = O_YS + (size_t)MS * DM, O_PFV = O_PFK + 2ull * MP * 384, O_PFL = O_PFV + 2ull * MP * 384,
                 O_PSK = O_PFL + 2ull * MP * 6, O_PSV = O_PSK + 2ull * MP * 256, O_PWKV = O_PSV + 2ull * MP * 256, O_PSH = O_PWKV + 2ull * 32 * 6 * 4096,
                 O_SFK = O_PSH + 2ull * 32 * 1280, O_SFV = O_SFK + 2ull * MS * 384, O_SFL = O_SFV + 2ull * MS * 384, O_SSK = O_SFL + 2ull * MS * 6,
                 O_SSV = O_SSK + 2ull * MS * 256, O_SWKV = O_SSV + 2ull * MS * 256, O_SSH = O_SWKV + 2ull * 32 * 6 * 4096, O_END = O_SSH + 2ull * 32 * 1280;
static_assert(O_END == 246341632ull, "output size");

constexpr size_t MiB = 1u << 20;
constexpr size_t WS_CTL = 0, CTL_BYTES = 4096, WS_WIN = 1 * MiB, WS_WOUT = 20 * MiB, WS_LOGF = 24 * MiB, WS_XB = 28 * MiB, WS_OB = 160 * MiB, WS_UB = 292 * MiB,
                 WS_BFK = WS_UB + (((size_t)MT * NPAD * 2 + MiB - 1) / MiB) * MiB,
                 BF_BYTES = (size_t)(32 * 6 * 66) * 4096, BS_BYTES = (size_t)(32 * 4 * 66) * 4096, WS_BFV = WS_BFK + BF_BYTES, WS_BSK = WS_BFV + BF_BYTES, WS_BSV = WS_BSK + BS_BYTES, WS_END = WS_BSV + BS_BYTES;
static_assert(WS_WIN + 2ull * NPAD * DM * 2 <= WS_WOUT && WS_WOUT + 2ull * DM * DM * 2 <= WS_LOGF && WS_LOGF + (size_t)MT * 8 * 4 <= WS_XB &&
              WS_XB + (size_t)MT * DM * 2 <= WS_OB && WS_OB + (size_t)MT * DM * 2 <= WS_UB && WS_END <= 1023 * MiB, "ws map");

constexpr int LDS_BYTES = 147456;
constexpr int WK_STRIDE = 8448;
constexpr int SC_OFF = 8 * WK_STRIDE;
constexpr int CH = 16;
constexpr int OPTOK = 384;
constexpr int OPBUF_BYTES = CH * OPTOK * 4;
constexpr int SC_OP = SC_OFF, SC_Y = SC_OP + 2 * OPBUF_BYTES, YBUF_BYTES = CH * 128 * 4  , SC_BON = SC_Y + 2 * YBUF_BYTES, SC_FLAGS = SC_BON + 2 * 64;
static_assert(SC_FLAGS + 64 <= LDS_BYTES, "scan LDS");
enum { F_PROD = 0, F_POST = 1, F_CONS = 2, F_PRODB = 6, F_POSTB = 7, F_SETUP = 8 };

struct Params { const float* in[24]; float* out; unsigned char* ws; int ph_lo, ph_hi, rep_ph, dbg; };
typedef const __attribute__((address_space(4))) Params* PP;
DI PP pp_launder(PP p) { asm volatile("" : "+s"(p)); return p; }

DI float bf2f(unsigned short h) { return __uint_as_float((unsigned)h << 16); }
DI float bflo(unsigned w) { return __uint_as_float(w << 16); }
DI float bfhi(unsigned w) { return __uint_as_float(w & 0xffff0000u); }
DI unsigned cvtpk(float lo, float hi) { f32x2 v = {lo, hi}; bf16x2_t b = __builtin_convertvector(v, bf16x2_t); return __builtin_bit_cast(unsigned, b); }
DI float fast_exp2(float x) { return __builtin_amdgcn_exp2f(x); }
DI float fast_rcp(float x) { return __builtin_amdgcn_rcpf(x); }
DI float sigmoidf_(float x) { return fast_rcp(1.f + fast_exp2(-LOG2E * x)); }
DI float siluf_(float x) { return x * sigmoidf_(x); }
DI float swap32_other(float x, float& mine_lo, float& mine_hi) { auto r = __builtin_amdgcn_permlane32_swap(__float_as_uint(x), __float_as_uint(x), false, false); mine_lo = __uint_as_float(r[0]); mine_hi = __uint_as_float(r[1]); return 0.f; }
DI float red4(float x) {
    auto a = __builtin_amdgcn_permlane16_swap(__float_as_uint(x), __float_as_uint(x), false, false);
    const float s = __uint_as_float(a[0]) + __uint_as_float(a[1]);
    auto b = __builtin_amdgcn_permlane32_swap(__float_as_uint(s), __float_as_uint(s), false, false);
    return __uint_as_float(b[0]) + __uint_as_float(b[1]);
}
template <int CTRL> DI float dpp_f(float x) { return __uint_as_float((unsigned)__builtin_amdgcn_update_dpp(0, (int)__float_as_uint(x), CTRL, 0xf, 0xf, false)); }
DI float red16(float x) {
    x += dpp_f<0x121>(x); x += dpp_f<0x122>(x); x += dpp_f<0x124>(x); x += dpp_f<0x128>(x); return x;
}
DI unsigned ld_flag(LAS unsigned* p) { return __hip_atomic_load(p, __ATOMIC_ACQUIRE, __HIP_MEMORY_SCOPE_WORKGROUP); }
DI void st_flag(LAS unsigned* p, unsigned v) { __hip_atomic_store(p, v, __ATOMIC_RELEASE, __HIP_MEMORY_SCOPE_WORKGROUP); }
DI void wait_ge(LAS unsigned* p, unsigned need) { while (ld_flag(p) < need) __builtin_amdgcn_s_sleep(1); }
DI int crow(int r, int hi) { return (r & 3) + 8 * (r >> 2) + 4 * hi; }
#define MFMA32(a, b, c) __builtin_amdgcn_mfma_f32_32x32x16_bf16((a), (b), (c), 0, 0, 0)
#define MFMA16(a, b, c) __builtin_amdgcn_mfma_f32_16x16x32_bf16((a), (b), (c), 0, 0, 0)

DI void p0_item(const float* W, int Nsrc, int kind, bf16_t* WT, LAS float* scr, int item, int nblk, int lane) {
    const int kb = item / nblk, nb = item % nblk, k0 = 64 * kb, n0 = 32 * nb;
    const int n = n0 + (lane & 31); int src = n; bool valid = true;
    if (kind == 0) { if (n < 2816) src = n; else if (n < 4224) src = n + 6; else if (n < 4230) src = n - 4224 + 2816; else { valid = false; src = 0; } }
#pragma unroll
    for (int i = 0; i < 32; ++i) { const int kk = 2 * i + (lane >> 5); scr[kk * 33 + (lane & 31)] = valid ? W[(size_t)(k0 + kk) * Nsrc + src] : 0.f; }
    asm volatile("s_waitcnt lgkmcnt(0)" ::: "memory");
    const int c = lane & 7;
#pragma unroll
    for (int j = 0; j < 4; ++j) { const int nn = (lane >> 3) + 8 * j; const LAS float* s = scr + (8 * c) * 33 + nn;
        u32x4 o; o.x = cvtpk(s[0 * 33], s[1 * 33]); o.y = cvtpk(s[2 * 33], s[3 * 33]); o.z = cvtpk(s[4 * 33], s[5 * 33]); o.w = cvtpk(s[6 * 33], s[7 * 33]);
        *(u32x4*)(WT + (size_t)(n0 + nn) * 1024 + k0 + 8 * c) = o; }
    asm volatile("s_waitcnt lgkmcnt(0)" ::: "memory");
}
DI void phase0(PP P, LAS unsigned char* lds, int wave, int lane, int bidx, int gdim) {
    LAS float* scr = (LAS float*)(lds + wave * 8448);
    const int gw = bidx * 8 + wave, NGW = gdim * 8;
    constexpr int I_IN = 16 * (NPAD / 32), I_OUT = 16 * 32, NITEMS = 2 * (I_IN + I_OUT);
    for (int it = gw; it < NITEMS; it += NGW) {
        int r = it; const int l = r / (I_IN + I_OUT); r -= l * (I_IN + I_OUT);
        if (r < I_IN) p0_item(P->in[9] + (size_t)l * DM * INC, INC, 0, (bf16_t*)(P->ws + WS_WIN) + (size_t)l * NPAD * DM, scr, r, NPAD / 32, lane);
        else p0_item(P->in[21] + (size_t)l * DM * DM, DM, 1, (bf16_t*)(P->ws + WS_WOUT) + (size_t)l * DM * DM, scr, r - I_IN, 32, lane);
    }
    bf16_t* xb = (bf16_t*)(P->ws + WS_XB);
    for (int m = gw; m < MT; m += NGW) {
        const float* xr = (m < MP) ? P->in[0] + (size_t)m * DM : P->in[1] + (size_t)(m - MP) * DM;
        const f32x4* x4 = (const f32x4*)xr + lane; u32x2* o = (u32x2*)(xb + (size_t)m * DM) + lane;
#pragma unroll
        for (int j = 0; j < 4; ++j) { const f32x4 v = x4[64 * j]; u32x2 w; w.x = cvtpk(v.x, v.y); w.y = cvtpk(v.z, v.w); o[64 * j] = w; }
    }
}

DI float log_sigmoid_f(float x) { return fminf(x, 0.f) - log1pf(expf(-fabsf(x))); }
struct EpiU {
    static constexpr bool PERM = true, AFTER_DRAIN = false;
    unsigned char* ws; float* out; const float* fb; int l, mode;
    DI void operator()(const pg8::f32x4 (&acc)[2][2][4][2], const pg8::Unit& u, int wr, int wc, int fr, int fq) const {
        const int row0 = u.pm * 256 + wr * 64 + fr;
        if (mode == 0) {
            bf16_t* U = (bf16_t*)(ws + WS_UB); float* logf = (float*)(ws + WS_LOGF);
#pragma unroll
            for (int bj = 0; bj < 2; ++bj) {
                const int ch = u.pn * 2 + bj, c0 = ch * 128 + wc * 32 + 8 * fq;
                int W = 0, cs = 0, isv = 0, NHx = 6; size_t op = 0, os = 0, wb = 0;
                if (ch >= 16 && ch < 19) { W = 384; cs = U_KB; op = O_PFK; os = O_SFK; wb = WS_BFK; }
                else if (ch >= 19 && ch < 22) { W = 384; cs = U_VB; op = O_PFV; os = O_SFV; wb = WS_BFV; isv = 1; }
                else if (ch == 27 || ch == 28) { W = 256; cs = U_KC; op = O_PSK; os = O_SSK; wb = WS_BSK; NHx = 4; }
                else if (ch == 29 || ch == 30) { W = 256; cs = U_VC; op = O_PSV; os = O_SSV; wb = WS_BSV; NHx = 4; isv = 1; }
                const int hh = (c0 - cs) >> 6, dd = (c0 - cs) & 63;
                const unsigned koff = (unsigned)((dd >> 4) * 1024 + ((dd >> 3) & 1) * 512), voff = (unsigned)((dd >> 5) * 2048 + ((dd & 31) >> 3) * 16);
                float* segp = out + op + (size_t)l * MP * W + (c0 - cs); float* segs = out + os + (size_t)l * MS * W + (c0 - cs);
#pragma unroll
                for (int ai = 0; ai < 2; ++ai)
#pragma unroll
                    for (int m = 0; m < 4; ++m) {
                        const int r = row0 + ai * 128 + m * 16;
                        const f32x4 v0 = acc[ai][bj][m][0], v1 = acc[ai][bj][m][1];
                        u32x4 w; w.x = cvtpk(v0[0], v0[1]); w.y = cvtpk(v0[2], v0[3]); w.z = cvtpk(v1[0], v1[1]); w.w = cvtpk(v1[2], v1[3]);
                        if (W) { float* d = (r < MP) ? segp + (size_t)r * W : segs + (size_t)(r - MP) * W; *(f32x4*)d = v0; *(f32x4*)(d + 4) = v1;
                            int bq, tq_, smp; if (r < MP) { bq = r >> 11; tq_ = r & 2047; smp = 0; } else { const int rs = r - MP; bq = rs >> 6; tq_ = rs & 63; smp = 1; }
                            const unsigned tix = smp ? (unsigned)(32 * NHx * 64 + (bq * NHx + hh) * 2 + (tq_ >> 5)) : (unsigned)((bq * NHx + hh) * 64 + (tq_ >> 5));
                            const int r32_ = tq_ & 31;
                            const unsigned off = isv ? voff + (unsigned)((r32_ >> 4) * 1024 + (r32_ & 15) * 64) : koff + (unsigned)(r32_ * 16);
                            *(u32x4*)(ws + wb + (size_t)tix * 4096 + off) = w; }
                        else if (ch != 33) *(u32x4*)(U + (size_t)r * NPAD + c0) = w;
                        if (ch < 10) {
                            if (r < MP) { if ((r & 2047) == 2047) { float* d = out + O_PSH + (size_t)(l * 32 + (r >> 11)) * SHW + c0; *(f32x4*)d = v0; *(f32x4*)(d + 4) = v1; } }
                            else { const int rs = r - MP; if ((rs & 63) == 63) { float* d = out + O_SSH + (size_t)(l * 32 + (rs >> 6)) * SHW + c0; *(f32x4*)d = v0; *(f32x4*)(d + 4) = v1; } }
                        }
                        if (ch == 33 && wc == 0 && fq == 0) {
                            float lf[6];
#pragma unroll
                            for (int h = 0; h < 6; ++h) { const float x = (h < 4 ? v0[h] : v1[h - 4]) + fb[h]; lf[h] = log_sigmoid_f(x); }
                            float* d = (r < MP) ? out + O_PFL + ((size_t)l * MP + r) * 6 : out + O_SFL + ((size_t)l * MS + (r - MP)) * 6;
#pragma unroll
                            for (int h = 0; h < 6; ++h) { d[h] = lf[h]; logf[(size_t)r * 8 + h] = lf[h]; }
                        }
                    }
            }
        } else {
            const bf16_t* X = (const bf16_t*)(ws + WS_XB); bf16_t* Z = (bf16_t*)(ws + WS_UB);
#pragma unroll
            for (int ai = 0; ai < 2; ++ai)
#pragma unroll
                for (int m = 0; m < 4; ++m) {
                    const size_t r = (size_t)(row0 + ai * 128 + m * 16);
#pragma unroll
                    for (int bj = 0; bj < 2; ++bj) {
                        const int c = u.pn * 256 + bj * 128 + wc * 32 + 8 * fq;
                        const u32x4 xw = *(const u32x4*)(X + r * DM + c);
                        f32x4 z0 = acc[ai][bj][m][0], z1 = acc[ai][bj][m][1];
                        z0[0] += ALPHA * bflo(xw.x); z0[1] += ALPHA * bfhi(xw.x); z0[2] += ALPHA * bflo(xw.y); z0[3] += ALPHA * bfhi(xw.y);
                        z1[0] += ALPHA * bflo(xw.z); z1[1] += ALPHA * bfhi(xw.z); z1[2] += ALPHA * bflo(xw.w); z1[3] += ALPHA * bfhi(xw.w);
                        u32x4 zw; zw.x = cvtpk(z0[0], z0[1]); zw.y = cvtpk(z0[2], z0[3]); zw.z = cvtpk(z1[0], z1[1]); zw.w = cvtpk(z1[2], z1[3]);
                        *(u32x4*)(Z + r * DM + c) = zw;
                    }
                }
        }
    }
};

DI float wave_sum(float v) {
#pragma unroll
    for (int o = 1; o < 64; o <<= 1) v += __shfl_xor(v, o);
    return v;
}
DI void phase_ln(PP P, int l, int wave, int lane, int bidx, int gdim) {
    const int gw = bidx * 8 + wave, NGW = gdim * 8;
    const bf16_t* Z = (const bf16_t*)(P->ws + WS_UB); bf16_t* xb = (bf16_t*)(P->ws + WS_XB);
    const f32x4* g4 = (const f32x4*)(P->in[22] + (size_t)l * DM) + lane; const f32x4* b4 = (const f32x4*)(P->in[23] + (size_t)l * DM) + lane;
    f32x4 g[4], bb[4];
#pragma unroll
    for (int j = 0; j < 4; ++j) { g[j] = g4[64 * j]; bb[j] = b4[64 * j]; }
    for (int m = gw; m < MT; m += NGW) {
        const u32x2* z4 = (const u32x2*)(Z + (size_t)m * DM) + lane;
        f32x4 v[4]; float s = 0.f;
#pragma unroll
        for (int j = 0; j < 4; ++j) { const u32x2 zz_ = z4[64 * j]; v[j] = (f32x4){bflo(zz_.x), bfhi(zz_.x), bflo(zz_.y), bfhi(zz_.y)}; s += (v[j].x + v[j].y) + (v[j].z + v[j].w); }
        const float mean = wave_sum(s) * (1.f / DM); float s2 = 0.f;
#pragma unroll
        for (int j = 0; j < 4; ++j) { v[j] = v[j] - mean; s2 += (v[j].x * v[j].x + v[j].y * v[j].y) + (v[j].z * v[j].z + v[j].w * v[j].w); }
        const float rstd = 1.f / sqrtf(wave_sum(s2) * (1.f / DM) + LN_EPS);
#pragma unroll
        for (int j = 0; j < 4; ++j) v[j] = v[j] * rstd * g[j] + bb[j];
        if (l == 0) { u32x2* o = (u32x2*)(xb + (size_t)m * DM) + lane;
#pragma unroll
            for (int j = 0; j < 4; ++j) { u32x2 w; w.x = cvtpk(v[j].x, v[j].y); w.y = cvtpk(v[j].z, v[j].w); o[64 * j] = w; } }
        else { f32x4* o = (f32x4*)(P->out + O_YP + (size_t)m * DM) + lane;
#pragma unroll
            for (int j = 0; j < 4; ++j) o[64 * j] = v[j]; }
    }
}

DI void scan_wave(PP P, int l, LAS unsigned char* lds, int wave, int lane, int seq0, int nseq, bool sample, int dbg, bool two = false) {
    const int row = wave * 16 + (lane & 15), kq = lane >> 4;
    LAS unsigned* flags = (LAS unsigned*)(lds + SC_FLAGS);
    unsigned cgl = 0;
    const int nch = sample ? TSS / CH : TP / CH;
    __builtin_amdgcn_s_setprio(3);
    for (int s = 0; s < nseq; ++s) {
        const int seq = seq0 + s, b = seq / 6, h = seq % 6;
        f32x4 S[4];
        if (sample) { const f32x4* sp = (const f32x4*)(P->in[7] + ((size_t)((l * 32 + b) * 6 + h) * 64 + row) * 64 + kq * 16);
#pragma unroll
            for (int i = 0; i < 4; ++i) S[i] = sp[i]; }
        else {
#pragma unroll
            for (int i = 0; i < 4; ++i) S[i] = (f32x4){0.f, 0.f, 0.f, 0.f}; }
        for (int c = 0; c < nch; ++c, ++cgl) {
            if (two) { wait_ge(&flags[(cgl & 1) ? F_PRODB : F_PROD], (cgl >> 1) + 1); if (cgl >= 2) wait_ge(&flags[(cgl & 1) ? F_POSTB : F_POST], cgl >> 1); }
            else { wait_ge(&flags[F_PROD], cgl + 1); if (cgl >= 2) wait_ge(&flags[F_POST], cgl - 1); }
            LAS const float* opb = (LAS const float*)(lds + SC_OP + (cgl & 1) * OPBUF_BYTES);
            LAS float* yb = (LAS float*)(lds + SC_Y + (cgl & 1) * YBUF_BYTES);
            LAS const float* bon = (LAS const float*)(lds + SC_BON + (cgl & 1) * 64);
            LAS const float* tp0 = opb + kq * 16; asm volatile("" : "+v"(tp0));
            LAS const float* vp0 = opb + 320 + row; asm volatile("" : "+v"(vp0));
            f32x4 w4[2][4], kk4[2][4], ka4[2][4], kp4[2][4], r4[2][4]; float vv[2], bt[2];
#define SC_LOAD(buf, t_) do { LAS const float* tp = tp0 + (t_) * OPTOK; \
                _Pragma("unroll") for (int i = 0; i < 4; ++i) { w4[buf][i] = *(LAS const f32x4*)(tp + 4 * i); kk4[buf][i] = *(LAS const f32x4*)(tp + 64 + 4 * i); ka4[buf][i] = *(LAS const f32x4*)(tp + 128 + 4 * i); \
                    kp4[buf][i] = *(LAS const f32x4*)(tp + 192 + 4 * i); r4[buf][i] = *(LAS const f32x4*)(tp + 256 + 4 * i); } \
                vv[buf] = vp0[(t_) * OPTOK]; bt[buf] = bon[t_]; } while (0)
            SC_LOAD(0, 0);
#pragma unroll
            for (int t = 0; t < CH; ++t) {
                if ((dbg & 8) && t >= 8) break;
                const int cb = t & 1, nb = cb ^ 1;
                if (t + 1 < CH) SC_LOAD(nb, t + 1);
                f32x4 a4 = S[0] * kk4[cb][0];
#pragma unroll
                for (int i = 1; i < 4; ++i) a4 += S[i] * kk4[cb][i];
                float sa = (a4[0] + a4[1]) + (a4[2] + a4[3]);
                sa = red4(sa);
                const float nsa = -sa;
                f32x4 y4 = (f32x4){0.f, 0.f, 0.f, 0.f};
#pragma unroll
                for (int i = 0; i < 4; ++i) { S[i] = S[i] * w4[cb][i] + nsa * ka4[cb][i] + vv[cb] * kp4[cb][i]; y4 += S[i] * r4[cb][i]; }
                float y = (y4[0] + y4[1]) + (y4[2] + y4[3]);
                y = red4(y);
                if (kq < 2) yb[t * 128 + kq * 64 + row] = kq == 0 ? y : bt[cb] * vv[cb];
            }
#undef SC_LOAD
            st_flag(&flags[F_CONS + wave], cgl + 1);
        }
        float* so = P->out + (sample ? O_SWKV : O_PWKV) + ((size_t)((l * 32 + b) * 6 + h) * 64 + row) * 64 + kq * 16;
        if (!(dbg & 256)) {
#pragma unroll
            for (int i = 0; i < 4; ++i) *(f32x4*)(so + 4 * i) = S[i]; }
    }
    __builtin_amdgcn_s_setprio(0);
}

constexpr int SC_CST = SC_FLAGS + 64, CST_BYTES = 10 * 64 * 4, RAWBUF = 16384;
static_assert(SC_CST + CST_BYTES <= LDS_BYTES && 2 * RAWBUF <= 4 * WK_STRIDE && 15 * 1024 <= RAWBUF, "prep LDS");
#define RAWOFF(R, sg, c) ((((sg) * 3 + ((R) >> 3)) * 1024) + (((R) & 7) * 128) + (c) * 2)
DI void prep_wave(PP P, int l, LAS unsigned char* lds, int lane, int seq0, int nseq, bool sample, int dbg) {
    const int fr = lane & 15, fq = lane >> 4;
    LAS unsigned* flags = (LAS unsigned*)(lds + SC_FLAGS);
    LAS float* cst = (LAS float*)(lds + SC_CST);
    const bf16_t* ub = (const bf16_t*)(P->ws + WS_UB);
    const float* mu = P->in[10] + (size_t)l * SHW;
    unsigned cgl = 0;
    const int nch = sample ? TSS / CH : TP / CH;
    const int c8 = lane & 7, rsub = lane >> 3;
    const unsigned goff = (unsigned)(rsub * NPAD + c8 * 8) * 2u;
    for (int s = 0; s < nseq; ++s) {
        const int seq = seq0 + s, b = seq / 6, h = seq % 6;
        const size_t m0 = sample ? (size_t)MP + (size_t)b * TSS : (size_t)b * TP;
        const float* sh0 = P->in[8] + (size_t)(l * 32 + b) * SHW;
        {
            const int kc = h * 64 + lane;
            cst[0 * 64 + lane] = mu[U_R + kc]; cst[1 * 64 + lane] = mu[U_K + kc]; cst[2 * 64 + lane] = mu[U_V + kc];
            cst[3 * 64 + lane] = P->in[11][(size_t)l * 384 + kc]; cst[4 * 64 + lane] = P->in[13][(size_t)l * 384 + kc]; cst[5 * 64 + lane] = P->in[15][(size_t)l * 384 + kc];
            cst[6 * 64 + lane] = P->in[16][(size_t)l * 384 + kc]; cst[7 * 64 + lane] = P->in[17][(size_t)l * 384 + kc];
            cst[8 * 64 + lane] = mu[U_WLO + lane]; cst[9 * 64 + lane] = mu[U_ALO + lane];
        }
        LAS unsigned char* btab = lds + 4 * WK_STRIDE;
        {
            LAS float* wst = (LAS float*)lds;
#pragma unroll
            for (int arr = 0; arr < 2; ++arr)
#pragma unroll
                for (int ks = 0; ks < 2; ++ks) {
                    const float* W = P->in[arr == 0 ? 12 : 14] + (size_t)l * 64 * 384 + (size_t)(32 * ks) * 384 + h * 64;
                    asm volatile("" ::: "memory");
#pragma unroll
                    for (int n = 0; n < 8; ++n) { const int row = (lane >> 4) + 4 * n; *(LAS f32x4*)(wst + row * 64 + (lane & 15) * 4) = *(const f32x4*)(W + (size_t)row * 384 + (lane & 15) * 4); }
                    asm volatile("" ::: "memory");
#pragma unroll
                    for (int j = 0; j < 4; ++j) { u32x4 pq;
#pragma unroll
                        for (int e = 0; e < 4; ++e) { const int k0 = 8 * fq + 2 * e; pq[e] = cvtpk(wst[k0 * 64 + 16 * j + fr], wst[(k0 + 1) * 64 + 16 * j + fr]); }
                        *(LAS u32x4*)(btab + (((arr * 4 + j) * 2 + ks) * 64 + lane) * 16) = pq; }
                    asm volatile("" ::: "memory");
                }
        }
        u32x4 pf[15];
#define PREP_FETCH(c_) do { const char* gb_ = (const char*)(ub + (m0 + (size_t)(c_) * CH - 1) * NPAD); \
            _Pragma("unroll") for (int sg = 0; sg < 5; ++sg) { const char* gs_ = gb_ + (sg < 3 ? (sg * 384 + h * 64) * 2 : (sg == 3 ? U_WLO * 2 : U_ALO * 2)); \
                _Pragma("unroll") for (int rg = 0; rg < 3; ++rg) { if (rg < 2 || rsub == 0) pf[sg * 3 + rg] = *(const u32x4*)(gs_ + (size_t)(rg * 8 * NPAD * 2) + goff); } } } while (0)
        asm volatile("s_waitcnt vmcnt(0) lgkmcnt(0)" ::: "memory");
        PREP_FETCH(0);
        for (int c = 0; c < nch; ++c, ++cgl) {
            if (dbg & 2) { if (cgl >= 2) { for (int j = 0; j < 4; ++j) wait_ge(&flags[F_CONS + j], cgl - 1); } st_flag(&flags[F_PROD], cgl + 1); continue; }
            const int t0 = c * CH;
            LAS unsigned char* raw = lds + (c & 1) * RAWBUF;
#pragma unroll
            for (int sg = 0; sg < 5; ++sg)
#pragma unroll
                for (int rg = 0; rg < 3; ++rg) { if (rg < 2 || rsub == 0) *(LAS u32x4*)(raw + (sg * 3 + rg) * 1024 + lane * 16) = pf[sg * 3 + rg]; }
            if (t0 == 0 && rsub == 0) {
#pragma unroll
                for (int sg = 0; sg < 5; ++sg) {
                    u32x4 v = (u32x4){0u, 0u, 0u, 0u};
                    if (sample) { const int col_ = (sg < 3 ? sg * 384 + h * 64 : (sg == 3 ? U_WLO : U_ALO)) + c8 * 8;
                        const f32x4 a = *(const f32x4*)(sh0 + col_), bq = *(const f32x4*)(sh0 + col_ + 4); v.x = cvtpk(a[0], a[1]); v.y = cvtpk(a[2], a[3]); v.z = cvtpk(bq[0], bq[1]); v.w = cvtpk(bq[2], bq[3]); }
                    *(LAS u32x4*)(raw + sg * 3 * 1024 + c8 * 16) = v;
                }
            }
            asm volatile("" ::: "memory");
            if (c + 1 < nch) PREP_FETCH(c + 1);
            int zz = 0; asm volatile("" : "+v"(zz));
            LAS const float* cz = cst + zz;
            f32x4 Dw[4], Da[4];
            {
                bf16x8 Aw[2], Aa[2];
#pragma unroll
                for (int ks = 0; ks < 2; ++ks) {
                    const u32x4 cw = *(LAS const u32x4*)(raw + RAWOFF(fr + 1, 3, 32 * ks + 8 * fq)), pwv = *(LAS const u32x4*)(raw + RAWOFF(fr, 3, 32 * ks + 8 * fq));
                    const u32x4 ca = *(LAS const u32x4*)(raw + RAWOFF(fr + 1, 4, 32 * ks + 8 * fq)), pav = *(LAS const u32x4*)(raw + RAWOFF(fr, 4, 32 * ks + 8 * fq));
                    const f32x4 mw0 = *(LAS const f32x4*)(cz + 8 * 64 + 32 * ks + 8 * fq), mw1 = *(LAS const f32x4*)(cz + 8 * 64 + 32 * ks + 8 * fq + 4);
                    const f32x4 ma0 = *(LAS const f32x4*)(cz + 9 * 64 + 32 * ks + 8 * fq), ma1 = *(LAS const f32x4*)(cz + 9 * 64 + 32 * ks + 8 * fq + 4);
                    u32x4 pw, pa;
#pragma unroll
                    for (int e = 0; e < 4; ++e) {
                        const float c0 = bflo(cw[e]), c1 = bfhi(cw[e]), p0 = bflo(pwv[e]), p1 = bfhi(pwv[e]);
                        const float m0_ = (e < 2 ? mw0[2 * e] : mw1[2 * e - 4]), m1_ = (e < 2 ? mw0[2 * e + 1] : mw1[2 * e - 3]);
                        const float z0 = c0 + (p0 - c0) * m0_, z1 = c1 + (p1 - c1) * m1_;
                        const float t0_ = 1.f - 2.f * fast_rcp(1.f + fast_exp2(2.f * LOG2E * z0)), t1_ = 1.f - 2.f * fast_rcp(1.f + fast_exp2(2.f * LOG2E * z1));
                        pw[e] = cvtpk(t0_, t1_);
                        const float d0 = bflo(ca[e]), d1 = bfhi(ca[e]), q0 = bflo(pav[e]), q1 = bfhi(pav[e]);
                        const float n0_ = (e < 2 ? ma0[2 * e] : ma1[2 * e - 4]), n1_ = (e < 2 ? ma0[2 * e + 1] : ma1[2 * e - 3]);
                        pa[e] = cvtpk(d0 + (q0 - d0) * n0_, d1 + (q1 - d1) * n1_);
                    }
                    Aw[ks] = __builtin_bit_cast(bf16x8, pw); Aa[ks] = __builtin_bit_cast(bf16x8, pa);
                }
#pragma unroll
                for (int j = 0; j < 4; ++j) {
                    const f32x4 z = (f32x4){0.f, 0.f, 0.f, 0.f};
                    LAS const unsigned char* bt = btab + zz + lane * 16;
                    Dw[j] = MFMA16(Aw[0], *(LAS const bf16x8*)(bt + ((0 * 4 + j) * 2 + 0) * 1024), z); Dw[j] = MFMA16(Aw[1], *(LAS const bf16x8*)(bt + ((0 * 4 + j) * 2 + 1) * 1024), Dw[j]);
                    Da[j] = MFMA16(Aa[0], *(LAS const bf16x8*)(bt + ((1 * 4 + j) * 2 + 0) * 1024), z); Da[j] = MFMA16(Aa[1], *(LAS const bf16x8*)(bt + ((1 * 4 + j) * 2 + 1) * 1024), Da[j]);
                }
            }
            if (cgl >= 2) {
#pragma unroll
                for (int j = 0; j < 4; ++j) wait_ge(&flags[F_CONS + j], cgl - 1);
            }
            LAS float* opb = (LAS float*)(lds + SC_OP + (cgl & 1) * OPBUF_BYTES);
            LAS float* bon = (LAS float*)(lds + SC_BON + (cgl & 1) * 64);
#pragma unroll
            for (int i = 0; i < 4; ++i) {
                const int tl = 4 * fq + i; LAS const unsigned char* rc = raw + RAWOFF(tl + 1, 0, fr); LAS const unsigned char* rp = raw + RAWOFF(tl, 0, fr);
#define RB(p_, sg_, j_) bf2f(*(LAS const bf16_t*)((p_) + (sg_) * 3072 + (j_) * 32))
                float rr[4], kk[4], vv[4], aa[4], ww[4], kn[4]; float ss = 0.f;
#pragma unroll
                for (int j = 0; j < 4; ++j) {
                    const float cr = RB(rc, 0, j), ck = RB(rc, 1, j), cv = RB(rc, 2, j);
                    const float pr = RB(rp, 0, j), pk = RB(rp, 1, j), pv_ = RB(rp, 2, j);
                    rr[j] = cr + (pr - cr) * cz[0 * 64 + 16 * j + fr]; kk[j] = ck + (pk - ck) * cz[1 * 64 + 16 * j + fr]; vv[j] = cv + (pv_ - cv) * cz[2 * 64 + 16 * j + fr];
                    const float x = cz[3 * 64 + 16 * j + fr] + Dw[j][i];
                    const float sg = fast_rcp(1.f + fast_exp2(-LOG2E * x));
                    ww[j] = fast_exp2(-0.60653066f * LOG2E * sg);
                    aa[j] = fast_rcp(1.f + fast_exp2(-LOG2E * (cz[4 * 64 + 16 * j + fr] + Da[j][i])));
                    kn[j] = kk[j] * cz[5 * 64 + 16 * j + fr]; ss += kn[j] * kn[j];
                }
                ss = red16(ss);
                const float rn = 1.f / sqrtf(ss + 1e-12f);
                float bs = 0.f; LAS float* o = opb + tl * OPTOK + fr;
#pragma unroll
                for (int j = 0; j < 4; ++j) {
                    const float knn = kn[j] * rn, kp = kk[j] * (1.f + (aa[j] - 1.f) * cz[6 * 64 + 16 * j + fr]);
                    bs += rr[j] * kp * cz[7 * 64 + 16 * j + fr];
                    o[16 * j] = ww[j]; o[64 + 16 * j] = knn; o[128 + 16 * j] = knn * aa[j]; o[192 + 16 * j] = kp; o[256 + 16 * j] = rr[j]; o[320 + 16 * j] = vv[j];
                }
                bs = red16(bs);
                if (fr == 0) bon[tl] = bs;
#undef RB
            }
            st_flag(&flags[F_PROD], cgl + 1);
        }
#undef PREP_FETCH
    }
}

DI void helper2_wave(PP P, int l, LAS unsigned char* lds, int lane, int seq0, int par, int dbg) {
    const int nseq = 1; const bool sample = false;
    const int fr = lane & 15, fq = lane >> 4;
    LAS unsigned* flags = (LAS unsigned*)(lds + SC_FLAGS);
    LAS float* cst = (LAS float*)(lds + SC_CST);
    const bf16_t* ub = (const bf16_t*)(P->ws + WS_UB);
    const float* mu = P->in[10] + (size_t)l * SHW;
    unsigned cgl = 0;
    const int nch = sample ? TSS / CH : TP / CH;
    const int c8 = lane & 7, rsub = lane >> 3;
    const unsigned goff = (unsigned)(rsub * NPAD + c8 * 8) * 2u;
    for (int s = 0; s < nseq; ++s) {
        const int seq = seq0 + s, b = seq / 6, h = seq % 6;
        const size_t m0 = sample ? (size_t)MP + (size_t)b * TSS : (size_t)b * TP;
        const float* sh0 = P->in[8] + (size_t)(l * 32 + b) * SHW;
        if (par == 0) {
            const int kc = h * 64 + lane;
            cst[0 * 64 + lane] = mu[U_R + kc]; cst[1 * 64 + lane] = mu[U_K + kc]; cst[2 * 64 + lane] = mu[U_V + kc];
            cst[3 * 64 + lane] = P->in[11][(size_t)l * 384 + kc]; cst[4 * 64 + lane] = P->in[13][(size_t)l * 384 + kc]; cst[5 * 64 + lane] = P->in[15][(size_t)l * 384 + kc];
            cst[6 * 64 + lane] = P->in[16][(size_t)l * 384 + kc]; cst[7 * 64 + lane] = P->in[17][(size_t)l * 384 + kc];
            cst[8 * 64 + lane] = mu[U_WLO + lane]; cst[9 * 64 + lane] = mu[U_ALO + lane];
        }
        LAS unsigned char* btab = lds + 4 * WK_STRIDE;
        if (par == 0) {
            LAS float* wst = (LAS float*)lds;
#pragma unroll
            for (int arr = 0; arr < 2; ++arr)
#pragma unroll
                for (int ks = 0; ks < 2; ++ks) {
                    const float* W = P->in[arr == 0 ? 12 : 14] + (size_t)l * 64 * 384 + (size_t)(32 * ks) * 384 + h * 64;
                    asm volatile("" ::: "memory");
#pragma unroll
                    for (int n = 0; n < 8; ++n) { const int row = (lane >> 4) + 4 * n; *(LAS f32x4*)(wst + row * 64 + (lane & 15) * 4) = *(const f32x4*)(W + (size_t)row * 384 + (lane & 15) * 4); }
                    asm volatile("" ::: "memory");
#pragma unroll
                    for (int j = 0; j < 4; ++j) { u32x4 pq;
#pragma unroll
                        for (int e = 0; e < 4; ++e) { const int k0 = 8 * fq + 2 * e; pq[e] = cvtpk(wst[k0 * 64 + 16 * j + fr], wst[(k0 + 1) * 64 + 16 * j + fr]); }
                        *(LAS u32x4*)(btab + (((arr * 4 + j) * 2 + ks) * 64 + lane) * 16) = pq; }
                    asm volatile("" ::: "memory");
                }
        }
        u32x4 pf[15];
#define PREP_FETCH(c_) do { const char* gb_ = (const char*)(ub + (m0 + (size_t)(c_) * CH - 1) * NPAD); \
            _Pragma("unroll") for (int sg = 0; sg < 5; ++sg) { const char* gs_ = gb_ + (sg < 3 ? (sg * 384 + h * 64) * 2 : (sg == 3 ? U_WLO * 2 : U_ALO * 2)); \
                _Pragma("unroll") for (int rg = 0; rg < 3; ++rg) { if (rg < 2 || rsub == 0) pf[sg * 3 + rg] = *(const u32x4*)(gs_ + (size_t)(rg * 8 * NPAD * 2) + goff); } } } while (0)
        asm volatile("s_waitcnt vmcnt(0) lgkmcnt(0)" ::: "memory");
        if (par == 0) st_flag(&flags[F_SETUP], 1u); else wait_ge(&flags[F_SETUP], 1u);
        const f32x4 pg4 = *(const f32x4*)(P->in[18] + (size_t)l * 384 + h * 64 + 4 * fr), pb4 = *(const f32x4*)(P->in[19] + (size_t)l * 384 + h * 64 + 4 * fr);
        bf16_t* obp = (bf16_t*)(P->ws + WS_OB);
#define POST_CHUNK(cl_) do { const unsigned cg_ = (unsigned)(cl_); \
            u32x2 gwv_[4]; \
            _Pragma("unroll") for (int i = 0; i < 4; ++i) gwv_[i] = *(const u32x2*)(ub + (m0 + (cl_) * CH + 4 * i + fq) * NPAD + U_GA + h * 64 + 4 * fr); \
            _Pragma("unroll") for (int j = 0; j < 4; ++j) wait_ge(&flags[F_CONS + j], cg_ + 1); \
            LAS const float* yb_ = (LAS const float*)(lds + SC_Y + par * YBUF_BYTES); \
            f32x4 yv_[4], bv_[4]; \
            _Pragma("unroll") for (int i = 0; i < 4; ++i) { const int tl_ = 4 * i + fq; yv_[i] = *(LAS const f32x4*)(yb_ + tl_ * 128 + 4 * fr); bv_[i] = *(LAS const f32x4*)(yb_ + tl_ * 128 + 64 + 4 * fr); } \
            st_flag(&flags[par ? F_POSTB : F_POST], (cg_ >> 1) + 1); \
            _Pragma("unroll") for (int i = 0; i < 4; ++i) { const size_t m_ = m0 + (cl_) * CH + 4 * i + fq; \
                const f32x4 y4_ = yv_[i]; \
                const float mean_ = red16((y4_[0] + y4_[1]) + (y4_[2] + y4_[3])) * (1.f / 64.f); \
                const f32x4 d_ = y4_ - mean_; \
                const float var_ = red16((d_[0] * d_[0] + d_[1] * d_[1]) + (d_[2] * d_[2] + d_[3] * d_[3])) * (1.f / 64.f); \
                const float rstd_ = __builtin_amdgcn_rsqf(var_ + GN_EPS); \
                f32x4 o_ = d_ * rstd_ * pg4 + pb4 + bv_[i]; \
                o_[0] *= siluf_(bflo(gwv_[i].x)); o_[1] *= siluf_(bfhi(gwv_[i].x)); o_[2] *= siluf_(bflo(gwv_[i].y)); o_[3] *= siluf_(bfhi(gwv_[i].y)); \
                u32x2 w_; w_.x = cvtpk(o_[0], o_[1]); w_.y = cvtpk(o_[2], o_[3]); \
                if (!(dbg & 256)) *(u32x2*)(obp + m_ * DM + h * 64 + 4 * fr) = w_; } } while (0)
        float cr_[8][4];
        f32x4 lmu_[2][4];
#pragma unroll
        for (int ks = 0; ks < 2; ++ks) { lmu_[ks][0] = *(LAS const f32x4*)(cst + 8 * 64 + 32 * ks + 8 * fq); lmu_[ks][1] = *(LAS const f32x4*)(cst + 8 * 64 + 32 * ks + 8 * fq + 4);
            lmu_[ks][2] = *(LAS const f32x4*)(cst + 9 * 64 + 32 * ks + 8 * fq); lmu_[ks][3] = *(LAS const f32x4*)(cst + 9 * 64 + 32 * ks + 8 * fq + 4); }
#pragma unroll
        for (int a_ = 0; a_ < 8; ++a_)
#pragma unroll
            for (int j = 0; j < 4; ++j) cr_[a_][j] = cst[a_ * 64 + 16 * j + fr];
        PREP_FETCH(par);
        for (int c = par; c < nch; c += 2) { cgl = (unsigned)c;
            const int t0 = c * CH;
            LAS unsigned char* raw = lds + par * RAWBUF;
#pragma unroll
            for (int sg = 0; sg < 5; ++sg)
#pragma unroll
                for (int rg = 0; rg < 3; ++rg) { if (rg < 2 || rsub == 0) *(LAS u32x4*)(raw + (sg * 3 + rg) * 1024 + lane * 16) = pf[sg * 3 + rg]; }
            if (t0 == 0 && rsub == 0) {
#pragma unroll
                for (int sg = 0; sg < 5; ++sg) {
                    u32x4 v = (u32x4){0u, 0u, 0u, 0u};
                    if (sample) { const int col_ = (sg < 3 ? sg * 384 + h * 64 : (sg == 3 ? U_WLO : U_ALO)) + c8 * 8;
                        const f32x4 a = *(const f32x4*)(sh0 + col_), bq = *(const f32x4*)(sh0 + col_ + 4); v.x = cvtpk(a[0], a[1]); v.y = cvtpk(a[2], a[3]); v.z = cvtpk(bq[0], bq[1]); v.w = cvtpk(bq[2], bq[3]); }
                    *(LAS u32x4*)(raw + sg * 3 * 1024 + c8 * 16) = v;
                }
            }
            asm volatile("" ::: "memory");
            if (c + 2 < nch) PREP_FETCH(c + 2);
            int zz = 0; asm volatile("" : "+v"(zz));
            LAS const float* cz = cst + zz;
            f32x4 Dw[4], Da[4];
            {
                bf16x8 Aw[2], Aa[2];
#pragma unroll
                for (int ks = 0; ks < 2; ++ks) {
                    const u32x4 cw = *(LAS const u32x4*)(raw + RAWOFF(fr + 1, 3, 32 * ks + 8 * fq)), pwv = *(LAS const u32x4*)(raw + RAWOFF(fr, 3, 32 * ks + 8 * fq));
                    const u32x4 ca = *(LAS const u32x4*)(raw + RAWOFF(fr + 1, 4, 32 * ks + 8 * fq)), pav = *(LAS const u32x4*)(raw + RAWOFF(fr, 4, 32 * ks + 8 * fq));
                    const f32x4 mw0 = lmu_[ks][0], mw1 = lmu_[ks][1], ma0 = lmu_[ks][2], ma1 = lmu_[ks][3];
                    u32x4 pw, pa;
#pragma unroll
                    for (int e = 0; e < 4; ++e) {
                        const float c0 = bflo(cw[e]), c1 = bfhi(cw[e]), p0 = bflo(pwv[e]), p1 = bfhi(pwv[e]);
                        const float m0_ = (e < 2 ? mw0[2 * e] : mw1[2 * e - 4]), m1_ = (e < 2 ? mw0[2 * e + 1] : mw1[2 * e - 3]);
                        const float z0 = c0 + (p0 - c0) * m0_, z1 = c1 + (p1 - c1) * m1_;
                        const float t0_ = 1.f - 2.f * fast_rcp(1.f + fast_exp2(2.f * LOG2E * z0)), t1_ = 1.f - 2.f * fast_rcp(1.f + fast_exp2(2.f * LOG2E * z1));
                        pw[e] = cvtpk(t0_, t1_);
                        const float d0 = bflo(ca[e]), d1 = bfhi(ca[e]), q0 = bflo(pav[e]), q1 = bfhi(pav[e]);
                        const float n0_ = (e < 2 ? ma0[2 * e] : ma1[2 * e - 4]), n1_ = (e < 2 ? ma0[2 * e + 1] : ma1[2 * e - 3]);
                        pa[e] = cvtpk(d0 + (q0 - d0) * n0_, d1 + (q1 - d1) * n1_);
                    }
                    Aw[ks] = __builtin_bit_cast(bf16x8, pw); Aa[ks] = __builtin_bit_cast(bf16x8, pa);
                }
#pragma unroll
                for (int j = 0; j < 4; ++j) {
                    const f32x4 z = (f32x4){0.f, 0.f, 0.f, 0.f};
                    LAS const unsigned char* bt = btab + zz + lane * 16;
                    Dw[j] = MFMA16(Aw[0], *(LAS const bf16x8*)(bt + ((0 * 4 + j) * 2 + 0) * 1024), z); Dw[j] = MFMA16(Aw[1], *(LAS const bf16x8*)(bt + ((0 * 4 + j) * 2 + 1) * 1024), Dw[j]);
                    Da[j] = MFMA16(Aa[0], *(LAS const bf16x8*)(bt + ((1 * 4 + j) * 2 + 0) * 1024), z); Da[j] = MFMA16(Aa[1], *(LAS const bf16x8*)(bt + ((1 * 4 + j) * 2 + 1) * 1024), Da[j]);
                }
            }
            if (cgl >= 2) {
#pragma unroll
                for (int j = 0; j < 4; ++j) wait_ge(&flags[F_CONS + j], cgl - 1);
            }
            LAS float* opb = (LAS float*)(lds + SC_OP + (cgl & 1) * OPBUF_BYTES);
            LAS float* bon = (LAS float*)(lds + SC_BON + (cgl & 1) * 64);
            float lr_[4], lk_[4], lv_[4];
#pragma unroll
            for (int i = 0; i < 4; ++i) {
                const int tl = 4 * fq + i; LAS const unsigned char* rc = raw + RAWOFF(tl + 1, 0, fr); LAS const unsigned char* rp = raw + RAWOFF(tl, 0, fr);
#define RB(p_, sg_, j_) bf2f(*(LAS const bf16_t*)((p_) + (sg_) * 3072 + (j_) * 32))
                float rr[4], kk[4], vv[4], aa[4], ww[4], kn[4]; float ss = 0.f;
#pragma unroll
                for (int j = 0; j < 4; ++j) {
                    const float cr = RB(rc, 0, j), ck = RB(rc, 1, j), cv = RB(rc, 2, j);
                    const float pr = i == 0 ? RB(rp, 0, j) : lr_[j], pk = i == 0 ? RB(rp, 1, j) : lk_[j], pv_ = i == 0 ? RB(rp, 2, j) : lv_[j];
                    lr_[j] = cr; lk_[j] = ck; lv_[j] = cv;
                    rr[j] = cr + (pr - cr) * cr_[0][j]; kk[j] = ck + (pk - ck) * cr_[1][j]; vv[j] = cv + (pv_ - cv) * cr_[2][j];
                    const float x = cr_[3][j] + Dw[j][i];
                    const float sg = fast_rcp(1.f + fast_exp2(-LOG2E * x));
                    ww[j] = fast_exp2(-0.60653066f * LOG2E * sg);
                    aa[j] = fast_rcp(1.f + fast_exp2(-LOG2E * (cr_[4][j] + Da[j][i])));
                    kn[j] = kk[j] * cr_[5][j]; ss += kn[j] * kn[j];
                }
                ss = red16(ss);
                const float rn = __builtin_amdgcn_rsqf(ss + 1e-12f);
                float bs = 0.f; LAS float* o = opb + tl * OPTOK + fr;
#pragma unroll
                for (int j = 0; j < 4; ++j) {
                    const float knn = kn[j] * rn, kp = kk[j] * (1.f + (aa[j] - 1.f) * cr_[6][j]);
                    bs += rr[j] * kp * cr_[7][j];
                    o[16 * j] = ww[j]; o[64 + 16 * j] = knn; o[128 + 16 * j] = knn * aa[j]; o[192 + 16 * j] = kp; o[256 + 16 * j] = rr[j]; o[320 + 16 * j] = vv[j];
                }
                bs = red16(bs);
                if (fr == 0) bon[tl] = bs;
#undef RB
            }
            st_flag(&flags[par ? F_PRODB : F_PROD], (cgl >> 1) + 1);
            if (c >= 2) POST_CHUNK(c - 2);
        }
        POST_CHUNK(nch - 2 + par);
        wait_ge(&flags[par ? F_PROD : F_PRODB], (unsigned)(nch / 2));
#undef POST_CHUNK
#undef PREP_FETCH
    }
}

DI void prep_simple(PP P, int l, LAS unsigned char* lds, int lane, int seq0, int nseq, bool sample, int dbg) {
    LAS unsigned* flags = (LAS unsigned*)(lds + SC_FLAGS);
    LAS float* Wd = (LAS float*)lds; LAS float* Wa = Wd + 4096;
    LAS float* lor = (LAS float*)(lds + 4 * WK_STRIDE);
    const bf16_t* ub = (const bf16_t*)(P->ws + WS_UB);
    const float* mu = P->in[10] + (size_t)l * SHW;
    unsigned cgl = 0;
    const int nch = sample ? TSS / CH : TP / CH;
    for (int s = 0; s < nseq; ++s) {
        const int seq = seq0 + s, b = seq / 6, h = seq % 6;
        const int kc = h * 64 + lane;
        const float mur = mu[U_R + kc], muk = mu[U_K + kc], muv = mu[U_V + kc], muw = mu[U_WLO + lane], mua = mu[U_ALO + lane];
        const float w0c = P->in[11][(size_t)l * 384 + kc], a0c = P->in[13][(size_t)l * 384 + kc], kkc = P->in[15][(size_t)l * 384 + kc], kac = P->in[16][(size_t)l * 384 + kc], rkc = P->in[17][(size_t)l * 384 + kc];
        const size_t m0 = sample ? (size_t)MP + (size_t)b * TSS : (size_t)b * TP;
        const int T = sample ? TSS : TP;
        const float* sh0 = P->in[8] + (size_t)(l * 32 + b) * SHW;
        { const float* wd = P->in[12] + (size_t)l * 64 * 384 + kc; const float* wa = P->in[14] + (size_t)l * 64 * 384 + kc;
#pragma unroll 4
          for (int i = 0; i < 64; ++i) { Wd[i * 64 + lane] = wd[(size_t)i * 384]; Wa[i * 64 + lane] = wa[(size_t)i * 384]; } }
        float pr = sample ? sh0[U_R + kc] : 0.f, pk = sample ? sh0[U_K + kc] : 0.f, pv = sample ? sh0[U_V + kc] : 0.f, pwl = sample ? sh0[U_WLO + lane] : 0.f, pal = sample ? sh0[U_ALO + lane] : 0.f;
        const bf16_t* row = ub + m0 * NPAD;
        unsigned short n_r = row[U_R + kc], n_k = row[U_K + kc], n_v = row[U_V + kc], n_wl = row[U_WLO + lane], n_al = row[U_ALO + lane];
        for (int c = 0; c < nch; ++c, ++cgl) {
            if (cgl >= 2) {
#pragma unroll
                for (int j = 0; j < 4; ++j) wait_ge(&flags[F_CONS + j], cgl - 1);
            }
            LAS float* opb = (LAS float*)(lds + SC_OP + (cgl & 1) * OPBUF_BYTES);
            LAS float* bon = (LAS float*)(lds + SC_BON + (cgl & 1) * 64);
#pragma unroll 1
            for (int tl = 0; tl < CH; ++tl) {
                const int t = c * CH + tl;
                const float cr = bf2f(n_r), ck = bf2f(n_k), cv = bf2f(n_v), cwl = bf2f(n_wl), cal = bf2f(n_al);
                { const bf16_t* nrow = ub + (m0 + (t + 1 < T ? t + 1 : t)) * NPAD;
                  n_r = nrow[U_R + kc]; n_k = nrow[U_K + kc]; n_v = nrow[U_V + kc]; n_wl = nrow[U_WLO + lane]; n_al = nrow[U_ALO + lane]; }
                const float r = cr + (pr - cr) * mur, k = ck + (pk - ck) * muk, v = cv + (pv - cv) * muv, zw = cwl + (pwl - cwl) * muw, za = cal + (pal - cal) * mua;
                pr = cr; pk = ck; pv = cv; pwl = cwl; pal = cal;
                lor[lane] = 1.f - 2.f * fast_rcp(1.f + fast_exp2(2.f * LOG2E * zw)); lor[64 + lane] = za;
                float dw = 0.f, da = 0.f;
#pragma unroll 2
                for (int i = 0; i < 64; i += 4) { const f32x4 tw = *(LAS const f32x4*)(lor + i), ta = *(LAS const f32x4*)(lor + 64 + i);
#pragma unroll
                    for (int e = 0; e < 4; ++e) { dw += tw[e] * Wd[(i + e) * 64 + lane]; da += ta[e] * Wa[(i + e) * 64 + lane]; } }
                const float x = w0c + dw;
                const float sg = fast_rcp(1.f + fast_exp2(-LOG2E * x));
                const float w = fast_exp2(-0.60653066f * LOG2E * sg);
                const float a = fast_rcp(1.f + fast_exp2(-LOG2E * (a0c + da)));
                const float kn = k * kkc; const float ss = wave_sum(kn * kn);
                const float knn = kn * (1.f / sqrtf(ss + 1e-12f));
                const float kp = k * (1.f + (a - 1.f) * kac);
                const float bs = wave_sum(r * kp * rkc);
                LAS float* o = opb + tl * OPTOK + lane;
                o[0] = w; o[64] = knn; o[128] = knn * a; o[192] = kp; o[256] = r; o[320] = v;
                if (lane == 0) bon[tl] = bs;
            }
            st_flag(&flags[F_PROD], cgl + 1);
        }
    }
}

DI void post_wave(PP P, int l, LAS unsigned char* lds, int lane, int seq0, int nseq, bool sample, int dbg) {
    const int r16 = lane & 15, tq = lane >> 4;
    LAS unsigned* flags = (LAS unsigned*)(lds + SC_FLAGS);
    const bf16_t* ub = (const bf16_t*)(P->ws + WS_UB); bf16_t* ob = (bf16_t*)(P->ws + WS_OB);
    unsigned cgl = 0;
    const int nch = sample ? TSS / CH : TP / CH;
    for (int s = 0; s < nseq; ++s) {
        const int seq = seq0 + s, b = seq / 6, h = seq % 6;
        const size_t m0 = sample ? (size_t)MP + (size_t)b * TSS : (size_t)b * TP;
        const f32x4 g4 = *(const f32x4*)(P->in[18] + (size_t)l * 384 + h * 64 + 4 * r16), b4 = *(const f32x4*)(P->in[19] + (size_t)l * 384 + h * 64 + 4 * r16);
        for (int c = 0; c < nch; ++c, ++cgl) {
            if (dbg & 1) { for (int j = 0; j < 4; ++j) wait_ge(&flags[F_CONS + j], cgl + 1); st_flag(&flags[F_POST], cgl + 1); continue; }
            u32x2 gwv[4];
#pragma unroll
            for (int i = 0; i < 4; ++i) gwv[i] = *(const u32x2*)(ub + (m0 + c * CH + 4 * i + tq) * NPAD + U_GA + h * 64 + 4 * r16);
#pragma unroll
            for (int j = 0; j < 4; ++j) wait_ge(&flags[F_CONS + j], cgl + 1);
            LAS const float* yb = (LAS const float*)(lds + SC_Y + (cgl & 1) * YBUF_BYTES);
#pragma unroll
            for (int i = 0; i < 4; ++i) {
                const int tl = 4 * i + tq; const size_t m = m0 + c * CH + tl;
                const f32x4 y4 = *(LAS const f32x4*)(yb + tl * 128 + 4 * r16), bv4 = *(LAS const f32x4*)(yb + tl * 128 + 64 + 4 * r16);
                const u32x2 gw = gwv[i];
                const float mean = red16((y4[0] + y4[1]) + (y4[2] + y4[3])) * (1.f / 64.f);
                const f32x4 d = y4 - mean;
                const float var = red16((d[0] * d[0] + d[1] * d[1]) + (d[2] * d[2] + d[3] * d[3])) * (1.f / 64.f);
                const float rstd = 1.f / sqrtf(var + GN_EPS);
                f32x4 o = d * rstd * g4 + b4 + bv4;
                o[0] *= siluf_(bflo(gw.x)); o[1] *= siluf_(bfhi(gw.x)); o[2] *= siluf_(bflo(gw.y)); o[3] *= siluf_(bfhi(gw.y));
                u32x2 w; w.x = cvtpk(o[0], o[1]); w.y = cvtpk(o[2], o[3]);
                if (!(dbg & 256)) *(u32x2*)(ob + m * DM + h * 64 + 4 * r16) = w;
            }
            st_flag(&flags[F_POST], cgl + 1);
        }
    }
}

DI void naive_seq(PP P, int l, LAS unsigned char* sl, int lane, int b, int h, bool sample) {
    LAS float* opl = (LAS float*)sl;
    LAS float* lor = opl + 384;
    const bf16_t* ub = (const bf16_t*)(P->ws + WS_UB); bf16_t* ob = (bf16_t*)(P->ws + WS_OB);
    const float* mu = P->in[10] + (size_t)l * SHW;
    const int kc = h * 64 + lane;
    const float mur = mu[U_R + kc], muk = mu[U_K + kc], muv = mu[U_V + kc], muw = mu[U_WLO + lane], mua = mu[U_ALO + lane];
    const float w0c = P->in[11][(size_t)l * 384 + kc], a0c = P->in[13][(size_t)l * 384 + kc], kkc = P->in[15][(size_t)l * 384 + kc], kac = P->in[16][(size_t)l * 384 + kc], rkc = P->in[17][(size_t)l * 384 + kc];
    const float gng = P->in[18][(size_t)l * 384 + kc], gnb = P->in[19][(size_t)l * 384 + kc];
    const size_t m0 = sample ? (size_t)MP + (size_t)b * TSS : (size_t)b * TP;
    const int T = sample ? TSS : TP;
    const float* sh0 = P->in[8] + (size_t)(l * 32 + b) * SHW;
    LAS float* Wd = opl + 512; LAS float* Wa = Wd + 4096;
    { const float* wd = P->in[12] + (size_t)l * 64 * 384 + kc; const float* wa = P->in[14] + (size_t)l * 64 * 384 + kc;
#pragma unroll 4
      for (int i = 0; i < 64; ++i) { Wd[i * 64 + lane] = wd[(size_t)i * 384]; Wa[i * 64 + lane] = wa[(size_t)i * 384]; } }
    float S[64];
    if (sample) { const float* sp = P->in[7] + ((size_t)((l * 32 + b) * 6 + h) * 64 + lane) * 64;
#pragma unroll
        for (int k = 0; k < 64; ++k) S[k] = sp[k]; }
    else {
#pragma unroll
        for (int k = 0; k < 64; ++k) S[k] = 0.f; }
    float pr = sample ? sh0[U_R + kc] : 0.f, pk = sample ? sh0[U_K + kc] : 0.f, pv = sample ? sh0[U_V + kc] : 0.f, pwl = sample ? sh0[U_WLO + lane] : 0.f, pal = sample ? sh0[U_ALO + lane] : 0.f;
    const bf16_t* row = ub + m0 * NPAD;
    unsigned short n_r = row[U_R + kc], n_k = row[U_K + kc], n_v = row[U_V + kc], n_wl = row[U_WLO + lane], n_al = row[U_ALO + lane], n_g = row[U_GA + kc];
#pragma unroll 1
    for (int t = 0; t < T; ++t) {
        const float cr = bf2f(n_r), ck = bf2f(n_k), cv = bf2f(n_v), cwl = bf2f(n_wl), cal = bf2f(n_al), cg = bf2f(n_g);
        { const bf16_t* nrow = ub + (m0 + (t + 1 < T ? t + 1 : t)) * NPAD;
          n_r = nrow[U_R + kc]; n_k = nrow[U_K + kc]; n_v = nrow[U_V + kc]; n_wl = nrow[U_WLO + lane]; n_al = nrow[U_ALO + lane]; n_g = nrow[U_GA + kc]; }
        const float r = cr + (pr - cr) * mur, k = ck + (pk - ck) * muk, v = cv + (pv - cv) * muv, zw = cwl + (pwl - cwl) * muw, za = cal + (pal - cal) * mua;
        pr = cr; pk = ck; pv = cv; pwl = cwl; pal = cal;
        lor[lane] = tanhf(zw); lor[64 + lane] = za;
        float dw = 0.f, da = 0.f;
#pragma unroll 1
        for (int i = 0; i < 64; i += 4) { const f32x4 tw = *(LAS const f32x4*)(lor + i), ta = *(LAS const f32x4*)(lor + 64 + i);
#pragma unroll
            for (int e = 0; e < 4; ++e) { dw += tw[e] * Wd[(i + e) * 64 + lane]; da += ta[e] * Wa[(i + e) * 64 + lane]; } }
        const float x = w0c + dw;
        const float wlog = -log1pf(expf(-x)) - 0.5f;
        const float w = expf(-expf(wlog));
        const float a = 1.f / (1.f + expf(-(a0c + da)));
        const float kn = k * kkc; const float ss = wave_sum(kn * kn);
        const float knn = kn * (1.f / sqrtf(ss + 1e-12f));
        const float kp = k * (1.f + (a - 1.f) * kac);
        const float bs = wave_sum(r * kp * rkc);
        opl[lane] = w; opl[64 + lane] = knn; opl[128 + lane] = knn * a; opl[192 + lane] = kp; opl[256 + lane] = r; opl[320 + lane] = v;
        const float vv = v;
        float sa = 0.f;
#pragma unroll
        for (int i = 0; i < 64; i += 4) { const f32x4 q = *(LAS const f32x4*)(opl + 64 + i);
#pragma unroll
            for (int e = 0; e < 4; ++e) sa += S[i + e] * q[e]; }
        float y = 0.f;
#pragma unroll
        for (int i = 0; i < 64; i += 4) { const f32x4 qw = *(LAS const f32x4*)(opl + i), qa = *(LAS const f32x4*)(opl + 128 + i), qk = *(LAS const f32x4*)(opl + 192 + i), qr = *(LAS const f32x4*)(opl + 256 + i);
#pragma unroll
            for (int e = 0; e < 4; ++e) { S[i + e] = S[i + e] * qw[e] - sa * qa[e] + vv * qk[e]; y += S[i + e] * qr[e]; } }
        const float mean = wave_sum(y) * (1.f / 64.f); const float d = y - mean;
        const float var = wave_sum(d * d) * (1.f / 64.f);
        float o = d * (1.f / sqrtf(var + GN_EPS)) * gng + gnb + bs * vv;
        o *= cg / (1.f + expf(-cg));
        ob[(m0 + t) * DM + kc] = (bf16_t)(cvtpk(o, o) & 0xffffu);
        asm volatile("" ::: "memory");
    }
    float* so = P->out + (sample ? O_SWKV : O_PWKV) + ((size_t)((l * 32 + b) * 6 + h) * 64 + lane) * 64;
#pragma unroll
    for (int k = 0; k < 64; k += 4) *(f32x4*)(so + k) = (f32x4){S[k], S[k + 1], S[k + 2], S[k + 3]};
}

DI bf16x8 ld_bf16x8(const bf16_t* p) { return *(const bf16x8*)p; }
DI bf16x8 cvt_f32x8(const float* p) { const f32x4 a = *(const f32x4*)p, b = *(const f32x4*)(p + 4); u32x4 w; w.x = cvtpk(a[0], a[1]); w.y = cvtpk(a[2], a[3]); w.z = cvtpk(b[0], b[1]); w.w = cvtpk(b[2], b[3]); return __builtin_bit_cast(bf16x8, w); }
DI bf16x8 pack8(const f32x16& x, int s) { u32x4 w; w.x = cvtpk(x[8 * s], x[8 * s + 1]); w.y = cvtpk(x[8 * s + 2], x[8 * s + 3]); w.z = cvtpk(x[8 * s + 4], x[8 * s + 5]); w.w = cvtpk(x[8 * s + 6], x[8 * s + 7]); return __builtin_bit_cast(bf16x8, w); }
DI bf16x8 vfrag(LAS const unsigned char* p) {
    const v4i16_t lo = __builtin_amdgcn_ds_read_tr16_b64_v4i16((LAS v4i16_t*)p), hi = __builtin_amdgcn_ds_read_tr16_b64_v4i16((LAS v4i16_t*)(p + 512));
    return (bf16x8){lo[0], lo[1], lo[2], lo[3], hi[0], hi[1], hi[2], hi[3]};
}

struct AttnState { f32x16 o0, o1; float m_run, l_run, carry; };

template <int KIND, bool F32>
DI void attn_tile(AttnState& st, const bf16x8 (&qr)[4], bf16x8 (&kf)[4], f32x4 (&kq)[8], bf16x8 (&vr)[4], f32x4 (&vq)[8], const char* knext, const char* vnext, unsigned vpitch16, float lf, bool diag, LAS unsigned char* wl, int lane) {
    const int r32 = lane & 31, hi = lane >> 5;
    LAS float* sm = (LAS float*)(wl + 8192);
#pragma unroll
    for (int pc = 0; pc < 4; ++pc) {
        if (F32) { u32x4 x; x.x = cvtpk(vq[2 * pc][0], vq[2 * pc][1]); x.y = cvtpk(vq[2 * pc][2], vq[2 * pc][3]); x.z = cvtpk(vq[2 * pc + 1][0], vq[2 * pc + 1][1]); x.w = cvtpk(vq[2 * pc + 1][2], vq[2 * pc + 1][3]);
            *(LAS u32x4*)(wl + pc * 1024 + lane * 16) = x; }
        else *(LAS bf16x8*)(wl + pc * 1024 + lane * 16) = vr[pc];
    }
#pragma unroll
    for (int pc = 0; pc < 4; ++pc) {
        if (F32) { const char* p_ = vnext + (size_t)((pc & 1) * vpitch16 + (pc >> 1) * 128); vq[2 * pc] = *(const f32x4*)p_; vq[2 * pc + 1] = *(const f32x4*)(p_ + 16); }
        else vr[pc] = *(const bf16x8*)(vnext + pc * 1024);
    }
    if (F32) {
#pragma unroll
        for (int i = 0; i < 4; ++i) { u32x4 w; w.x = cvtpk(kq[2 * i][0], kq[2 * i][1]); w.y = cvtpk(kq[2 * i][2], kq[2 * i][3]); w.z = cvtpk(kq[2 * i + 1][0], kq[2 * i + 1][1]); w.w = cvtpk(kq[2 * i + 1][2], kq[2 * i + 1][3]);
            kf[i] = __builtin_bit_cast(bf16x8, w); }
    }
    f32x16 p = {};
    __builtin_amdgcn_s_setprio(1);
#pragma unroll
    for (int d0 = 0; d0 < 4; ++d0) p = MFMA32(kf[d0], qr[d0], p);
    __builtin_amdgcn_s_setprio(0);
    asm volatile("" : "+v"(p));
    LAS const unsigned char* vb = wl + ((lane >> 4) & 1) * 32 + (lane & 3) * 8 + (4 * hi + ((lane & 15) >> 2)) * 64;
    const bf16x8 vf0 = vfrag(vb + 0 * 1024), vf1 = vfrag(vb + 1 * 1024), vf2 = vfrag(vb + 2 * 1024), vf3 = vfrag(vb + 3 * 1024);
    if (F32) {
#pragma unroll
        for (int d0 = 0; d0 < 4; ++d0) { kq[2 * d0] = *(const f32x4*)(knext + 64 * d0); kq[2 * d0 + 1] = *(const f32x4*)(knext + 64 * d0 + 16); }
    } else {
#pragma unroll
        for (int d0 = 0; d0 < 4; ++d0) kf[d0] = *(const bf16x8*)(knext + d0 * 1024);
    }
    if (KIND == 0) {
        float incl = lf;
#pragma unroll
        for (int off = 1; off < 32; off <<= 1) { const float t = __shfl_down(incl, off, 32); if (r32 + off < 32) incl += t; }
        const float bias = (st.carry + (incl - lf)) * LOG2E;
        const float tot = __shfl(incl, 0, 32);
        if (hi == 0) sm[r32] = bias;
        st.carry += tot;
        float s[16];
#pragma unroll
        for (int g = 0; g < 4; ++g) { const f32x4 b4 = *(LAS const f32x4*)(sm + 8 * g + 4 * hi);
#pragma unroll
            for (int e = 0; e < 4; ++e) s[4 * g + e] = p[4 * g + e] * QSCALE2 + b4[e]; }
        if (diag) {
#pragma unroll
            for (int r = 0; r < 16; ++r) if (crow(r, hi) > r32) s[r] = -1e30f;
        }
        if (diag) {
            float mt = s[0];
#pragma unroll
            for (int r = 1; r < 16; ++r) mt = fmaxf(mt, s[r]);
            { auto rr = __builtin_amdgcn_permlane32_swap(__float_as_uint(mt), __float_as_uint(mt), false, false); mt = fmaxf(__uint_as_float(rr[0]), __uint_as_float(rr[1])); }
            st.m_run = mt;
        }
        float ls = 0.f;
#pragma unroll
        for (int r = 0; r < 16; ++r) { p[r] = fast_exp2(s[r] - st.m_run); ls += p[r]; }
        st.l_run += ls;
    } else {
        float be[16], om[16];
#pragma unroll
        for (int r = 0; r < 16; ++r) {
            const float z2 = fmaxf(p[r] * QSCALE2, -80.f);
            const float e = fast_exp2(-z2); const float bt = fast_rcp(1.f + e);
            be[r] = bt; om[r] = e * bt;
        }
        if (diag) {
#pragma unroll
            for (int r = 0; r < 16; ++r) if (crow(r, hi) >= r32) { be[r] = 0.f; om[r] = 1.f; }
        }
        float H[4], oth[4];
#pragma unroll
        for (int g = 0; g < 4; ++g) { const float gp = (om[4 * g] * om[4 * g + 1]) * (om[4 * g + 2] * om[4 * g + 3]);
            auto rr = __builtin_amdgcn_permlane32_swap(__float_as_uint(gp), __float_as_uint(gp), false, false);
            const float a = __uint_as_float(rr[0]), b = __uint_as_float(rr[1]); H[g] = a * b; oth[g] = hi ? 1.f : b; }
        float suf[4]; suf[3] = 1.f; suf[2] = H[3]; suf[1] = H[3] * H[2]; suf[0] = suf[1] * H[1];
        const float cin = st.carry;
#pragma unroll
        for (int g = 0; g < 4; ++g) {
            float A = cin * suf[g] * oth[g];
            p[4 * g + 3] = be[4 * g + 3] * A; A *= om[4 * g + 3];
            p[4 * g + 2] = be[4 * g + 2] * A; A *= om[4 * g + 2];
            p[4 * g + 1] = be[4 * g + 1] * A; A *= om[4 * g + 1];
            p[4 * g + 0] = be[4 * g + 0] * A;
        }
        st.carry = cin * suf[0] * H[0];
    }
    const bf16x8 pa0 = pack8(p, 0), pa1 = pack8(p, 1);
    __builtin_amdgcn_s_setprio(1);
    st.o0 = MFMA32(pa0, vf0, st.o0);
    st.o1 = MFMA32(pa0, vf2, st.o1);
    st.o0 = MFMA32(pa1, vf1, st.o0);
    st.o1 = MFMA32(pa1, vf3, st.o1);
    __builtin_amdgcn_s_setprio(0);
    if (F32) {
#pragma unroll
        for (int i = 0; i < 8; ++i) { asm volatile("" : "+v"(kq[i])); asm volatile("" : "+v"(vq[i])); }
    } else {
#pragma unroll
        for (int i = 0; i < 4; ++i) { asm volatile("" : "+v"(kf[i])); asm volatile("" : "+v"(vr[i])); }
    }
}

template <int KIND>
DI void attn_item(PP P, int l, LAS unsigned char* wl, int lane, bool sample, int b, int h, int qb) {
    const int r32 = lane & 31, hi = lane >> 5;
    const char* ubb = (const char*)(P->ws + WS_UB);
    constexpr unsigned PITCH = NPAD * 2;
    constexpr int NH = KIND == 0 ? NHB : NHC;
    constexpr int QC = KIND == 0 ? U_QB : U_QC, KC = KIND == 0 ? U_KB : U_KC, VC = KIND == 0 ? U_VB : U_VC, GC = KIND == 0 ? U_GB : U_GC, OC = KIND == 0 ? 384 : 768;
    const int q0 = qb * 32, past = sample ? PAST : 0;
    const unsigned row0 = sample ? (unsigned)(MP + b * TSS) : (unsigned)(b * TP);
    const unsigned kl = (unsigned)(r32 * NPAD + KC + h * 64 + 8 * hi) * 2u;
    const unsigned vl = (unsigned)((lane >> 2) * NPAD + VC + h * 64 + (lane & 3) * 8) * 2u;
    bf16x8 qr[4];
    { const char* qp = ubb + (size_t)((row0 + q0) * PITCH + (unsigned)(r32 * NPAD + QC + h * 64 + 8 * hi) * 2u);
#pragma unroll
      for (int d0 = 0; d0 < 4; ++d0) qr[d0] = *(const bf16x8*)(qp + 32 * d0); }
    AttnState st; st.o0 = f32x16{}; st.o1 = f32x16{}; st.m_run = -1e30f; st.l_run = 0.f; st.carry = KIND == 0 ? 0.f : 1.f;
    const int tdiag = (past + q0) / 32, tnew0 = past / 32;
    const float* logf = (const float*)(P->ws + WS_LOGF) + h;
    bf16x8 kf[4], vr[4]; f32x4 kq[8], vq[8];
    {
        const unsigned tix0 = sample ? (unsigned)(32 * NH * 64 + (b * NH + h) * 2) : (unsigned)((b * NH + h) * 64);
        const char* kbb = (const char*)(P->ws + (KIND == 0 ? WS_BFK : WS_BSK)) + (size_t)tix0 * 4096 + lane * 16;
        const char* vbb = (const char*)(P->ws + (KIND == 0 ? WS_BFV : WS_BSV)) + (size_t)tix0 * 4096 + lane * 16;
        float lf = 0.f;
        { const unsigned tl_ = (unsigned)(tdiag - tnew0); const unsigned trow_ = row0 + tl_ * 32u;
#pragma unroll
          for (int d0 = 0; d0 < 4; ++d0) kf[d0] = *(const bf16x8*)(kbb + (size_t)(tl_ * 4096u) + d0 * 1024);
#pragma unroll
          for (int pc = 0; pc < 4; ++pc) vr[pc] = *(const bf16x8*)(vbb + (size_t)(tl_ * 4096u) + pc * 1024);
          if (KIND == 0) lf = logf[(size_t)(trow_ + r32) * 8]; }
        for (int tile = tdiag; tile >= tnew0; --tile) {
            const unsigned tn = (unsigned)((tile > tnew0 ? tile - 1 : tnew0) - tnew0);
            const unsigned trow_ = row0 + tn * 32u;
            const float lfc = lf;
            if (KIND == 0) lf = logf[(size_t)(trow_ + r32) * 8];
            attn_tile<KIND, false>(st, qr, kf, kq, vr, vq, kbb + (size_t)(tn * 4096u), vbb + (size_t)(tn * 4096u), 0u, lfc, tile == tdiag, wl, lane);
        }
    }
    if (sample) {
        const char* cK = (const char*)(P->in[KIND == 0 ? 2 : 5] + (size_t)(l * 32 + b) * PAST * NH * 64 + h * 64);
        const char* cV = (const char*)(P->in[KIND == 0 ? 3 : 6] + (size_t)(l * 32 + b) * PAST * NH * 64 + h * 64);
        const float* cL = P->in[4] + (size_t)(l * 32 + b) * PAST * 6 + h;
        constexpr unsigned CP = NH * 64 * 4;
        const unsigned klc = (unsigned)r32 * CP + 32u * hi, vlc = (unsigned)(lane >> 2) * CP + 32u * (lane & 3);
        float lf = 0.f;
        { const char* kb_ = cK + (size_t)((unsigned)(tnew0 - 1) * 32u * CP) + klc;
#pragma unroll
          for (int d0 = 0; d0 < 4; ++d0) { kq[2 * d0] = *(const f32x4*)(kb_ + 64 * d0); kq[2 * d0 + 1] = *(const f32x4*)(kb_ + 64 * d0 + 16); }
          const char* vb_ = cV + (size_t)((unsigned)(tnew0 - 1) * 32u * CP) + vlc;
#pragma unroll
          for (int pc = 0; pc < 4; ++pc) { const char* p_ = vb_ + (size_t)((pc & 1) * (16u * CP) + (pc >> 1) * 128); vq[2 * pc] = *(const f32x4*)p_; vq[2 * pc + 1] = *(const f32x4*)(p_ + 16); }
          if (KIND == 0) lf = cL[(size_t)((tnew0 - 1) * 32 + r32) * 6]; }
        for (int tile = tnew0 - 1; tile >= 0; --tile) {
            const int tn = tile > 0 ? tile - 1 : 0;
            const float lfc = lf;
            if (KIND == 0) lf = cL[(size_t)(tn * 32 + r32) * 6];
            attn_tile<KIND, true>(st, qr, kf, kq, vr, vq, cK + (size_t)((unsigned)tn * 32u * CP) + klc, cV + (size_t)((unsigned)tn * 32u * CP) + vlc, 16u * CP, lfc, false, wl, lane);
        }
    }
    LAS float* stg = (LAS float*)wl; LAS float* sm = (LAS float*)(wl + 8192);
    if (KIND == 0) {
        auto rr = __builtin_amdgcn_permlane32_swap(__float_as_uint(st.l_run), __float_as_uint(st.l_run), false, false);
        const float lt = __uint_as_float(rr[0]) + __uint_as_float(rr[1]);
        if (hi == 0) sm[r32] = 1.f / lt;
    }
#pragma unroll
    for (int r = 0; r < 16; ++r) { stg[crow(r, hi) * 64 + r32] = st.o0[r]; stg[crow(r, hi) * 64 + 32 + r32] = st.o1[r]; }
    char* obb = (char*)(P->ws + WS_OB);
#pragma unroll
    for (int i = 0; i < 4; ++i) {
        const int row = i * 8 + (lane >> 3), chn = lane & 7;
        const f32x4 a = *(LAS const f32x4*)(stg + row * 64 + chn * 8), c = *(LAS const f32x4*)(stg + row * 64 + chn * 8 + 4);
        const float li = KIND == 0 ? sm[row] : 1.f;
        const unsigned m = row0 + q0 + row;
        const u32x4 g = *(const u32x4*)(ubb + (size_t)(m * PITCH + (unsigned)(GC + h * 64 + chn * 8) * 2u));
        u32x4 w;
        w.x = cvtpk(a[0] * li * siluf_(bflo(g.x)), a[1] * li * siluf_(bfhi(g.x))); w.y = cvtpk(a[2] * li * siluf_(bflo(g.y)), a[3] * li * siluf_(bfhi(g.y)));
        w.z = cvtpk(c[0] * li * siluf_(bflo(g.z)), c[1] * li * siluf_(bfhi(g.z))); w.w = cvtpk(c[2] * li * siluf_(bflo(g.w)), c[3] * li * siluf_(bfhi(g.w)));
        *(u32x4*)(obb + (size_t)(m * (DM * 2) + (unsigned)(OC + h * 64 + chn * 8) * 2u)) = w;
    }
}

constexpr int Q_SAMPLE = 2 * (16 + 24), Q_ITEMS = Q_SAMPLE + 40 * 64;
DI unsigned xcc_id() { return (unsigned)__builtin_amdgcn_s_getreg((3 << 11) | 20) & 7u; }
DI void worker_loop(PP P, int l, int lq, LAS unsigned char* lds, int wave, int lane) {
    LAS unsigned char* wl = lds + wave * WK_STRIDE;
    unsigned* qbase = (unsigned*)(P->ws + WS_CTL) + 64 + lq * 128;
    const unsigned x0 = xcc_id();
    for (unsigned sx = 0; sx < 8; ++sx) {
        const unsigned x = (x0 + sx) & 7u;
        unsigned* qctr = qbase + x * 16;
        for (;;) {
            unsigned idx = 0;
            if (lane == 0) idx = atomicAdd(qctr, 1u);
            idx = (unsigned)__builtin_amdgcn_readfirstlane((int)idx);
            if (idx >= (unsigned)Q_ITEMS) break;
            int kind, smp, bh, qb;
            if (idx < (unsigned)Q_SAMPLE) {
                smp = 1;
                if (idx < 32u) { kind = 1; bh = (int)x + 8 * (int)(idx >> 1); qb = idx & 1; }
                else { const int i2 = idx - 32; kind = 0; bh = (int)x + 8 * (i2 >> 1); qb = i2 & 1; }
            } else {
                smp = 0;
                const int i2 = idx - Q_SAMPLE, g = i2 >> 6; qb = 63 - (i2 & 63);
                if (g < 16) { kind = 1; bh = (int)x + 8 * g; } else { kind = 0; bh = (int)x + 8 * (g - 16); }
            }
            if (kind) attn_item<1>(P, l, wl, lane, smp != 0, bh / NHC, bh % NHC, qb);
            else attn_item<0>(P, l, wl, lane, smp != 0, bh / NHB, bh % NHB, qb);
        }
    }
}

DI void phase_mix(PP P, int lq, LAS unsigned char* lds, int wave, int lane, int bidx, int gdim) {
    const int l = lq & 1; const int dbg = (lq & 2) ? (P->dbg | 256) : 0;
    if (wave == 0 && lane < 16) ((LAS unsigned*)(lds + SC_FLAGS))[lane] = 0u;
    __syncthreads();
    const int bx = bidx;
#ifdef NAIVE_SCAN
    if (wave == 0) {
        for (int sq = bx; sq < 384; sq += gdim) {
            if (sq < 192) naive_seq(P, l, lds + SC_OFF, lane, sq / 6, sq % 6, false);
            else naive_seq(P, l, lds + SC_OFF, lane, (sq - 192) / 6, (sq - 192) % 6, true);
        }
    }
#else
    if (gdim >= 256 && !(dbg & 16)) {
        if (bx < 192) {
#ifndef SK_SCAN
            if (wave < 4) scan_wave(P, l, lds, wave, lane, bx, 1, false, dbg, true);
#endif
#ifndef SK_PREP
            if (wave == 4 || wave == 5) helper2_wave(P, l, lds, lane, bx, wave - 4, dbg);
#endif
        } else if (bx < 256) {
            const int s0 = (bx - 192) * 3;
#ifndef SK_SCAN
            if (wave < 4) scan_wave(P, l, lds, wave, lane, s0, 3, true, dbg);
#endif
#ifndef SK_PREP
            if (wave == 4) PREPFN(P, l, lds, lane, s0, 3, true, dbg);
#endif
#ifndef SK_POST
            if (wave == 5) post_wave(P, l, lds, lane, s0, 3, true, dbg);
#endif
        }
    }
#endif
#ifndef SK_WORK
    if (!(dbg & 4)) worker_loop(P, l, lq, lds, wave, lane);
#endif
}

__global__ void __launch_bounds__(512, 2) fwd_kernel(Params Pv) {
    extern __shared__ __attribute__((aligned(16))) unsigned char lds_raw[];
    LAS unsigned char* lds = (LAS unsigned char*)lds_raw;
    const int tid = threadIdx.x, lane0 = tid & 63, wave0 = __builtin_amdgcn_readfirstlane(tid >> 6);
    PP P0 = (PP)__builtin_amdgcn_kernarg_segment_ptr();
    const int lo = Pv.ph_lo, hi = Pv.ph_hi;
    const int rep_ph = Pv.rep_ph;
#pragma unroll 1
    for (int ph2 = lo * 2; ph2 < hi * 2; ++ph2) {
        const int ph = ph2 >> 1, rep = ph2 & 1;
        if (rep && ph != rep_ph) continue;
        PP P = pp_launder(P0);
        int lane = lane0, wave = wave0, bidx = (int)blockIdx.x, gdim = (int)gridDim.x;
        asm volatile("" : "+v"(lane)); asm volatile("" : "+s"(wave)); asm volatile("" : "+s"(bidx)); asm volatile("" : "+s"(gdim));
        if (ph == 0) {
#ifndef SK_P0
            phase0(P, lds, wave, lane, bidx, gdim);
#endif
        } else {
            const int l = (ph - 1) >> 2, k = (ph - 1) & 3;
            if (k == 0 || k == 2) {
#ifndef SK_G1
                pg8::Gemm g; pg8::StaticOrder S; EpiU E;
                E.ws = P->ws; E.out = P->out; E.fb = P->in[20] + l * 6; E.l = l; E.mode = k;
                if (k == 0) { g = pg8::Gemm{(const bf16_t*)(P->ws + WS_XB), (const bf16_t*)(P->ws + WS_WIN) + (size_t)l * NPAD * DM, MT, NPAD, DM}; S.init(MT, NPAD, gdim, bidx); }
                else { g = pg8::Gemm{(const bf16_t*)(P->ws + WS_OB), (const bf16_t*)(P->ws + WS_WOUT) + (size_t)l * DM * DM, MT, DM, DM}; S.init(MT, DM, gdim, bidx); }
                pg8::gemm_phase<EpiU, pg8::StaticOrder, true, true>(lds, g, S, E);
#endif
            } else if (k == 1) {
#ifndef SK_MIX
                phase_mix(P, l + 2 * rep, lds, wave, lane, bidx, gdim);
#endif
            } else {
#ifndef SK_LN
                phase_ln(P, l, wave, lane, bidx, gdim);
#endif
            }
        }
        if (ph2 + 1 < hi * 2) cg::this_grid().sync();
    }
}

extern "C" void kernel_launch(void* const* d_in, const int* in_sizes, int n_in, void* d_out, int out_size, void* d_ws, size_t ws_size, hipStream_t stream) {
    static int grid = 0;
    if (grid == 0) {
        if (n_in != 24 || (size_t)out_size != O_END || ws_size < WS_END) { fprintf(stderr, "kernel_launch: unexpected shapes n_in %d out %d ws %zu\n", n_in, out_size, ws_size); grid = -1; return; }
        int dev = 0, cus = 0, per_cu = 0;
        (void)hipGetDevice(&dev); (void)hipDeviceGetAttribute(&cus, hipDeviceAttributeMultiprocessorCount, dev);
        if (hipFuncSetAttribute((const void*)fwd_kernel, hipFuncAttributeMaxDynamicSharedMemorySize, LDS_BYTES) != hipSuccess) { fprintf(stderr, "kernel_launch: hipFuncSetAttribute failed\n"); grid = -1; return; }
        if (hipOccupancyMaxActiveBlocksPerMultiprocessor(&per_cu, (const void*)fwd_kernel, 512, LDS_BYTES) != hipSuccess || per_cu < 1) { fprintf(stderr, "kernel_launch: occupancy query says %d\n", per_cu); per_cu = 1; }
        (void)hipGetLastError();
        grid = cus * 1;
        if (grid != 256) fprintf(stderr, "kernel_launch: grid %d (expected 256)\n", grid);
    }
    if (grid < 0) return;
    (void)hipMemsetAsync((char*)d_ws + WS_CTL, 0, CTL_BYTES, stream);
    Params p{};
    for (int i = 0; i < 24; ++i) p.in[i] = (const float*)d_in[i];
    p.out = (float*)d_out; p.ws = (unsigned char*)d_ws; p.ph_lo = 0; p.ph_hi = 9; p.rep_ph = -1; p.dbg = 0;
    void* args[] = {&p};
    hipError_t e = hipLaunchCooperativeKernel((const void*)fwd_kernel, dim3(grid), dim3(512), args, LDS_BYTES, stream);
    if (e != hipSuccess) fprintf(stderr, "cooperative launch failed: %s (grid %d)\n", hipGetErrorString(e), grid);
}
```
